# Optimizing an MI355X kernel written in HIP

```python
import math
import jax, jax.numpy as jnp
from jax import lax
import numpy as np

D_MODEL = 1024
BATCH = 16
SEQ = 4096
DEPTH = 1

S5_WIDTH = D_MODEL // 2
S5_GROUP = 16
S5_GROUPS = S5_WIDTH // S5_GROUP
S5_STATE = 64
HGRN_WIDTH = D_MODEL // 2
HGRN_HEAD_DIM = 128
HGRN_HEADS = HGRN_WIDTH // HGRN_HEAD_DIM
HGRN_CHUNK = 64
PEER_HEADS = 8
PEER_TOPK = 16
PEER_NKEYS = 128
PEER_NEXPERTS = PEER_NKEYS * PEER_NKEYS
PEER_QDIM = 256
PEER_TOKEN_BLOCK = 128
IN_COLS = S5_WIDTH + 4 * HGRN_WIDTH + 2 * D_MODEL
DEEPNORM_ALPHA = (2.0 * DEPTH) ** 0.25
DEEPNORM_BETA = (8.0 * DEPTH) ** -0.25
LN_EPS = 1e-5
RMS_EPS = 1e-6

kernel_name = "hybrid_s5_hgrn2_peer_deepnorm"


def layer_norm(x, g, b):
    xf = x.astype(jnp.float32)
    mu = jnp.mean(xf, axis=-1, keepdims=True)
    var = jnp.mean(jnp.square(xf - mu), axis=-1, keepdims=True)
    y = (xf - mu) * lax.rsqrt(var + LN_EPS) * g.astype(jnp.float32) + b.astype(jnp.float32)
    return y.astype(x.dtype)


def s5_branch(u, lam_re, lam_im, b_re, b_im, c_re, c_im, d_skip, log_step, w_glu, b_glu):
    bsz, seq, _ = u.shape
    uf = u.astype(jnp.float32).reshape(bsz, seq, S5_GROUPS, S5_GROUP)
    lam = lax.complex(lam_re.astype(jnp.float32), lam_im.astype(jnp.float32))
    dt = jnp.exp(log_step.astype(jnp.float32))[:, None]
    lam_bar = jnp.exp(lam * dt)
    b_mat = lax.complex(b_re.astype(jnp.float32), b_im.astype(jnp.float32))
    b_bar = ((lam_bar - 1.0) / lam)[..., None] * b_mat
    bu = jnp.einsum('bsgh,gph->sbgp', uf.astype(jnp.complex64), b_bar)
    a = jnp.broadcast_to(lam_bar, (seq, 1, S5_GROUPS, S5_STATE))

    def combine(left, right):
        a_l, b_l = left
        a_r, b_r = right
        return a_r * a_l, a_r * b_l + b_r

    _, states = lax.associative_scan(combine, (a, bu), axis=0)
    c_mat = lax.complex(c_re.astype(jnp.float32), c_im.astype(jnp.float32))
    y = jnp.real(jnp.einsum('sbgp,ghp->bsgh', states, c_mat)) + d_skip.astype(jnp.float32) * uf
    y = jax.nn.gelu(y.reshape(bsz, seq, S5_WIDTH))
    y = y * jax.nn.sigmoid(y @ w_glu.astype(jnp.float32) + b_glu.astype(jnp.float32))
    return y.astype(u.dtype)


def hgrn2_branch(q, f_pre, i_in, g, lb, gnorm_w):
    bsz, seq, _ = q.shape
    n_chunks = seq // HGRN_CHUNK
    lbf = lb.astype(jnp.float32)
    f = lbf + (1.0 - lbf) * jax.nn.sigmoid(f_pre.astype(jnp.float32))
    log_f = jnp.log(f)
    k = 1.0 - f
    qf = jax.nn.silu(q.astype(jnp.float32))
    v = i_in.astype(jnp.float32)

    def to_chunks(t):
        return t.reshape(bsz, n_chunks, HGRN_CHUNK, HGRN_HEADS, HGRN_HEAD_DIM).transpose(1, 0, 3, 2, 4)

    causal = jnp.tril(jnp.ones((HGRN_CHUNK, HGRN_CHUNK), dtype=bool))[:, :, None]

    def step(state, inp):
        qc, kc, vc, lc = inp
        bcum = jnp.cumsum(lc, axis=-2)
        inter = jnp.einsum('bhck,bhkv->bhcv', qc * jnp.exp(bcum), state)
        diff = bcum[:, :, :, None, :] - bcum[:, :, None, :, :]
        decay = jnp.exp(jnp.where(causal, diff, -jnp.inf))
        scores = jnp.einsum('bhtk,bhsk,bhtsk->bhts', qc, kc, decay)
        intra = jnp.einsum('bhts,bhsv->bhtv', scores, vc)
        blast = bcum[:, :, -1:, :]
        new_state = (jnp.exp(blast[:, :, 0, :])[..., None] * state
                     + jnp.einsum('bhsk,bhsv->bhkv', kc * jnp.exp(blast - bcum), vc))
        return new_state, inter + intra

    s0 = jnp.zeros((bsz, HGRN_HEADS, HGRN_HEAD_DIM, HGRN_HEAD_DIM), jnp.float32)
    _, o = lax.scan(step, s0, (to_chunks(qf), to_chunks(k), to_chunks(v), to_chunks(log_f)))
    o = o.transpose(1, 0, 3, 2, 4).reshape(bsz, seq, HGRN_HEADS, HGRN_HEAD_DIM)
    o = o * lax.rsqrt(jnp.mean(jnp.square(o), axis=-1, keepdims=True) + RMS_EPS)
    o = o * gnorm_w.astype(jnp.float32).reshape(HGRN_HEADS, HGRN_HEAD_DIM)
    o = o.reshape(bsz, seq, HGRN_WIDTH) * jax.nn.silu(g.astype(jnp.float32))
    return o.astype(q.dtype)


def peer_layer(x, w_pq, sub_keys, peer_u, peer_v):
    bsz, seq, d = x.shape
    xt = x.reshape(-1, PEER_TOKEN_BLOCK, d)
    half = PEER_QDIM // 2

    def block(xb):
        q = (xb @ w_pq).reshape(PEER_TOKEN_BLOCK, PEER_HEADS, 2, half)
        s = jnp.einsum('thpd,hpnd->thpn', q, sub_keys).astype(jnp.float32)
        s1, i1 = lax.top_k(s[:, :, 0], PEER_TOPK)
        s2, i2 = lax.top_k(s[:, :, 1], PEER_TOPK)
        cand = (s1[..., :, None] + s2[..., None, :]).reshape(PEER_TOKEN_BLOCK, PEER_HEADS, PEER_TOPK * PEER_TOPK)
        top, flat = lax.top_k(cand, PEER_TOPK)
        e = (jnp.take_along_axis(i1, flat // PEER_TOPK, axis=-1) * PEER_NKEYS
             + jnp.take_along_axis(i2, flat % PEER_TOPK, axis=-1))
        gates = jax.nn.softmax(top, axis=-1)
        u = peer_u[e]
        act = jax.nn.gelu(jnp.einsum('thkd,td->thk', u, xb).astype(jnp.float32))
        return jnp.einsum('thk,thkd->td', (gates * act).astype(xb.dtype), peer_v[e])

    y = lax.map(block, xt)
    return y.reshape(bsz, seq, d)


def setup_inputs(seed: int = 0) -> dict:
    key = jax.random.key(seed)
    ks = jax.random.split(key, 32)
    nrm = lambda k, shape, scale: jax.random.normal(k, shape, jnp.float32) * scale
    L = DEPTH
    G, P, H, W = S5_GROUPS, S5_STATE, S5_GROUP, S5_WIDTH
    x = nrm(ks[0], (BATCH, SEQ, D_MODEL), 1.0)
    w_in = nrm(ks[1], (L, D_MODEL, IN_COLS), D_MODEL ** -0.5)
    s5_lam_re = -0.5 * jnp.exp(nrm(ks[2], (L, G, P), 0.01))
    s5_lam_im = math.pi * jnp.arange(P, dtype=jnp.float32)[None, None, :] + nrm(ks[3], (L, G, P), 0.01)
    s5_b_re = nrm(ks[4], (L, G, P, H), (2.0 * H) ** -0.5)
    s5_b_im = nrm(ks[5], (L, G, P, H), (2.0 * H) ** -0.5)
    s5_c_re = nrm(ks[6], (L, G, H, P), (2.0 * P) ** -0.5)
    s5_c_im = nrm(ks[7], (L, G, H, P), (2.0 * P) ** -0.5)
    s5_d = nrm(ks[8], (L, G, H), 1.0)
    s5_log_step = jax.random.uniform(ks[9], (L, G), jnp.float32, math.log(1e-3), math.log(1e-1))
    s5_w_glu = nrm(ks[10], (L, W, W), W ** -0.5)
    s5_b_glu = nrm(ks[11], (L, W), 0.01)
    hgrn_lb_logits = 1.0 + nrm(ks[12], (L + 1, HGRN_WIDTH), 0.1)
    hgrn_gnorm_w = 1.0 + nrm(ks[13], (L, HGRN_WIDTH), 0.01)
    w_pa = nrm(ks[14], (L, S5_WIDTH, D_MODEL), S5_WIDTH ** -0.5)
    w_pb = nrm(ks[15], (L, HGRN_WIDTH, D_MODEL), HGRN_WIDTH ** -0.5)
    w_o = nrm(ks[16], (L, D_MODEL, D_MODEL), D_MODEL ** -0.5 * DEEPNORM_BETA)
    ln1_g = 1.0 + nrm(ks[17], (L, D_MODEL), 0.01)
    ln1_b = nrm(ks[18], (L, D_MODEL), 0.01)
    peer_w_q = nrm(ks[19], (L, D_MODEL, PEER_HEADS * PEER_QDIM), D_MODEL ** -0.5)
    peer_sub_keys = nrm(ks[20], (L, PEER_HEADS, 2, PEER_NKEYS, PEER_QDIM // 2), (PEER_QDIM // 2) ** -0.5)
    peer_u = nrm(ks[21], (L, PEER_NEXPERTS, D_MODEL), D_MODEL ** -0.5)
    peer_v = nrm(ks[22], (L, PEER_NEXPERTS, D_MODEL), DEEPNORM_BETA)
    ln2_g = 1.0 + nrm(ks[23], (L, D_MODEL), 0.01)
    ln2_b = nrm(ks[24], (L, D_MODEL), 0.01)
    return {"x": x, "w_in": w_in, "s5_lam_re": s5_lam_re, "s5_lam_im": s5_lam_im,
            "s5_b_re": s5_b_re, "s5_b_im": s5_b_im, "s5_c_re": s5_c_re, "s5_c_im": s5_c_im,
            "s5_d": s5_d, "s5_log_step": s5_log_step, "s5_w_glu": s5_w_glu, "s5_b_glu": s5_b_glu,
            "hgrn_lb_logits": hgrn_lb_logits, "hgrn_gnorm_w": hgrn_gnorm_w,
            "w_pa": w_pa, "w_pb": w_pb, "w_o": w_o, "ln1_g": ln1_g, "ln1_b": ln1_b,
            "peer_w_q": peer_w_q, "peer_sub_keys": peer_sub_keys, "peer_u": peer_u, "peer_v": peer_v,
            "ln2_g": ln2_g, "ln2_b": ln2_b}


def reference(x, w_in, s5_lam_re, s5_lam_im, s5_b_re, s5_b_im, s5_c_re, s5_c_im,
              s5_d, s5_log_step, s5_w_glu, s5_b_glu, hgrn_lb_logits, hgrn_gnorm_w,
              w_pa, w_pb, w_o, ln1_g, ln1_b, peer_w_q, peer_sub_keys, peer_u, peer_v,
              ln2_g, ln2_b):
    lb_all = jnp.cumsum(jax.nn.softmax(hgrn_lb_logits.astype(jnp.float32), axis=0), axis=0)[:DEPTH]
    sizes = [S5_WIDTH, HGRN_WIDTH, HGRN_WIDTH, HGRN_WIDTH, HGRN_WIDTH, D_MODEL, D_MODEL]
    split_at = np.cumsum(sizes)[:-1].tolist()
    for l in range(DEPTH):
        proj = x @ w_in[l]
        u_s5, q_h, f_h, i_h, g_h, gate_a, gate_b = jnp.split(proj, split_at, axis=-1)
        y_a = s5_branch(u_s5, s5_lam_re[l], s5_lam_im[l], s5_b_re[l], s5_b_im[l],
                        s5_c_re[l], s5_c_im[l], s5_d[l], s5_log_step[l], s5_w_glu[l], s5_b_glu[l])
        y_b = hgrn2_branch(q_h, f_h, i_h, g_h, lb_all[l], hgrn_gnorm_w[l])
        merged = jax.nn.sigmoid(gate_a) * (y_a @ w_pa[l]) + jax.nn.sigmoid(gate_b) * (y_b @ w_pb[l])
        mix = merged @ w_o[l]
        x = layer_norm(DEEPNORM_ALPHA * x + mix, ln1_g[l], ln1_b[l])
        ffn = peer_layer(x, peer_w_q[l], peer_sub_keys[l], peer_u[l], peer_v[l])
        x = layer_norm(DEEPNORM_ALPHA * x + ffn, ln2_g[l], ln2_b[l])
    return x
```

```cpp
#include <hip/hip_runtime.h>
#include <hip/hip_cooperative_groups.h>
#include <cstdio>
#include <cstdint>
namespace cg = cooperative_groups;

#define DEVI __device__ __forceinline__
#define LAS __attribute__((address_space(3)))
typedef unsigned short bf16;
typedef unsigned v4u __attribute__((ext_vector_type(4)));
typedef unsigned v2u __attribute__((ext_vector_type(2)));
typedef float f32x4 __attribute__((ext_vector_type(4)));
typedef float f32x2 __attribute__((ext_vector_type(2)));
typedef short bf16x8 __attribute__((ext_vector_type(8)));
typedef float f32x16 __attribute__((ext_vector_type(16)));

constexpr int D = 1024, BATCH = 16, SEQ = 4096, T = BATCH * SEQ;
constexpr int S5W = 512, S5H = 16, S5G = 32, S5P = 64;
constexpr int HW = 512, HD = 128, HH = 4;
constexpr int PH = 8, PK = 16, PNK = 128, PNE = 16384;
constexpr int INC = 4608;
constexpr float ALPHA = 1.189207115002721f;
constexpr float LN_EPS = 1e-5f, RMS_EPS = 1e-6f;
constexpr int NCH = 64;
constexpr int UK = 1152;

constexpr size_t MiB = 1u << 20;
constexpr size_t WS_XB = 0;
constexpr size_t WS_Y2 = 0;
constexpr size_t WS_YAB = 64 * MiB;
constexpr size_t WS_X1B = 0;
constexpr size_t WS_U5 = 128 * MiB;
constexpr size_t WS_IDS = 128 * MiB;
constexpr size_t WS_GATES = 160 * MiB;
constexpr size_t WS_Q = 200 * MiB;
constexpr size_t WS_LF = 264 * MiB;
constexpr size_t WS_MG = 264 * MiB;
constexpr size_t WS_VV = 392 * MiB;
constexpr size_t WS_GS = 456 * MiB;
constexpr size_t WS_GA = 520 * MiB;
constexpr size_t WS_GB = 648 * MiB;
constexpr size_t WS_H1 = 392 * MiB;
constexpr size_t WS_SC = 264 * MiB;
constexpr size_t WS_PD = 264 * MiB;
constexpr size_t WS_OP = 264 * MiB;
constexpr size_t WS_CF = 520 * MiB;
constexpr size_t WS_WINT = 776 * MiB;
constexpr size_t WS_WGLUT = 785 * MiB;
constexpr size_t WS_WPAT = 786 * MiB;
constexpr size_t WS_WOT = 788 * MiB;
constexpr size_t WS_WFT = 790 * MiB;
constexpr size_t WS_WZ = 794 * MiB;
constexpr size_t WS_TY = 810 * MiB;
constexpr size_t WS_PU = 882 * MiB;
constexpr size_t WS_PV = 914 * MiB;
constexpr size_t WS_Z = 946 * MiB;
constexpr size_t WS_L64 = 962 * MiB;
constexpr size_t WS_HGS = 963 * MiB;
constexpr size_t WS_HGD = 979 * MiB;
constexpr size_t WS_US = 979 * MiB + 256 * 1024;
constexpr size_t WS_XS = 979 * MiB + 512 * 1024;
constexpr size_t WS_X1Q = 192 * MiB;
constexpr size_t WS_CTL = 980 * MiB;
constexpr size_t WS_END = 981 * MiB;

#ifndef PEER_FP8
#define PEER_FP8 1
#endif
constexpr float PU_SCALE = 256.0f, PV_SCALE = 16.0f;
#ifndef PEER_U_INT8
#define PEER_U_INT8 1
#endif
constexpr int CTL_WORDS = 8192;
constexpr int CW_GU = 4096, CW_GV = 4096 + 64 * 8;
constexpr int LDS_BYTES = 147456;

DEVI unsigned f2bf(float f) { unsigned u = __float_as_uint(f); return (u + 0x7fffu + ((u >> 16) & 1u)) >> 16; }
DEVI unsigned pk2(float lo, float hi) { return f2bf(lo) | (f2bf(hi) << 16); }
typedef _Float16 h16x2 __attribute__((ext_vector_type(2)));
DEVI unsigned pkh2(float a, float b) { const h16x2 v = {(_Float16)a, (_Float16)b}; return __builtin_bit_cast(unsigned, v); }
DEVI float h2f(unsigned short b) { return (float)__builtin_bit_cast(_Float16, b); }
DEVI float bflo(unsigned w) { return __uint_as_float(w << 16); }
DEVI float bfhi(unsigned w) { return __uint_as_float(w & 0xffff0000u); }
DEVI float bf2f(bf16 b) { return __uint_as_float(((unsigned)b) << 16); }
DEVI float sigm(float x) { return __builtin_amdgcn_rcpf(1.0f + __builtin_amdgcn_exp2f(-1.4426950408889634f * x)); }
DEVI float silu(float x) { return x * sigm(x); }
DEVI float gelu_t(float x) { return x * sigm(1.5957691216057308f * (x + 0.044715f * x * x * x)); }
DEVI float wave_sum(float v) {
#pragma unroll
    for (int o = 1; o < 64; o <<= 1) v += __shfl_xor(v, o);
    return v;
}
DEVI float wave_max(float v) {
#pragma unroll
    for (int o = 1; o < 64; o <<= 1) v = fmaxf(v, __shfl_xor(v, o));
    return v;
}

struct Args { const float* in[25]; float* out; unsigned char* ws; int ph_lo, ph_hi; };

#define XB_TMO      128
#define XB_XCNT(j)  (256  + 64 * (j))
#define XB_XSUB(j)  (1280 + 64 * (j))
#define XB_XGEN(j)  (2304 + 64 * (j))
#define XB_TOP      3328
#define XB_TOPGEN   3392
#define XCD_BAR_WORDS 3456
#define XB_SPIN_CAP (1u << 20)

__device__ __forceinline__ unsigned xb_ld(unsigned* p)              { return __hip_atomic_load(p, __ATOMIC_RELAXED, __HIP_MEMORY_SCOPE_AGENT); }
__device__ __forceinline__ unsigned xb_add(unsigned* p, unsigned v) { return __hip_atomic_fetch_add(p, v, __ATOMIC_RELAXED, __HIP_MEMORY_SCOPE_AGENT); }
__device__ __forceinline__ unsigned xb_xcc_id() { return (unsigned)__builtin_amdgcn_s_getreg((3 << 11) | 20) & 0xFu; }
#define XB_SPIN(cond, bar) do { unsigned _sp = 0; while (cond) { __builtin_amdgcn_s_sleep(1); \
    if ((++_sp & 255u) == 0u) { if (xb_ld(&(bar)[XB_TMO])) break; if (_sp > XB_SPIN_CAP) { atomicAdd(&(bar)[XB_TMO], 1u); break; } } } } while (0)

struct XcdBarrier {
    unsigned* bar; unsigned x;
    volatile LAS unsigned* st;
};

__device__ __forceinline__ XcdBarrier xcd_barrier_post(unsigned* bar, volatile LAS unsigned* st) {
    XcdBarrier b; b.bar = bar; b.x = xb_xcc_id(); b.st = st;
    if (threadIdx.x == 0) (void)xb_add(&bar[XB_XCNT(b.x)], 1u);
    return b;
}
__device__ __forceinline__ void xcd_barrier_complete(unsigned* bar, unsigned x, unsigned& nloc, unsigned& nx) {
    const unsigned G = gridDim.x * gridDim.y * gridDim.z;
    unsigned sum, cnt, mine, sp = 0u;
    for (;;) {
        sum = 0u; cnt = 0u; mine = 0u;
#pragma unroll
        for (unsigned j = 0; j < 16; ++j) { const unsigned c = xb_ld(&bar[XB_XCNT(j)]); sum += c; cnt += (c > 0u) ? 1u : 0u; mine = (j == x) ? c : mine; }
        if (sum == G) break;
        __builtin_amdgcn_s_sleep(1);
        if ((++sp & 255u) == 0u) { if (xb_ld(&bar[XB_TMO])) break; if (sp > XB_SPIN_CAP) { atomicAdd(&bar[XB_TMO], 1u); break; } }
    }
    nloc = mine > 0u ? mine : 1u; nx = cnt > 0u ? cnt : 1u;
}

__device__ __forceinline__ void xcd_barrier(const XcdBarrier& b) {
    asm volatile("s_waitcnt vmcnt(0)" ::: "memory");
    __syncthreads();
    if (threadIdx.x == 0) {
        unsigned* bar = b.bar;
        __builtin_amdgcn_s_waitcnt(0);
        unsigned nloc = b.st[0], nx = b.st[1];
        if (nloc == 0u) { xcd_barrier_complete(bar, b.x, nloc, nx); b.st[0] = nloc; b.st[1] = nx; }
        const unsigned old = xb_add(&bar[XB_XSUB(b.x)], 1u);
        const unsigned gen = old / nloc;
        if (old + 1u == (gen + 1u) * nloc) {
            __builtin_amdgcn_fence(__ATOMIC_RELEASE, "agent");
            asm volatile("s_waitcnt vmcnt(0)" ::: "memory");
            const unsigned og = xb_add(&bar[XB_TOP], 1u);
            const unsigned tg = og / nx;
            if (og + 1u == (tg + 1u) * nx) xb_add(&bar[XB_TOPGEN], 1u);
            else XB_SPIN(xb_ld(&bar[XB_TOPGEN]) == tg, bar);
            __builtin_amdgcn_fence(__ATOMIC_ACQUIRE, "agent");
            xb_add(&bar[XB_XGEN(b.x)], 1u);
            asm volatile("s_waitcnt vmcnt(0)" ::: "memory");
        } else {
            XB_SPIN(xb_ld(&bar[XB_XGEN(b.x)]) == gen, bar);
            __builtin_amdgcn_fence(__ATOMIC_ACQUIRE, "agent");
            asm volatile("s_waitcnt vmcnt(0)" ::: "memory");
        }
    }
    __syncthreads();
}


namespace pg8 {
#define PG8_LAS __attribute__((address_space(3)))
typedef unsigned short bf16_t;
constexpr int BM = 256, BK = 64, HALF = 128, HTB = HALF * BK * 2  , STAGE_BYTES = 8 * HTB, NXCD = 8, WGM = 8;

__host__ __device__ __forceinline__ int lds_byte(int r, int c) { const int st = (r >> 4) * 2 + (c >> 5), rr = r & 15, cc = c & 31, ob = rr * 64 + cc * 2; return st * 1024 + (ob ^ (((ob >> 9) & 1) << 5)); }
__host__ __device__ __forceinline__ void stage_rc(int b, int& R, int& C) { const int st = b / 1024, sb = b % 1024, swz = sb ^ (((sb >> 9) & 1) << 5); R = (st >> 1) * 16 + swz / 64; C = (st & 1) * 32 + (swz % 64) / 2; }
__host__ __device__ __forceinline__ int perm32(int rho) { const int n = rho >> 4, i = rho & 15; return 8 * (i >> 2) + 4 * n + (i & 3); }

struct Unit { int pm, pn, z; };
struct Gemm { const bf16_t* A; const bf16_t* Bt; int M, N, K, lda, ldb; size_t sA, sB; int nz; };

struct StaticOrder {
    int nM, nN, nwg, G, c, nz;
    __host__ __device__ void init(int M, int N, int G_, int c_, int nz_ = 1) { nM = M / BM; nN = N / BM; nwg = nM * nN; G = G_; c = c_; nz = nz_; }
    __host__ __device__ bool next(int i, Unit& u) const {
        const long L0 = (long)i * G + c; if (L0 >= (long)nwg * nz) return false;
        u.z = (int)(L0 / nwg); int wgid = (int)(L0 % nwg); { const int q = nwg / NXCD, r = nwg % NXCD, xcd = wgid % NXCD, off = wgid / NXCD; wgid = (xcd < r ? xcd * (q + 1) : r * (q + 1) + (xcd - r) * q) + off; }
        const int nig = WGM * nN, gid = wgid / nig, fm = gid * WGM, gsz = (nM - fm) < WGM ? (nM - fm) : WGM;
        u.pm = fm + ((wgid % nig) % gsz); u.pn = (wgid % nig) / gsz; return true;
    }
    __device__ __forceinline__ void a_ready(const Unit&) const {}
    __device__ __forceinline__ void done(const Unit&) const {}
};

struct ChainOrder : StaticOrder {
    __host__ __device__ bool next(int i, Unit& u) const { if (!StaticOrder::next(i >> 1, u)) return false; u.z = i & 1; return true; }
};
__device__ __forceinline__ unsigned cvt_pk_bf16(float lo, float hi) { unsigned r; asm volatile("v_cvt_pk_bf16_f32 %0, %1, %2" : "=v"(r) : "v"(lo), "v"(hi)); return r; }

template <class Epi, class Sched, bool ALIGN_EPI = false, bool SP2 = false>
__device__ __forceinline__ void gemm_phase(PG8_LAS unsigned char* lds, const Gemm g, const Sched& S, const Epi& E) {
    const int tid = threadIdx.x, wid = __builtin_amdgcn_readfirstlane(tid >> 6), lane = tid & 63, wr = wid >> 2, wc = wid & 3, fr = lane & 15, fq = lane >> 4;
    const int K = g.K, nt = K / BK;
    unsigned voffA[2], voffB[2];
#pragma unroll
    for (int i = 0; i < 2; ++i) { int R, C; stage_rc(tid * 16 + i * 8192, R, C); const int Rb = Epi::PERM ? ((R & ~31) + perm32(R & 31)) : R;
        voffA[i] = (unsigned)(R * g.lda + C) * 2u; voffB[i] = (unsigned)(Rb * g.ldb + C) * 2u; }
    const size_t kstep = (size_t)(BK * 2);
    const size_t hstepA = (size_t)HALF * g.lda * 2, hstepB = (size_t)HALF * g.ldb * 2;
    const size_t tstepA = 2 * hstepA, tstepB = 2 * hstepB;
    const unsigned ldsw = (unsigned)wid * 1024u;
    const int aoff = lds_byte(wr * 64 + fr, fq * 8), boff = lds_byte(wc * 32 + fr, fq * 8);
#define PG8_SA(b, h) (((b) * 2 + (h)) * HTB)
#define PG8_SB(b, h) ((4 + (b) * 2 + (h)) * HTB)
#define PG8_STAGE(bufoff, gbase, voff) do { _Pragma("unroll") for (int _i = 0; _i < 2; ++_i) \
        __builtin_amdgcn_global_load_lds((const unsigned*)((const char*)(gbase) + (voff)[_i]), (PG8_LAS unsigned*)(lds + (bufoff) + ldsw + _i * 8192), 16, 0, 0); } while (0)
#define PG8_LDA(dst, b, h) do { _Pragma("unroll") for (int m = 0; m < 4; ++m) _Pragma("unroll") for (int k = 0; k < 2; ++k) dst[m][k] = *(const PG8_LAS bf16x8*)(lds + PG8_SA(b, h) + aoff + m * 2048 + k * 1024); } while (0)
#define PG8_LDB(dst, b, h) do { _Pragma("unroll") for (int n = 0; n < 2; ++n) _Pragma("unroll") for (int k = 0; k < 2; ++k) dst[n][k] = *(const PG8_LAS bf16x8*)(lds + PG8_SB(b, h) + boff + n * 2048 + k * 1024); } while (0)
#define PG8_MMA(ai, bj, At, Bt) do { __builtin_amdgcn_s_setprio(1); _Pragma("unroll") for (int m = 0; m < 4; ++m) _Pragma("unroll") for (int n = 0; n < 2; ++n) _Pragma("unroll") for (int k = 0; k < 2; ++k) \
        acc[ai][bj][m][n] = __builtin_amdgcn_mfma_f32_16x16x32_bf16(Bt[n][k], At[m][k], acc[ai][bj][m][n], 0, 0, 0); __builtin_amdgcn_s_setprio(0); } while (0)
#define PG8_WAIT_V(n) asm volatile("s_waitcnt vmcnt(" #n ")" ::: "memory")
#define PG8_WAIT_L(n) asm volatile("s_waitcnt lgkmcnt(" #n ")" ::: "memory")
#define PG8_BAR __builtin_amdgcn_s_barrier()
#define PG8_SCHED __builtin_amdgcn_sched_barrier(0)
    Unit cur, nxt; int ui = 0;
    if (!S.next(0, cur)) return;
    f32x4 acc[2][2][4][2];
#pragma unroll
    for (int a = 0; a < 2; ++a)
#pragma unroll
        for (int b = 0; b < 2; ++b)
#pragma unroll
            for (int m = 0; m < 4; ++m)
#pragma unroll
                for (int n = 0; n < 2; ++n) acc[a][b][m][n] = (f32x4){0.f, 0.f, 0.f, 0.f};
    bf16x8 At[4][2], B0[2][2], B1[2][2];
    const char* cA = (const char*)(g.A + (size_t)cur.z * g.sA) + (size_t)cur.pm * tstepA; const char* cB = (const char*)(g.Bt + (size_t)cur.z * g.sB) + (size_t)cur.pn * tstepB;
    S.a_ready(cur);
    if constexpr (SP2) {
        PG8_STAGE(PG8_SB(0, 0), cB, voffB); PG8_STAGE(PG8_SB(0, 1), cB + hstepB, voffB); PG8_STAGE(PG8_SA(0, 0), cA, voffA); PG8_STAGE(PG8_SA(0, 1), cA + hstepA, voffA);
        if (wr == 1) PG8_BAR;
        PG8_WAIT_V(2); PG8_BAR;
        PG8_STAGE(PG8_SB(1, 0), cB + kstep, voffB); PG8_STAGE(PG8_SA(1, 0), cA + kstep, voffA); PG8_STAGE(PG8_SB(1, 1), cB + hstepB + kstep, voffB);
        PG8_WAIT_V(6); PG8_BAR;
    } else {
        PG8_STAGE(PG8_SB(0, 0), cB, voffB); PG8_STAGE(PG8_SA(0, 0), cA, voffA); PG8_STAGE(PG8_SB(0, 1), cB + hstepB, voffB); PG8_STAGE(PG8_SA(0, 1), cA + hstepA, voffA);
        if (wr == 1) PG8_BAR;
        PG8_WAIT_V(4); PG8_BAR;
        PG8_STAGE(PG8_SB(1, 0), cB + kstep, voffB); PG8_STAGE(PG8_SA(1, 0), cA + kstep, voffA); PG8_STAGE(PG8_SB(1, 1), cB + hstepB + kstep, voffB);
        PG8_WAIT_V(6); PG8_BAR;
    }
    for (;;) {
        const bool has_next = S.next(ui + 1, nxt);
        const char* nA = has_next ? (const char*)(g.A + (size_t)nxt.z * g.sA) + (size_t)nxt.pm * tstepA : cA; const char* nB = has_next ? (const char*)(g.Bt + (size_t)nxt.z * g.sB) + (size_t)nxt.pn * tstepB : cB;
        for (int t = 0; t < nt; t += 2) {
            const bool last = (t == nt - 2);
            const char* a1 = cA + (size_t)(t + 1) * kstep;
            const char* a2 = last ? nA : cA + (size_t)(t + 2) * kstep; const char* b2 = last ? nB : cB + (size_t)(t + 2) * kstep;
            const char* a3 = a2 + kstep; const char* b3 = b2 + kstep;
            if (last && has_next) S.a_ready(nxt);
            if constexpr (SP2) {
            PG8_LDB(B0, 0, 0); PG8_LDB(B1, 0, 1); PG8_SCHED; PG8_LDA(At, 0, 0); PG8_STAGE(PG8_SA(1, 1), a1 + hstepA, voffA);
            PG8_WAIT_V(8); PG8_WAIT_L(0); PG8_BAR; PG8_MMA(0, 0, At, B0); PG8_MMA(0, 1, At, B1); PG8_BAR; PG8_SCHED;
            PG8_LDA(At, 0, 1); PG8_STAGE(PG8_SB(0, 0), b2, voffB); PG8_STAGE(PG8_SB(0, 1), b2 + hstepB, voffB); PG8_STAGE(PG8_SA(0, 0), a2, voffA);
            PG8_WAIT_V(8); PG8_WAIT_L(0); PG8_BAR; PG8_MMA(1, 0, At, B0); PG8_MMA(1, 1, At, B1); PG8_BAR; PG8_SCHED;
            PG8_LDB(B0, 1, 0); PG8_LDB(B1, 1, 1); PG8_SCHED; PG8_LDA(At, 1, 0); PG8_STAGE(PG8_SA(0, 1), a2 + hstepA, voffA);
            PG8_WAIT_V(8); PG8_WAIT_L(0); PG8_BAR; PG8_MMA(0, 0, At, B0); PG8_MMA(0, 1, At, B1); PG8_BAR; PG8_SCHED;
            PG8_LDA(At, 1, 1); PG8_STAGE(PG8_SB(1, 0), b3, voffB); PG8_STAGE(PG8_SB(1, 1), b3 + hstepB, voffB); PG8_STAGE(PG8_SA(1, 0), a3, voffA);
            PG8_WAIT_V(8); PG8_WAIT_L(0); PG8_BAR; PG8_MMA(1, 0, At, B0); PG8_MMA(1, 1, At, B1); PG8_BAR; PG8_SCHED;
            } else {
            PG8_LDB(B0, 0, 0); PG8_SCHED; PG8_LDA(At, 0, 0); PG8_STAGE(PG8_SA(1, 1), a1 + hstepA, voffA);
            PG8_WAIT_L(8); PG8_BAR; PG8_WAIT_L(0); PG8_MMA(0, 0, At, B0); PG8_BAR; PG8_SCHED;
            PG8_LDB(B1, 0, 1); PG8_STAGE(PG8_SB(0, 0), b2, voffB);
            PG8_BAR; PG8_WAIT_L(0); PG8_MMA(0, 1, At, B1); PG8_BAR;
            PG8_LDA(At, 0, 1); PG8_STAGE(PG8_SA(0, 0), a2, voffA);
            PG8_BAR; PG8_WAIT_L(0); PG8_MMA(1, 0, At, B0); PG8_BAR; PG8_SCHED;
            PG8_STAGE(PG8_SB(0, 1), b2 + hstepB, voffB);
            PG8_WAIT_V(6); PG8_BAR; PG8_MMA(1, 1, At, B1); PG8_BAR;
            PG8_LDB(B0, 1, 0); PG8_SCHED; PG8_LDA(At, 1, 0); PG8_STAGE(PG8_SA(0, 1), a2 + hstepA, voffA);
            PG8_WAIT_L(8); PG8_BAR; PG8_WAIT_L(0); PG8_MMA(0, 0, At, B0); PG8_BAR; PG8_SCHED;
            PG8_LDB(B1, 1, 1); PG8_STAGE(PG8_SB(1, 0), b3, voffB);
            PG8_BAR; PG8_WAIT_L(0); PG8_MMA(0, 1, At, B1); PG8_BAR;
            PG8_LDA(At, 1, 1); PG8_STAGE(PG8_SA(1, 0), a3, voffA);
            PG8_BAR; PG8_WAIT_L(0); PG8_MMA(1, 0, At, B0); PG8_BAR; PG8_SCHED;
            PG8_STAGE(PG8_SB(1, 1), b3 + hstepB, voffB);
            PG8_WAIT_V(6); PG8_BAR; PG8_MMA(1, 1, At, B1); PG8_BAR;
            }
        }
        if constexpr (ALIGN_EPI) { if (wr == 0) PG8_BAR; }
        if constexpr (!Epi::AFTER_DRAIN) { E(acc, cur, wr, wc, fr, fq); S.done(cur); }
        if (!has_next) break;
        if (!Epi::CHAIN || nxt.z == 0) {
#pragma unroll
        for (int a = 0; a < 2; ++a)
#pragma unroll
            for (int b = 0; b < 2; ++b)
#pragma unroll
                for (int m = 0; m < 4; ++m)
#pragma unroll
                    for (int n = 0; n < 2; ++n) acc[a][b][m][n] = (f32x4){0.f, 0.f, 0.f, 0.f};
        }
        cur = nxt; cA = nA; cB = nB; ++ui;
        if constexpr (ALIGN_EPI) { if (wr == 1) PG8_BAR; }
    }
    PG8_WAIT_V(0);
    if constexpr (!ALIGN_EPI) { if (wr == 0) PG8_BAR; }
    PG8_BAR;
    if constexpr (Epi::AFTER_DRAIN) { E.fused(acc, cur, wr, wc, fr, fq, lds, wid, lane); S.done(cur); }
#undef PG8_SA
#undef PG8_SB
#undef PG8_STAGE
#undef PG8_LDA
#undef PG8_LDB
#undef PG8_MMA
#undef PG8_WAIT_V
#undef PG8_WAIT_L
#undef PG8_BAR
#undef PG8_SCHED
}
}

typedef f32x4 AccT[2][2][4][2];
DEVI v4u pack8(const f32x4& a, const f32x4& b) { v4u w; w.x = pk2(a[0], a[1]); w.y = pk2(a[2], a[3]); w.z = pk2(b[0], b[1]); w.w = pk2(b[2], b[3]); return w; }
DEVI void unpack8(const v4u& w, float (&f)[8]) { f[0] = bflo(w.x); f[1] = bfhi(w.x); f[2] = bflo(w.y); f[3] = bfhi(w.y); f[4] = bflo(w.z); f[5] = bfhi(w.z); f[6] = bflo(w.w); f[7] = bfhi(w.w); }

struct EpiProj {
    static constexpr bool PERM = true, AFTER_DRAIN = false, CHAIN = false;
    unsigned char* ws; const float* lb_logits;
    template <int TYPE> DEVI void run(const AccT& acc, const pg8::Unit& u, int wr, int wc, int fr, int fq) const {
        const int row0 = u.pm * 256 + wr * 64 + fr;
#pragma unroll
        for (int bj = 0; bj < 2; ++bj) {
            const int col = u.pn * 256 + bj * 128 + wc * 32 + 8 * fq;
            float lb[8];
            if (TYPE == 2) {
#pragma unroll
                for (int j = 0; j < 8; ++j) { const int fc = col - 1024 + j; lb[j] = 1.0f / (1.0f + __expf(lb_logits[512 + fc] - lb_logits[fc])); }
            }
#pragma unroll
            for (int ai = 0; ai < 2; ++ai)
#pragma unroll
                for (int m = 0; m < 4; ++m) {
                    const int row = row0 + ai * 128 + m * 16;
                    f32x4 v0 = acc[ai][bj][m][0], v1 = acc[ai][bj][m][1];
                    if (TYPE == 0) {
                        const int g = col >> 4, h0 = col & 15, b = row >> 12, t = row & 4095, c = t >> 6, j = t & 63;
                        bf16* p = (bf16*)(ws + WS_U5) + ((size_t)(g * 1024 + b * 64 + c) * UK + j * 16 + h0);
                        *(v4u*)p = pack8(v0, v1);
                    } else if (TYPE == 1 || TYPE == 4) {
#pragma unroll
                        for (int j = 0; j < 4; ++j) { v0[j] = silu(v0[j]); v1[j] = silu(v1[j]); }
                        if (TYPE == 1) *(v4u*)((bf16*)(ws + WS_Q) + (size_t)row * 512 + (col - 512)) = pack8(v0, v1);
                        else           *(v4u*)((bf16*)(ws + WS_GS) + (size_t)row * 512 + (col - 2048)) = pack8(v0, v1);
                    } else if (TYPE == 2) {
#pragma unroll
                        for (int j = 0; j < 4; ++j) { v0[j] = __logf(lb[j] + (1.0f - lb[j]) * sigm(v0[j])); v1[j] = __logf(lb[4 + j] + (1.0f - lb[4 + j]) * sigm(v1[j])); }
                        float* p = (float*)(ws + WS_LF) + (size_t)row * 512 + (col - 1024);
                        *(f32x4*)p = v0; *(f32x4*)(p + 4) = v1;
                    } else if (TYPE == 3) {
                        *(v4u*)((bf16*)(ws + WS_VV) + (size_t)row * 512 + (col - 1536)) = pack8(v0, v1);
                    } else {
#pragma unroll
                        for (int j = 0; j < 4; ++j) { v0[j] = sigm(v0[j]); v1[j] = sigm(v1[j]); }
                        if (TYPE == 5) *(v4u*)((bf16*)(ws + WS_GA) + (size_t)row * 1024 + (col - 2560)) = pack8(v0, v1);
                        else           *(v4u*)((bf16*)(ws + WS_GB) + (size_t)row * 1024 + (col - 3584)) = pack8(v0, v1);
                    }
                }
        }
    }
    DEVI void operator()(const AccT& acc, const pg8::Unit& u, int wr, int wc, int fr, int fq) const {
        const int pn = u.pn;
        if (pn < 2) run<0>(acc, u, wr, wc, fr, fq);
        else if (pn < 4) run<1>(acc, u, wr, wc, fr, fq);
        else if (pn < 6) run<2>(acc, u, wr, wc, fr, fq);
        else if (pn < 8) run<3>(acc, u, wr, wc, fr, fq);
        else if (pn < 10) run<4>(acc, u, wr, wc, fr, fq);
        else if (pn < 14) run<5>(acc, u, wr, wc, fr, fq);
        else run<6>(acc, u, wr, wc, fr, fq);
    }
};

struct EpiGlu {
    static constexpr bool PERM = true, AFTER_DRAIN = false, CHAIN = false;
    unsigned char* ws; const float* bias;
    DEVI void operator()(const AccT& acc, const pg8::Unit& u, int wr, int wc, int fr, int fq) const {
        const int row0 = u.pm * 256 + wr * 64 + fr;
#pragma unroll
        for (int bj = 0; bj < 2; ++bj) {
            const int col = u.pn * 256 + bj * 128 + wc * 32 + 8 * fq;
            const f32x4 b0 = *(const f32x4*)(bias + col), b1 = *(const f32x4*)(bias + col + 4);
            v4u yw[2][4];
#pragma unroll
            for (int ai = 0; ai < 2; ++ai)
#pragma unroll
                for (int m = 0; m < 4; ++m) yw[ai][m] = *(const v4u*)((const bf16*)(ws + WS_Y2) + (size_t)(row0 + ai * 128 + m * 16) * 512 + col);
            __builtin_amdgcn_sched_barrier(0);
#pragma unroll
            for (int ai = 0; ai < 2; ++ai)
#pragma unroll
                for (int m = 0; m < 4; ++m) {
                    const int row = row0 + ai * 128 + m * 16;
                    float y[8]; unpack8(yw[ai][m], y);
                    f32x4 v0 = acc[ai][bj][m][0] + b0, v1 = acc[ai][bj][m][1] + b1;
#pragma unroll
                    for (int j = 0; j < 4; ++j) { v0[j] = y[j] * sigm(v0[j]); v1[j] = y[4 + j] * sigm(v1[j]); }
                    *(v4u*)((bf16*)(ws + WS_YAB) + (size_t)row * 1024 + col) = pack8(v0, v1);
                }
            __builtin_amdgcn_sched_barrier(0);
        }
    }
};

struct EpiMerge {
    static constexpr bool PERM = true, AFTER_DRAIN = false, CHAIN = true;
    unsigned char* ws;
    DEVI void operator()(AccT& acc, const pg8::Unit& u, int wr, int wc, int fr, int fq) const {
        const int row0 = u.pm * 256 + wr * 64 + fr;
#pragma unroll
        for (int bj = 0; bj < 2; ++bj) {
            const int col = u.pn * 256 + bj * 128 + wc * 32 + 8 * fq;
#pragma unroll
            for (int ai = 0; ai < 2; ++ai) {
                v4u bw[4], aw[4];
#pragma unroll
                for (int m = 0; m < 4; ++m) { const size_t off = (size_t)(row0 + ai * 128 + m * 16) * 1024 + col;
                    bw[m] = *(const v4u*)((const bf16*)(ws + WS_GB) + off);
                    if (u.z == 0) aw[m] = *(const v4u*)((const bf16*)(ws + WS_GA) + off); }
                __builtin_amdgcn_sched_barrier(0);
#pragma unroll
                for (int m = 0; m < 4; ++m) {
                    const size_t off = (size_t)(row0 + ai * 128 + m * 16) * 1024 + col;
                    float gb[8]; unpack8(bw[m], gb);
                    if (u.z == 0) {
                        float ga[8]; unpack8(aw[m], ga);
#pragma unroll
                        for (int j = 0; j < 4; ++j) { acc[ai][bj][m][0][j] *= ga[j] * __builtin_amdgcn_rcpf(gb[j]); acc[ai][bj][m][1][j] *= ga[4 + j] * __builtin_amdgcn_rcpf(gb[4 + j]); }
                    } else {
                        f32x4 v0 = acc[ai][bj][m][0], v1 = acc[ai][bj][m][1];
#pragma unroll
                        for (int j = 0; j < 4; ++j) { v0[j] *= gb[j]; v1[j] *= gb[4 + j]; }
                        *(v4u*)((bf16*)(ws + WS_MG) + off) = pack8(v0, v1);
                    }
                }
                __builtin_amdgcn_sched_barrier(0);
            }
        }
    }
};

struct EpiOut {
    static constexpr bool PERM = true, AFTER_DRAIN = false, CHAIN = false;
    unsigned char* ws; const float* x;
    DEVI void operator()(const AccT& acc, const pg8::Unit& u, int wr, int wc, int fr, int fq) const {
        const int row0 = u.pm * 256 + wr * 64 + fr;
#pragma unroll
        for (int bj = 0; bj < 2; ++bj) {
            const int col = u.pn * 256 + bj * 128 + wc * 32 + 8 * fq;
#pragma unroll
            for (int ai = 0; ai < 2; ++ai) {
                f32x4 xr[4][2];
#pragma unroll
                for (int m = 0; m < 4; ++m) { const size_t off = (size_t)(row0 + ai * 128 + m * 16) * 1024 + col; xr[m][0] = *(const f32x4*)(x + off); xr[m][1] = *(const f32x4*)(x + off + 4); }
                __builtin_amdgcn_sched_barrier(0);
#pragma unroll
                for (int m = 0; m < 4; ++m) {
                    float* p = (float*)(ws + WS_H1) + (size_t)(row0 + ai * 128 + m * 16) * 1024 + col;
                    *(f32x4*)p = acc[ai][bj][m][0] + ALPHA * xr[m][0]; *(f32x4*)(p + 4) = acc[ai][bj][m][1] + ALPHA * xr[m][1];
                }
                __builtin_amdgcn_sched_barrier(0);
            }
        }
    }
};

struct EpiScores {
    static constexpr bool PERM = true, AFTER_DRAIN = false, CHAIN = false;
    unsigned char* ws;
    DEVI void operator()(const AccT& acc, const pg8::Unit& u, int wr, int wc, int fr, int fq) const {
        const int row0 = u.pm * 256 + wr * 64 + fr;
#pragma unroll
        for (int bj = 0; bj < 2; ++bj) {
            const int col = u.pn * 256 + bj * 128 + wc * 32 + 8 * fq;
#pragma unroll
            for (int ai = 0; ai < 2; ++ai)
#pragma unroll
                for (int m = 0; m < 4; ++m) {
                    const int row = row0 + ai * 128 + m * 16;
                    const f32x4 v0 = acc[ai][bj][m][0], v1 = acc[ai][bj][m][1];
                    v4u w; w.x = pkh2(v0[0], v0[1]); w.y = pkh2(v0[2], v0[3]); w.z = pkh2(v1[0], v1[1]); w.w = pkh2(v1[2], v1[3]);
                    *(v4u*)((unsigned short*)(ws + WS_SC) + (size_t)row * 2048 + col) = w;
                }
        }
    }
};

struct EpiS5Z {
    static constexpr bool PERM = true, AFTER_DRAIN = false, CHAIN = false;
    unsigned char* ws;
    DEVI void operator()(const AccT& acc, const pg8::Unit& u, int wr, int wc, int fr, int fq) const {
        const int row0 = u.pm * 256 + wr * 64 + fr, col = wc * 32 + 8 * fq;
        float* Z = (float*)(ws + WS_Z) + (size_t)u.z * 1024 * 128;
#pragma unroll
        for (int ai = 0; ai < 2; ++ai)
#pragma unroll
            for (int m = 0; m < 4; ++m) {
                const int row = row0 + ai * 128 + m * 16;
                float* p = Z + (size_t)row * 128 + col;
                *(f32x4*)p = acc[ai][0][m][0]; *(f32x4*)(p + 4) = acc[ai][0][m][1];
            }
    }
};
struct EpiS5Y {
    static constexpr bool PERM = true, AFTER_DRAIN = false, CHAIN = false;
    unsigned char* ws;
    DEVI void operator()(const AccT& acc, const pg8::Unit& u, int wr, int wc, int fr, int fq) const {
        const int row0 = u.pm * 256 + wr * 64 + fr;
        bf16* Y2 = (bf16*)(ws + WS_Y2);
#pragma unroll
        for (int bj = 0; bj < 2; ++bj) {
            const int n = u.pn * 256 + bj * 128 + wc * 32 + 8 * fq, i = n >> 4, h0 = n & 15;
#pragma unroll
            for (int ai = 0; ai < 2; ++ai)
#pragma unroll
                for (int m = 0; m < 4; ++m) {
                    const int r = row0 + ai * 128 + m * 16, b = r >> 6, c = r & 63;
                    f32x4 v0 = acc[ai][bj][m][0], v1 = acc[ai][bj][m][1];
#pragma unroll
                    for (int j = 0; j < 4; ++j) { v0[j] = gelu_t(v0[j]); v1[j] = gelu_t(v1[j]); }
                    *(v4u*)(Y2 + ((size_t)b * 4096 + c * 64 + i) * 512 + u.z * 16 + h0) = pack8(v0, v1);
                }
        }
    }
};

#define LDS_WAIT() asm volatile("s_waitcnt lgkmcnt(0)" ::: "memory")

DEVI void transpose_item(const float* W, int K, int N, bf16* WT, LAS float* scr, int item, int lane, int ldo = 0, int koff = 0) {
    if (ldo == 0) ldo = K;
    const int nblk = N / 32, kb = item / nblk, nb = item % nblk, k0 = 64 * kb, n0 = 32 * nb;
#pragma unroll 8
    for (int i = 0; i < 32; ++i) { const int kk = 2 * i + (lane >> 5); scr[kk * 33 + (lane & 31)] = W[(size_t)(k0 + kk) * N + n0 + (lane & 31)]; }
    LDS_WAIT();
    const int c = lane & 7;
#pragma unroll
    for (int j = 0; j < 4; ++j) { const int n = (lane >> 3) + 8 * j; const LAS float* s = scr + (8 * c) * 33 + n;
        v4u o; o.x = pk2(s[0 * 33], s[1 * 33]); o.y = pk2(s[2 * 33], s[3 * 33]); o.z = pk2(s[4 * 33], s[5 * 33]); o.w = pk2(s[6 * 33], s[7 * 33]);
        *(v4u*)(WT + (size_t)(n0 + n) * ldo + koff + k0 + 8 * c) = o; }
    LDS_WAIT();
}

DEVI void cvt_bf16_stream(const float* src, bf16* dst, size_t n8, size_t gtid, size_t gthreads) {
    for (size_t i = gtid; i < n8; i += gthreads) {
        const f32x4 a = *(const f32x4*)(src + i * 8), b = *(const f32x4*)(src + i * 8 + 4);
        *(v4u*)(dst + i * 8) = pack8(a, b);
    }
}

DEVI float clamp_fp8(float x) { return fminf(fmaxf(x, -448.0f), 448.0f); }
DEVI unsigned pk4_fp8(float a, float b, float c, float d) { a = clamp_fp8(a); b = clamp_fp8(b); c = clamp_fp8(c); d = clamp_fp8(d); int w = 0; w = __builtin_amdgcn_cvt_pk_fp8_f32(a, b, w, false); w = __builtin_amdgcn_cvt_pk_fp8_f32(c, d, w, true); return (unsigned)w; }
DEVI void cvt_fp8_stream(const float* src, unsigned char* dst, size_t n16, float scale, size_t gtid, size_t gthreads) {
    for (size_t i = gtid; i < n16; i += gthreads) {
        const f32x4 a = *(const f32x4*)(src + i * 16) * scale, b = *(const f32x4*)(src + i * 16 + 4) * scale, c = *(const f32x4*)(src + i * 16 + 8) * scale, d = *(const f32x4*)(src + i * 16 + 12) * scale;
        v4u o; o.x = pk4_fp8(a[0], a[1], a[2], a[3]); o.y = pk4_fp8(b[0], b[1], b[2], b[3]); o.z = pk4_fp8(c[0], c[1], c[2], c[3]); o.w = pk4_fp8(d[0], d[1], d[2], d[3]);
        *(v4u*)(dst + i * 16) = o;
    }
}

DEVI void cvt_fp8_sliced(const float* src, unsigned char* dst, float scale, size_t gtid, size_t gthreads) {
    for (size_t i = gtid; i < (size_t)PNE * D / 16; i += gthreads) {
        const size_t e = i >> 6; const int cg = (int)(i & 63), j = cg >> 3, within = (cg & 7) * 16;
        const f32x4 a = *(const f32x4*)(src + i * 16) * scale, b = *(const f32x4*)(src + i * 16 + 4) * scale, c = *(const f32x4*)(src + i * 16 + 8) * scale, d = *(const f32x4*)(src + i * 16 + 12) * scale;
        v4u o; o.x = pk4_fp8(a[0], a[1], a[2], a[3]); o.y = pk4_fp8(b[0], b[1], b[2], b[3]); o.z = pk4_fp8(c[0], c[1], c[2], c[3]); o.w = pk4_fp8(d[0], d[1], d[2], d[3]);
        *(v4u*)(dst + ((size_t)j * PNE + e) * 128 + within) = o;
    }
}

DEVI unsigned q4_i8(float a, float b, float c, float d) {
    const int ia = (int)rintf(a), ib = (int)rintf(b), ic = (int)rintf(c), id = (int)rintf(d);
    return (unsigned)(ia & 255) | ((unsigned)(ib & 255) << 8) | ((unsigned)(ic & 255) << 16) | ((unsigned)(id & 255) << 24);
}
DEVI void cvt_i8_rows(const float* src, unsigned char* dst, float* scales, int gw, int ngw, int lane) {
    for (int e = gw; e < PNE; e += ngw) {
        const float* rp = src + (size_t)e * 1024 + lane * 16;
        f32x4 v[4]; float m = 0.f;
#pragma unroll
        for (int q = 0; q < 4; ++q) { v[q] = *(const f32x4*)(rp + 4 * q); m = fmaxf(m, fmaxf(fmaxf(fabsf(v[q][0]), fabsf(v[q][1])), fmaxf(fabsf(v[q][2]), fabsf(v[q][3])))); }
        m = wave_max(m); m = fmaxf(m, 1e-30f);
        const float inv = 127.0f / m;
        v4u o;
#pragma unroll
        for (int q = 0; q < 4; ++q) o[q] = q4_i8(v[q][0] * inv, v[q][1] * inv, v[q][2] * inv, v[q][3] * inv);
        *(v4u*)(dst + ((size_t)(lane >> 3) * PNE + e) * 128 + (lane & 7) * 16) = o;
        if (lane == 0) scales[e] = m * (1.0f / 127.0f);
    }
}

DEVI void phase_prep(const Args& a, LAS unsigned char* lds) {
    const int tid = threadIdx.x, lane = tid & 63, wave = __builtin_amdgcn_readfirstlane(tid >> 6), G = gridDim.x;
    unsigned char* ws = a.ws;
    const size_t gtid = (size_t)blockIdx.x * 512 + tid, gthreads = (size_t)G * 512;
    cvt_bf16_stream(a.in[0], (bf16*)(ws + WS_XB), (size_t)T * D / 8, gtid, gthreads);
#if PEER_FP8
#if PEER_U_INT8
    cvt_i8_rows(a.in[21], ws + WS_PU, (float*)(ws + WS_US), blockIdx.x * 8 + wave, G * 8, lane);
#else
    cvt_fp8_sliced(a.in[21], ws + WS_PU, PU_SCALE, gtid, gthreads);
#endif
    cvt_fp8_sliced(a.in[22], ws + WS_PV, PV_SCALE, gtid, gthreads);
#else
    cvt_bf16_stream(a.in[21], (bf16*)(ws + WS_PU), (size_t)PNE * D / 8, gtid, gthreads);
    cvt_bf16_stream(a.in[22], (bf16*)(ws + WS_PV), (size_t)PNE * D / 8, gtid, gthreads);
#endif
    {
        LAS float* scr = (LAS float*)(lds + wave * 16384);
        const int gw = blockIdx.x * 8 + wave, NGW = G * 8;
        constexpr int I_IN = (1024 / 64) * (INC / 32), I_GLU = (512 / 64) * (512 / 32), I_PA = (512 / 64) * (1024 / 32), I_O = (1024 / 64) * (1024 / 32);
        constexpr int NIT = I_IN + I_GLU + 2 * I_PA + I_O;
        for (int it = gw; it < NIT; it += NGW) {
            int r = it;
            if (r < I_IN) { transpose_item(a.in[1], 1024, INC, (bf16*)(ws + WS_WINT), scr, r, lane); continue; } r -= I_IN;
            if (r < I_GLU) { transpose_item(a.in[10], 512, 512, (bf16*)(ws + WS_WGLUT), scr, r, lane); continue; } r -= I_GLU;
            if (r < I_PA) { transpose_item(a.in[14], 512, 1024, (bf16*)(ws + WS_WPAT), scr, r, lane, 1024, 0); continue; } r -= I_PA;
            if (r < I_PA) { transpose_item(a.in[15], 512, 1024, (bf16*)(ws + WS_WPAT), scr, r, lane, 1024, 512); continue; } r -= I_PA;
            transpose_item(a.in[16], 1024, 1024, (bf16*)(ws + WS_WOT), scr, r, lane);
        }
    }
    __syncthreads();
    {
        LAS float* wq = (LAS float*)lds;
        const float* wpq = a.in[19]; const float* keys = a.in[20];
        const int n = tid & 127, kh = __builtin_amdgcn_readfirstlane(tid >> 7);
        for (int item = blockIdx.x; item < 16 * 32; item += G) {
            const int slot = item >> 5, kt = item & 31;
            __syncthreads();
#pragma unroll
            for (int i = 0; i < 8; ++i) { const int idx = tid + 512 * i, kk = idx >> 7, d = idx & 127; wq[kk * 129 + d] = wpq[(size_t)(kt * 32 + kk) * 2048 + slot * 128 + d]; }
            __syncthreads();
            float acc[8];
#pragma unroll
            for (int kk = 0; kk < 8; ++kk) acc[kk] = 0.f;
            const float* kr = keys + ((size_t)(slot * 128 + n)) * 128;
            for (int d = 0; d < 128; d += 4) {
                const f32x4 kv = *(const f32x4*)(kr + d);
#pragma unroll
                for (int kk = 0; kk < 8; ++kk) { const LAS float* w = wq + (kh * 8 + kk) * 129 + d; acc[kk] += kv[0] * w[0] + kv[1] * w[1] + kv[2] * w[2] + kv[3] * w[3]; }
            }
            v4u o; o.x = pk2(acc[0], acc[1]); o.y = pk2(acc[2], acc[3]); o.z = pk2(acc[4], acc[5]); o.w = pk2(acc[6], acc[7]);
            *(v4u*)((bf16*)(ws + WS_WFT) + (size_t)(slot * 128 + n) * 1024 + kt * 32 + kh * 8) = o;
        }
    }
}

DEVI void s5_tables_item(const Args& a, LAS unsigned char* lds, int item) {
    const int tid = threadIdx.x, g = item >> 3, part = item & 7;
    unsigned char* ws = a.ws;
    LAS float* pwr = (LAS float*)lds;
    LAS float* pwi = pwr + 65 * 64;
    LAS float* Bbr = pwi + 65 * 64;
    LAS float* Bbi = Bbr + 1024;
    LAS float* Cr = Bbi + 1024;
    LAS float* Ci = Cr + 1024;
    LAS float* Kt = Ci + 1024;
    __syncthreads();
    if (tid < 64) {
        const int p = tid;
        const float dt = __expf(a.in[9][g]);
        const float lr = a.in[2][g * 64 + p], li = a.in[3][g * 64 + p];
        const float er = __expf(lr * dt); float sn, cs; sincosf(li * dt, &sn, &cs);
        const float Lr = er * cs, Li = er * sn;
        const float ar = Lr - 1.0f, ai = Li, den = lr * lr + li * li;
        const float cr = (ar * lr + ai * li) / den, ci = (ai * lr - ar * li) / den;
#pragma unroll
        for (int h = 0; h < 16; ++h) { const float br = a.in[4][(g * 64 + p) * 16 + h], bi = a.in[5][(g * 64 + p) * 16 + h];
            Bbr[p * 16 + h] = cr * br - ci * bi; Bbi[p * 16 + h] = cr * bi + ci * br; }
        float xr = 1.0f, xi = 0.0f;
        for (int d = 0; d <= 64; ++d) { pwr[d * 64 + p] = xr; pwi[d * 64 + p] = xi; const float nr = xr * Lr - xi * Li, ni = xr * Li + xi * Lr; xr = nr; xi = ni; }
        if (part == 0) { float* l64 = (float*)(ws + WS_L64) + (g * 64 + p) * 2; l64[0] = pwr[64 * 64 + p]; l64[1] = pwi[64 * 64 + p]; }
    }
    for (int i = tid; i < 1024; i += 512) { Cr[i] = a.in[6][g * 1024 + i]; Ci[i] = a.in[7][g * 1024 + i]; }
    __syncthreads();
    for (int pr = tid; pr < 1024; pr += 512) {
        const int d = pr >> 4, hp = pr & 15;
        float acc[16];
#pragma unroll
        for (int h = 0; h < 16; ++h) acc[h] = 0.f;
        for (int p = 0; p < 64; ++p) {
            const float c_r = Cr[hp * 64 + p], c_i = Ci[hp * 64 + p], w_r = pwr[d * 64 + p], w_i = pwi[d * 64 + p];
            const float cpr = c_r * w_r - c_i * w_i, cpi = c_r * w_i + c_i * w_r;
#pragma unroll
            for (int h = 0; h < 16; ++h) acc[h] += cpr * Bbr[p * 16 + h] - cpi * Bbi[p * 16 + h];
        }
#pragma unroll
        for (int h = 0; h < 16; ++h) Kt[pr * 16 + h] = acc[h];
    }
    __syncthreads();
    bf16* TY = (bf16*)(ws + WS_TY) + (size_t)g * 1024 * UK;
    for (int e = tid; e < 128 * 128; e += 512) {
        const int n = part * 128 + (e >> 7), k0 = (e & 127) * 8, i = n >> 4, hp = n & 15, j = k0 >> 4, h0 = k0 & 15;
        float v[8];
#pragma unroll
        for (int q = 0; q < 8; ++q) v[q] = 0.f;
        if (j <= i) {
            const LAS float* kp = Kt + ((i - j) * 16 + hp) * 16 + h0;
#pragma unroll
            for (int q = 0; q < 8; ++q) v[q] = kp[q];
            if (j == i && hp >= h0 && hp < h0 + 8) v[hp - h0] += a.in[8][g * 16 + hp];
        }
        v4u o; o.x = pk2(v[0], v[1]); o.y = pk2(v[2], v[3]); o.z = pk2(v[4], v[5]); o.w = pk2(v[6], v[7]);
        *(v4u*)(TY + (size_t)n * UK + k0) = o;
    }
    for (int e = tid; e < 128 * 64; e += 512) {
        const int n = part * 128 + (e >> 6), p = e & 63, i = n >> 4, hp = n & 15;
        const float c_r = Cr[hp * 64 + p], c_i = Ci[hp * 64 + p], w_r = pwr[(i + 1) * 64 + p], w_i = pwi[(i + 1) * 64 + p];
        TY[(size_t)n * UK + 1024 + p] = (bf16)f2bf(c_r * w_r - c_i * w_i);
        TY[(size_t)n * UK + 1088 + p] = (bf16)f2bf(-(c_r * w_i + c_i * w_r));
    }
    bf16* WZ = (bf16*)(ws + WS_WZ) + (size_t)g * 256 * 1024;
    for (int e = tid; e < 32 * 128; e += 512) {
        const int n = part * 32 + (e >> 7), k0 = (e & 127) * 8, j = k0 >> 4, h0 = k0 & 15;
        float v[8];
#pragma unroll
        for (int q = 0; q < 8; ++q) v[q] = 0.f;
        if (n < 128) {
            const int p = n & 63; const float w_r = pwr[(63 - j) * 64 + p], w_i = pwi[(63 - j) * 64 + p];
#pragma unroll
            for (int q = 0; q < 8; ++q) { const float b_r = Bbr[p * 16 + h0 + q], b_i = Bbi[p * 16 + h0 + q]; v[q] = (n < 64) ? (w_r * b_r - w_i * b_i) : (w_r * b_i + w_i * b_r); }
        }
        v4u o; o.x = pk2(v[0], v[1]); o.y = pk2(v[2], v[3]); o.z = pk2(v[4], v[5]); o.w = pk2(v[6], v[7]);
        *(v4u*)(WZ + (size_t)n * 1024 + k0) = o;
    }
}

DEVI void s5_scan(const Args& a) {
    unsigned char* ws = a.ws;
    for (int id = blockIdx.x * 512 + threadIdx.x; id < S5G * BATCH * 64; id += gridDim.x * 512) {
        const int p = id & 63, b = (id >> 6) & 15, g = id >> 10;
        const float* l64 = (const float*)(ws + WS_L64) + (g * 64 + p) * 2; const float Lr = l64[0], Li = l64[1];
        const float* zp = (const float*)(ws + WS_Z) + (size_t)(g * 1024 + b * 64) * 128 + p;
        bf16* up = (bf16*)(ws + WS_U5) + (size_t)(g * 1024 + b * 64) * UK + 1024 + p;
        float xr = 0.f, xi = 0.f;
#pragma unroll 8
        for (int c = 0; c < 64; ++c) {
            const float zr = zp[(size_t)c * 128], zi = zp[(size_t)c * 128 + 64];
            up[(size_t)c * UK] = (bf16)f2bf(xr); up[(size_t)c * UK + 64] = (bf16)f2bf(xi);
            const float nr = Lr * xr - Li * xi + zr, ni = Lr * xi + Li * xr + zi; xr = nr; xi = ni;
        }
    }
}

constexpr int HG_QT = 0, HG_KT = 17408, HG_KHT = 34816, HG_VT = 53248, HG_SBT = 71680, HG_P = 106496, HG_EB = 115712, HG_TOT = 116224;
DEVI int crow(int j, int hh) { return (j & 3) + 8 * (j >> 2) + 4 * hh; }
DEVI bf16x8 ldfrag(const LAS unsigned char* base, int row, int pitch, int col) { return *(const LAS bf16x8*)(base + (row * pitch + col) * 2); }

template <bool FULL> DEVI void hgrn_segment(const Args& a, LAS unsigned char* lds, int item) {
    const int tid = threadIdx.x, lane = tid & 63, wave = __builtin_amdgcn_readfirstlane(tid >> 6);
    const int seg = item & 3, h = (item >> 2) & 3, b = item >> 4;
    unsigned char* ws = a.ws;
    const int kcol = tid & 127, qd = tid >> 7, r32 = lane & 31, hh = lane >> 5;
    const int ti = wave >> 2, vi = wave & 3, ski = wave & 3, sv0 = (wave >> 2) * 2;
    const float* LF = (const float*)(ws + WS_LF); const bf16* Q = (const bf16*)(ws + WS_Q); const bf16* VV = (const bf16*)(ws + WS_VV); const bf16* GS = (const bf16*)(ws + WS_GS);
    bf16* YB = (bf16*)(ws + WS_YAB) + 512;
    float* HGS = (float*)(ws + WS_HGS); float* HGD = (float*)(ws + WS_HGD);
    LAS unsigned char* QT = lds + HG_QT; LAS unsigned char* KT = lds + HG_KT; LAS unsigned char* KHT = lds + HG_KHT; LAS unsigned char* VT = lds + HG_VT;
    LAS unsigned char* SBT = lds + HG_SBT; LAS unsigned char* PB = lds + HG_P;
    LAS float* EB = (LAS float*)(lds + HG_EB); LAS float* TOT = (LAS float*)(lds + HG_TOT); LAS float* O = (LAS float*)(lds + HG_QT);
    f32x16 S0, S1;
#pragma unroll
    for (int j = 0; j < 16; ++j) { S0[j] = 0.f; S1[j] = 0.f; }
    float sumlog = 0.f;
    __syncthreads();
    if (FULL) {
        for (int s2 = 0; s2 < seg; ++s2) {
            const int it2 = (b * 4 + h) * 4 + s2;
            const float* dS = HGS + (size_t)it2 * 16384; const float* Dl = HGD + it2 * 128;
#pragma unroll
            for (int j = 0; j < 16; ++j) { const int k = ski * 32 + crow(j, hh); const float d = Dl[k];
                S0[j] = d * S0[j] + dS[k * 128 + sv0 * 32 + r32]; S1[j] = d * S1[j] + dS[k * 128 + (sv0 + 1) * 32 + r32]; }
        }
#pragma unroll
        for (int g4 = 0; g4 < 4; ++g4) { const int k0 = ski * 32 + 8 * g4 + 4 * hh;
            v2u w0, w1; w0.x = pk2(S0[4 * g4], S0[4 * g4 + 1]); w0.y = pk2(S0[4 * g4 + 2], S0[4 * g4 + 3]); w1.x = pk2(S1[4 * g4], S1[4 * g4 + 1]); w1.y = pk2(S1[4 * g4 + 2], S1[4 * g4 + 3]);
            *(LAS v2u*)(SBT + ((sv0 * 32 + r32) * 136 + k0) * 2) = w0; *(LAS v2u*)(SBT + (((sv0 + 1) * 32 + r32) * 136 + k0) * 2) = w1; }
    }
    for (int cc = 0; cc < 16; ++cc) {
        const size_t row0 = (size_t)b * 4096 + (seg * 16 + cc) * 64;
        __syncthreads();
        float l[16], qv[16];
        {
            const size_t g0 = (row0 + qd * 16) * 512 + h * 128 + kcol;
            bf16 vraw[16];
#pragma unroll
            for (int i = 0; i < 16; ++i) { l[i] = LF[g0 + (size_t)i * 512]; vraw[i] = VV[g0 + (size_t)i * 512]; if (FULL) qv[i] = bf2f(Q[g0 + (size_t)i * 512]); }
            v4u w0, w1;
            w0.x = vraw[0] | ((unsigned)vraw[1] << 16); w0.y = vraw[2] | ((unsigned)vraw[3] << 16); w0.z = vraw[4] | ((unsigned)vraw[5] << 16); w0.w = vraw[6] | ((unsigned)vraw[7] << 16);
            w1.x = vraw[8] | ((unsigned)vraw[9] << 16); w1.y = vraw[10] | ((unsigned)vraw[11] << 16); w1.z = vraw[12] | ((unsigned)vraw[13] << 16); w1.w = vraw[14] | ((unsigned)vraw[15] << 16);
            *(LAS v4u*)(VT + (kcol * 72 + qd * 16) * 2) = w0; *(LAS v4u*)(VT + (kcol * 72 + qd * 16 + 8) * 2) = w1;
        }
        float pre[16]; { float run = 0.f;
#pragma unroll
            for (int i = 0; i < 16; ++i) { run += l[i]; pre[i] = run; }
            TOT[qd * 128 + kcol] = run; }
        __syncthreads();
        float off = 0.f, blast = 0.f;
#pragma unroll
        for (int q2 = 0; q2 < 4; ++q2) { const float tv = TOT[q2 * 128 + kcol]; blast += tv; off += (q2 < qd) ? tv : 0.f; }
        if (qd == 0) { EB[kcol] = __expf(blast); sumlog += blast; }
        {
            float kh[16];
#pragma unroll
            for (int i = 0; i < 16; ++i) {
                const float bc = off + pre[i], omf = 1.0f - __expf(l[i]);
                kh[i] = omf * __expf(blast - bc);
                if (FULL) { const int s = qd * 16 + i;
                    *(LAS bf16*)(QT + (s * 136 + kcol) * 2) = (bf16)f2bf(qv[i] * __expf(bc));
                    *(LAS bf16*)(KT + (s * 136 + kcol) * 2) = (bf16)f2bf(omf * __expf(-bc)); }
            }
            v4u w0, w1; w0.x = pk2(kh[0], kh[1]); w0.y = pk2(kh[2], kh[3]); w0.z = pk2(kh[4], kh[5]); w0.w = pk2(kh[6], kh[7]);
            w1.x = pk2(kh[8], kh[9]); w1.y = pk2(kh[10], kh[11]); w1.z = pk2(kh[12], kh[13]); w1.w = pk2(kh[14], kh[15]);
            *(LAS v4u*)(KHT + (kcol * 72 + qd * 16) * 2) = w0; *(LAS v4u*)(KHT + (kcol * 72 + qd * 16 + 8) * 2) = w1;
        }
        __syncthreads();
        f32x16 o;
#pragma unroll
        for (int j = 0; j < 16; ++j) o[j] = 0.f;
        if (FULL) {
            if (wave < 3) {
                const int sti = wave ? 1 : 0, ssi = wave == 2 ? 1 : 0;
                f32x16 sc;
#pragma unroll
                for (int j = 0; j < 16; ++j) sc[j] = 0.f;
#pragma unroll
                for (int ks = 0; ks < 8; ++ks) sc = __builtin_amdgcn_mfma_f32_32x32x16_bf16(ldfrag(QT, sti * 32 + r32, 136, ks * 16 + 8 * hh), ldfrag(KT, ssi * 32 + r32, 136, ks * 16 + 8 * hh), sc, 0, 0, 0);
                const int s = ssi * 32 + r32;
#pragma unroll
                for (int j = 0; j < 16; ++j) { const int t = sti * 32 + crow(j, hh); *(LAS bf16*)(PB + (t * 72 + s) * 2) = (bf16)f2bf(s <= t ? sc[j] : 0.f); }
            }
#pragma unroll
            for (int ks = 0; ks < 8; ++ks) o = __builtin_amdgcn_mfma_f32_32x32x16_bf16(ldfrag(QT, ti * 32 + r32, 136, ks * 16 + 8 * hh), ldfrag(SBT, vi * 32 + r32, 136, ks * 16 + 8 * hh), o, 0, 0, 0);
        }
        {
#pragma unroll
            for (int g4 = 0; g4 < 4; ++g4) { const f32x4 e = *(const LAS f32x4*)(EB + ski * 32 + 8 * g4 + 4 * hh);
#pragma unroll
                for (int q = 0; q < 4; ++q) { S0[4 * g4 + q] *= e[q]; S1[4 * g4 + q] *= e[q]; } }
#pragma unroll
            for (int ks = 0; ks < 4; ++ks) { const bf16x8 af = ldfrag(KHT, ski * 32 + r32, 72, ks * 16 + 8 * hh);
                S0 = __builtin_amdgcn_mfma_f32_32x32x16_bf16(af, ldfrag(VT, sv0 * 32 + r32, 72, ks * 16 + 8 * hh), S0, 0, 0, 0);
                S1 = __builtin_amdgcn_mfma_f32_32x32x16_bf16(af, ldfrag(VT, (sv0 + 1) * 32 + r32, 72, ks * 16 + 8 * hh), S1, 0, 0, 0); }
        }
        if (FULL) {
            __syncthreads();
            if (ti) {
#pragma unroll
                for (int ks = 0; ks < 4; ++ks) o = __builtin_amdgcn_mfma_f32_32x32x16_bf16(ldfrag(PB, ti * 32 + r32, 72, ks * 16 + 8 * hh), ldfrag(VT, vi * 32 + r32, 72, ks * 16 + 8 * hh), o, 0, 0, 0);
            } else {
#pragma unroll
                for (int ks = 0; ks < 2; ++ks) o = __builtin_amdgcn_mfma_f32_32x32x16_bf16(ldfrag(PB, r32, 72, ks * 16 + 8 * hh), ldfrag(VT, vi * 32 + r32, 72, ks * 16 + 8 * hh), o, 0, 0, 0);
            }
#pragma unroll
            for (int g4 = 0; g4 < 4; ++g4) { const int k0 = ski * 32 + 8 * g4 + 4 * hh;
                v2u w0, w1; w0.x = pk2(S0[4 * g4], S0[4 * g4 + 1]); w0.y = pk2(S0[4 * g4 + 2], S0[4 * g4 + 3]); w1.x = pk2(S1[4 * g4], S1[4 * g4 + 1]); w1.y = pk2(S1[4 * g4 + 2], S1[4 * g4 + 3]);
                *(LAS v2u*)(SBT + ((sv0 * 32 + r32) * 136 + k0) * 2) = w0; *(LAS v2u*)(SBT + (((sv0 + 1) * 32 + r32) * 136 + k0) * 2) = w1; }
#pragma unroll
            for (int j = 0; j < 16; ++j) O[(ti * 32 + crow(j, hh)) * 132 + vi * 32 + r32] = o[j];
            __syncthreads();
            {
                const int t = tid >> 3, sg = (tid & 7) * 16;
                float ov[16], ss = 0.f;
#pragma unroll
                for (int i = 0; i < 16; i += 4) { const f32x4 x = *(const LAS f32x4*)(O + t * 132 + sg + i); ov[i] = x[0]; ov[i + 1] = x[1]; ov[i + 2] = x[2]; ov[i + 3] = x[3]; }
#pragma unroll
                for (int i = 0; i < 16; ++i) ss += ov[i] * ov[i];
                ss += __shfl_xor(ss, 1); ss += __shfl_xor(ss, 2); ss += __shfl_xor(ss, 4);
                const float r = rsqrtf(ss * (1.0f / 128.0f) + RMS_EPS);
                const size_t go = (row0 + t) * 512 + h * 128 + sg, yo = (row0 + t) * 1024 + h * 128 + sg;
                const v4u g0 = *(const v4u*)(GS + go), g1 = *(const v4u*)(GS + go + 8);
                float gs0[8], gs1[8]; unpack8(g0, gs0); unpack8(g1, gs1);
                const float* gw = a.in[13] + h * 128 + sg;
#pragma unroll
                for (int i = 0; i < 8; ++i) { ov[i] = ov[i] * r * gw[i] * gs0[i]; ov[8 + i] = ov[8 + i] * r * gw[8 + i] * gs1[i]; }
                v4u w0, w1; w0.x = pk2(ov[0], ov[1]); w0.y = pk2(ov[2], ov[3]); w0.z = pk2(ov[4], ov[5]); w0.w = pk2(ov[6], ov[7]);
                w1.x = pk2(ov[8], ov[9]); w1.y = pk2(ov[10], ov[11]); w1.z = pk2(ov[12], ov[13]); w1.w = pk2(ov[14], ov[15]);
                *(v4u*)(YB + yo) = w0; *(v4u*)(YB + yo + 8) = w1;
            }
        }
    }
    if (!FULL) {
        float* dS = HGS + (size_t)item * 16384;
#pragma unroll
        for (int j = 0; j < 16; ++j) { const int k = ski * 32 + crow(j, hh); dS[k * 128 + sv0 * 32 + r32] = S0[j]; dS[k * 128 + (sv0 + 1) * 32 + r32] = S1[j]; }
        if (qd == 0) HGD[item * 128 + kcol] = __expf(sumlog);
    }
}

template <int NT> DEVI void ln1_rows(const Args& a, int r0, int rstride, int lane) {
    f32x4 v[NT][4];
#pragma unroll
    for (int q = 0; q < NT; ++q) { const float* hr = (const float*)(a.ws + WS_H1) + (size_t)(r0 + q * rstride) * 1024 + lane * 4;
#pragma unroll
        for (int j = 0; j < 4; ++j) v[q][j] = *(const f32x4*)(hr + 256 * j); }
    f32x4 gg[4], bb[4];
#pragma unroll
    for (int j = 0; j < 4; ++j) { gg[j] = *(const f32x4*)(a.in[17] + lane * 4 + 256 * j); bb[j] = *(const f32x4*)(a.in[18] + lane * 4 + 256 * j); }
#pragma unroll
    for (int q = 0; q < NT; ++q) {
        const int row = r0 + q * rstride;
        float s = 0.f;
#pragma unroll
        for (int j = 0; j < 4; ++j) s += (v[q][j][0] + v[q][j][1]) + (v[q][j][2] + v[q][j][3]);
        const float mean = wave_sum(s) * (1.0f / 1024.0f); float qq = 0.f;
#pragma unroll
        for (int j = 0; j < 4; ++j) { v[q][j] = v[q][j] - mean; qq += (v[q][j][0] * v[q][j][0] + v[q][j][1] * v[q][j][1]) + (v[q][j][2] * v[q][j][2] + v[q][j][3] * v[q][j][3]); }
        const float rstd = rsqrtf(wave_sum(qq) * (1.0f / 1024.0f) + LN_EPS);
        bf16* o = (bf16*)(a.ws + WS_X1B) + (size_t)row * 1024 + lane * 4;
        float am = 0.f;
#pragma unroll
        for (int j = 0; j < 4; ++j) {
            const f32x4 y = v[q][j] * rstd * gg[j] + bb[j]; v[q][j] = y;
            am = fmaxf(am, fmaxf(fmaxf(fabsf(y[0]), fabsf(y[1])), fmaxf(fabsf(y[2]), fabsf(y[3]))));
            v2u w; w.x = pk2(y[0], y[1]); w.y = pk2(y[2], y[3]);
            *(v2u*)(o + 256 * j) = w;
        }
#if PEER_U_INT8
        am = fmaxf(wave_max(am), 1e-30f);
        const float inv = 127.0f / am;
        unsigned char* qo = a.ws + WS_X1Q + (size_t)row * 1024 + lane * 4;
#pragma unroll
        for (int j = 0; j < 4; ++j) *(unsigned*)(qo + 256 * j) = q4_i8(v[q][j][0] * inv, v[q][j][1] * inv, v[q][j][2] * inv, v[q][j][3] * inv);
        if (lane == 0) ((float*)(a.ws + WS_XS))[row] = am * (1.0f / 127.0f);
#endif
    }
}

DEVI unsigned umax_(unsigned a, unsigned b) { return a > b ? a : b; }
DEVI unsigned umin_(unsigned a, unsigned b) { return a < b ? a : b; }
DEVI unsigned skey(float x) { const unsigned b = __float_as_uint(x); return b ^ (((int)b >> 31) | 0x80000000u); }
DEVI unsigned hkey(unsigned h) { return h ^ ((h & 0x8000u) ? 0xFFFFu : 0x8000u); }
DEVI float hkey_dec(unsigned k) { const unsigned kk = k >> 16; return h2f((unsigned short)(kk ^ ((kk & 0x8000u) ? 0x8000u : 0xFFFFu))); }
DEVI void topk_block(const Args& a, LAS float* stg, int task, int lane) {
    const int tb = task >> 3, h = task & 7;
    const unsigned short* sc = (const unsigned short*)(a.ws + WS_SC) + (size_t)tb * 64 * 2048 + h * 256;
    unsigned L[2][16];
#pragma unroll
    for (int p = 0; p < 2; ++p) {
#pragma unroll
        for (int i = 0; i < 16; ++i) L[p][i] = 0u;
        for (int sub = 0; sub < 2; ++sub) {
            v4u ld[8];
#pragma unroll
            for (int q = 0; q < 8; ++q) ld[q] = *(const v4u*)(sc + (size_t)(q * 8 + (lane >> 3)) * 2048 + p * 128 + sub * 64 + (lane & 7) * 8);
            __builtin_amdgcn_wave_barrier();
#pragma unroll
            for (int q = 0; q < 8; ++q) *(LAS v4u*)(stg + (q * 8 + (lane >> 3)) * 36 + (lane & 7) * 4) = ld[q];
            LDS_WAIT(); __builtin_amdgcn_wave_barrier();
#pragma unroll
            for (int q = 0; q < 8; ++q) {
                const v4u v = *(const LAS v4u*)(stg + lane * 36 + q * 4);
#pragma unroll
                for (int e = 0; e < 8; ++e) {
                    const unsigned hb = (e & 1) ? (v[e >> 1] >> 16) : (v[e >> 1] & 0xFFFFu);
                    unsigned x = (hkey(hb) << 16) | (unsigned)(sub * 64 + q * 8 + e);
#pragma unroll
                    for (int i = 0; i < 16; ++i) { const unsigned t = umax_(L[p][i], x); x = umin_(L[p][i], x); L[p][i] = t; }
                }
            }
            LDS_WAIT(); __builtin_amdgcn_wave_barrier();
        }
    }
    unsigned C[16];
#pragma unroll
    for (int i = 0; i < 16; ++i) C[i] = 0u;
#pragma unroll
    for (int ia = 0; ia < 16; ++ia) {
        const float va = hkey_dec(L[0][ia]); const unsigned ea = (L[0][ia] & 127u) << 7;
#pragma unroll
        for (int ib = 0; ib < 16; ++ib) {
            if ((ia + 1) * (ib + 1) <= 16) {
                unsigned x = (skey(va + hkey_dec(L[1][ib])) & 0xFFFFC000u) | ea | (L[1][ib] & 127u);
#pragma unroll
                for (int i = 0; i < 16; ++i) { const unsigned t = umax_(C[i], x); x = umin_(C[i], x); C[i] = t; }
            }
        }
    }
    const unsigned short* srow = sc + (size_t)lane * 2048;
    float cv[16]; float mx = -3.0e38f;
#pragma unroll
    for (int i = 0; i < 16; ++i) { const unsigned e = C[i] & 0x3FFFu; cv[i] = h2f(srow[e >> 7]) + h2f(srow[128 + (e & 127u)]); mx = fmaxf(mx, cv[i]); }
    float es = 0.f;
#pragma unroll
    for (int i = 0; i < 16; ++i) { cv[i] = __expf(cv[i] - mx); es += cv[i]; }
    const float inv = 1.0f / es;
    const size_t item = ((size_t)tb * 64 + lane) * 8 + h;
    int* ids = (int*)(a.ws + WS_IDS) + item * 16; float* gts = (float*)(a.ws + WS_GATES) + item * 16;
#pragma unroll
    for (int i = 0; i < 16; i += 4) { *(v4u*)(ids + i) = (v4u){C[i] & 0x3FFFu, C[i + 1] & 0x3FFFu, C[i + 2] & 0x3FFFu, C[i + 3] & 0x3FFFu};
        *(f32x4*)(gts + i) = (f32x4){cv[i] * inv, cv[i + 1] * inv, cv[i + 2] * inv, cv[i + 3] * inv}; }
}

DEVI void cvt16_fp8(const v4u& r, float (&f)[16]) {
#pragma unroll
    for (int w = 0; w < 4; ++w) { const f32x2 lo = __builtin_amdgcn_cvt_pk_f32_fp8((int)r[w], false), hi = __builtin_amdgcn_cvt_pk_f32_fp8((int)r[w], true);
        f[4 * w] = lo[0]; f[4 * w + 1] = lo[1]; f[4 * w + 2] = hi[0]; f[4 * w + 3] = hi[1]; }
}
DEVI int bperm_i(int srclane, int v) { return __builtin_amdgcn_ds_bpermute(srclane << 2, v); }
DEVI void gx_issue(v4u (&row)[16], const unsigned char* tab, int id0, int id1, int g) {
#pragma unroll
    for (int it = 0; it < 16; ++it) { const int e = bperm_i((it * 8 + g) & 63, it < 8 ? id0 : id1); row[it] = *(const v4u*)(tab + (size_t)e * 128); }
}
#if PEER_U_INT8
DEVI void gu_math(const v4u (&row)[16], const v4u& xq, const v4u&, float* pd, int g, int i) {
    int d[16];
#pragma unroll
    for (int it = 0; it < 16; ++it) { int s = 0;
#pragma unroll
        for (int w = 0; w < 4; ++w) s = __builtin_amdgcn_sdot4((int)row[it][w], (int)xq[w], s, false);
        d[it] = s; }
    const bool b2 = i & 4, b1 = i & 2, b0 = i & 1;
    int y[2];
#pragma unroll
    for (int hh = 0; hh < 2; ++hh) {
        int w4[4], w2[2];
#pragma unroll
        for (int q = 0; q < 4; ++q) { const int send = b2 ? d[8 * hh + q] : d[8 * hh + q + 4], keep = b2 ? d[8 * hh + q + 4] : d[8 * hh + q]; w4[q] = keep + __shfl_xor(send, 4); }
#pragma unroll
        for (int q = 0; q < 2; ++q) { const int send = b1 ? w4[q] : w4[q + 2], keep = b1 ? w4[q + 2] : w4[q]; w2[q] = keep + __shfl_xor(send, 2); }
        { const int send = b0 ? w2[0] : w2[1], keep = b0 ? w2[1] : w2[0]; y[hh] = keep + __shfl_xor(send, 1); }
    }
    pd[i * 8 + g] = (float)y[0]; pd[(8 + i) * 8 + g] = (float)y[1];
}
#else
DEVI void gu_math(const v4u (&row)[16], const v4u& x0, const v4u& x1, float* pd, int g, int i) {
    float xs[16]; { float u0[8], u1[8]; unpack8(x0, u0); unpack8(x1, u1);
#pragma unroll
        for (int q = 0; q < 8; ++q) { xs[q] = u0[q]; xs[8 + q] = u1[q]; } }
    f32x2 xp2[8];
#pragma unroll
    for (int q = 0; q < 8; ++q) xp2[q] = (f32x2){xs[2 * q], xs[2 * q + 1]};
    float d[16];
#pragma unroll
    for (int it = 0; it < 16; ++it) { f32x2 sm = {0.f, 0.f};
#pragma unroll
        for (int w = 0; w < 4; ++w) { sm = __builtin_elementwise_fma(__builtin_amdgcn_cvt_pk_f32_fp8((int)row[it][w], false), xp2[2 * w], sm);
                                      sm = __builtin_elementwise_fma(__builtin_amdgcn_cvt_pk_f32_fp8((int)row[it][w], true), xp2[2 * w + 1], sm); }
        d[it] = sm[0] + sm[1];
        if ((it & 3) == 3) __builtin_amdgcn_sched_barrier(0); }
    const bool b2 = i & 4, b1 = i & 2, b0 = i & 1;
    float y[2];
#pragma unroll
    for (int hh = 0; hh < 2; ++hh) {
        float w4[4], w2[2];
#pragma unroll
        for (int q = 0; q < 4; ++q) { const float send = b2 ? d[8 * hh + q] : d[8 * hh + q + 4], keep = b2 ? d[8 * hh + q + 4] : d[8 * hh + q]; w4[q] = keep + __shfl_xor(send, 4); }
#pragma unroll
        for (int q = 0; q < 2; ++q) { const float send = b1 ? w4[q] : w4[q + 2], keep = b1 ? w4[q + 2] : w4[q]; w2[q] = keep + __shfl_xor(send, 2); }
        { const float send = b0 ? w2[0] : w2[1], keep = b0 ? w2[1] : w2[0]; y[hh] = keep + __shfl_xor(send, 1); }
    }
    pd[i * 8 + g] = y[0]; pd[(8 + i) * 8 + g] = y[1];
}
#endif
DEVI void gu_chunk(const Args& a, int j, int chunk, int wave, int lane) {
    unsigned char* ws = a.ws;
    const int g = lane >> 3, i = lane & 7;
    const unsigned char* tab = ws + WS_PU + (size_t)j * PNE * 128 + i * 16;
    float* PD = (float*)(ws + WS_PD) + (size_t)j * T * 128;
    const int* idbase = (const int*)(ws + WS_IDS);
#if PEER_U_INT8
    const unsigned char* xbase = ws + WS_X1Q + j * 128 + i * 16;
#define GU_X1(p) (*(const v4u*)(p))
#else
    const bf16* xbase = (const bf16*)(ws + WS_X1B) + j * 128 + i * 16;
#define GU_X1(p) (*(const v4u*)((p) + 8))
#endif
    const int t0 = chunk * 256 + wave * 32;
    v4u rowA[16], rowB[16];
    int ia0 = idbase[(size_t)t0 * 128 + lane], ia1 = idbase[(size_t)t0 * 128 + 64 + lane];
    int ib0 = idbase[(size_t)(t0 + 1) * 128 + lane], ib1 = idbase[(size_t)(t0 + 1) * 128 + 64 + lane];
    v4u xa0 = *(const v4u*)(xbase + (size_t)t0 * 1024), xa1 = GU_X1(xbase + (size_t)t0 * 1024), xb0, xb1;
    gx_issue(rowA, tab, ia0, ia1, g);
    for (int tt = 0; tt < 32; tt += 2) {
        const int t = t0 + tt; const bool more = tt + 2 < 32;
        if (more) { ia0 = idbase[(size_t)(t + 2) * 128 + lane]; ia1 = idbase[(size_t)(t + 2) * 128 + 64 + lane]; }
        xb0 = *(const v4u*)(xbase + (size_t)(t + 1) * 1024); xb1 = GU_X1(xbase + (size_t)(t + 1) * 1024);
        __builtin_amdgcn_sched_barrier(0);
        gx_issue(rowB, tab, ib0, ib1, g);
        __builtin_amdgcn_sched_barrier(0);
        gu_math(rowA, xa0, xa1, PD + (size_t)t * 128, g, i);
        __builtin_amdgcn_sched_barrier(0);
        if (more) { ib0 = idbase[(size_t)(t + 3) * 128 + lane]; ib1 = idbase[(size_t)(t + 3) * 128 + 64 + lane];
            xa0 = *(const v4u*)(xbase + (size_t)(t + 2) * 1024); xa1 = GU_X1(xbase + (size_t)(t + 2) * 1024); }
        __builtin_amdgcn_sched_barrier(0);
        if (more) gx_issue(rowA, tab, ia0, ia1, g);
        __builtin_amdgcn_sched_barrier(0);
        gu_math(rowB, xb0, xb1, PD + (size_t)(t + 1) * 128, g, i);
        __builtin_amdgcn_sched_barrier(0);
    }
}
DEVI void gv_math(const v4u (&row)[16], float c0, float c1, bf16* op, int g, int i, int lane) {
    const bool b5 = lane & 32, b4 = lane & 16, b3 = lane & 8;
    const int p = (b5 ? 4 : 0) + (b4 ? 2 : 0) + (b3 ? 1 : 0), colA = (p >> 1) * 4 + (p & 1);
    float cf[16];
#pragma unroll
    for (int it = 0; it < 16; ++it) cf[it] = __uint_as_float((unsigned)bperm_i((it * 8 + g) & 63, (int)__float_as_uint(it < 8 ? c0 : c1)));
#pragma unroll
    for (int pass = 0; pass < 2; ++pass) {
        f32x2 acc2[4];
#pragma unroll
        for (int c = 0; c < 4; ++c) acc2[c] = (f32x2){0.f, 0.f};
#pragma unroll
        for (int it = 0; it < 16; ++it) { const f32x2 c2 = {cf[it], cf[it]};
#pragma unroll
            for (int w = 0; w < 4; ++w) { const f32x2 v = pass ? __builtin_amdgcn_cvt_pk_f32_fp8((int)row[it][w], true) : __builtin_amdgcn_cvt_pk_f32_fp8((int)row[it][w], false); acc2[w] = __builtin_elementwise_fma(c2, v, acc2[w]); }
            if ((it & 3) == 3) __builtin_amdgcn_sched_barrier(0);
        }
        float acc[8];
#pragma unroll
        for (int c = 0; c < 4; ++c) { acc[2 * c] = acc2[c][0]; acc[2 * c + 1] = acc2[c][1]; }
        float w4[4], w2[2], y;
#pragma unroll
        for (int q = 0; q < 4; ++q) { const float send = b5 ? acc[q] : acc[q + 4], keep = b5 ? acc[q + 4] : acc[q]; w4[q] = keep + __shfl_xor(send, 32); }
#pragma unroll
        for (int q = 0; q < 2; ++q) { const float send = b4 ? w4[q] : w4[q + 2], keep = b4 ? w4[q + 2] : w4[q]; w2[q] = keep + __shfl_xor(send, 16); }
        { const float send = b3 ? w2[0] : w2[1], keep = b3 ? w2[1] : w2[0]; y = keep + __shfl_xor(send, 8); }
        op[i * 16 + colA + 2 * pass] = (bf16)f2bf(y);
    }
}
DEVI void gv_chunk(const Args& a, int j, int chunk, int wave, int lane) {
    unsigned char* ws = a.ws;
    const int g = lane >> 3, i = lane & 7;
    const unsigned char* tab = ws + WS_PV + (size_t)j * PNE * 128 + i * 16;
    const int* idbase = (const int*)(ws + WS_IDS); const float* cfbase = (const float*)(ws + WS_CF);
    bf16* obase = (bf16*)(ws + WS_OP) + j * 128;
    const int t0 = chunk * 256 + wave * 32;
    v4u rowA[16], rowB[16];
    int ia0 = idbase[(size_t)t0 * 128 + lane], ia1 = idbase[(size_t)t0 * 128 + 64 + lane];
    int ib0 = idbase[(size_t)(t0 + 1) * 128 + lane], ib1 = idbase[(size_t)(t0 + 1) * 128 + 64 + lane];
    float ca0 = cfbase[(size_t)t0 * 128 + lane], ca1 = cfbase[(size_t)t0 * 128 + 64 + lane], cb0, cb1;
    gx_issue(rowA, tab, ia0, ia1, g);
    for (int tt = 0; tt < 32; tt += 2) {
        const int t = t0 + tt; const bool more = tt + 2 < 32;
        if (more) { ia0 = idbase[(size_t)(t + 2) * 128 + lane]; ia1 = idbase[(size_t)(t + 2) * 128 + 64 + lane]; }
        cb0 = cfbase[(size_t)(t + 1) * 128 + lane]; cb1 = cfbase[(size_t)(t + 1) * 128 + 64 + lane];
        __builtin_amdgcn_sched_barrier(0);
        gx_issue(rowB, tab, ib0, ib1, g);
        __builtin_amdgcn_sched_barrier(0);
        gv_math(rowA, ca0, ca1, obase + (size_t)t * 1024, g, i, lane);
        __builtin_amdgcn_sched_barrier(0);
        if (more) { ib0 = idbase[(size_t)(t + 3) * 128 + lane]; ib1 = idbase[(size_t)(t + 3) * 128 + 64 + lane];
            ca0 = cfbase[(size_t)(t + 2) * 128 + lane]; ca1 = cfbase[(size_t)(t + 2) * 128 + 64 + lane]; }
        __builtin_amdgcn_sched_barrier(0);
        if (more) gx_issue(rowA, tab, ia0, ia1, g);
        __builtin_amdgcn_sched_barrier(0);
        gv_math(rowB, cb0, cb1, obase + (size_t)(t + 1) * 1024, g, i, lane);
        __builtin_amdgcn_sched_barrier(0);
    }
}
template <int WHICH> DEVI void sliced_phase(const Args& a, LAS unsigned char* lds, int wave, int lane, int ctr_off = 0) {
    unsigned* ctr = (unsigned*)(a.ws + WS_CTL) + (WHICH ? CW_GV : CW_GU) + ctr_off;
    volatile LAS unsigned* slot = (volatile LAS unsigned*)(lds + LDS_BYTES - 32);
#ifdef SLICE_BY_BLOCK
    const int xcc = (int)(blockIdx.x & 7u);
#else
    const int xcc = (int)(xb_xcc_id() & 7u);
#endif
    for (int pass = 0; pass < 8; ++pass) {
        const int j = (xcc + pass) & 7;
        for (;;) {
            __syncthreads();
            if (threadIdx.x == 0) *slot = __hip_atomic_fetch_add(ctr + 64 * j, 1u, __ATOMIC_RELAXED, __HIP_MEMORY_SCOPE_AGENT);
            __syncthreads();
            const unsigned c = *slot;
            if (c >= (unsigned)(T / 256)) break;
            if (WHICH) gv_chunk(a, j, (int)c, wave, lane); else gu_chunk(a, j, (int)c, wave, lane);
        }
    }
}
DEVI void coef_phase(const Args& a) {
    unsigned char* ws = a.ws;
    const float* PD = (const float*)(ws + WS_PD); const float* gts = (const float*)(ws + WS_GATES); float* CF = (float*)(ws + WS_CF);
    for (size_t i = (size_t)blockIdx.x * 512 + threadIdx.x; i < (size_t)T * 128 / 4; i += (size_t)gridDim.x * 512) {
        f32x4 s = *(const f32x4*)(PD + i * 4);
#pragma unroll
        for (int j = 1; j < 8; ++j) s += *(const f32x4*)(PD + (size_t)j * T * 128 + i * 4);
        const f32x4 gt = *(const f32x4*)(gts + i * 4);
        f32x4 o;
#if PEER_U_INT8
        const v4u ev = *(const v4u*)((const int*)(ws + WS_IDS) + i * 4);
        const float xsc = ((const float*)(ws + WS_XS))[i >> 5];
        const float* us = (const float*)(ws + WS_US);
#pragma unroll
        for (int q = 0; q < 4; ++q) o[q] = gt[q] * gelu_t(s[q] * xsc * us[ev[q]]) * (1.0f / PV_SCALE);
#else
#pragma unroll
        for (int q = 0; q < 4; ++q) o[q] = gt[q] * gelu_t(s[q] * (1.0f / PU_SCALE)) * (1.0f / PV_SCALE);
#endif
        *(f32x4*)(CF + i * 4) = o;
    }
}
template <int NT> DEVI void ln2_tokens(const Args& a, int t0, int tstride, int lane) {
    unsigned char* ws = a.ws;
    v4u xr[NT][2], orr[NT][2];
#pragma unroll
    for (int q = 0; q < NT; ++q) { const size_t o = (size_t)(t0 + q * tstride) * 1024 + lane * 16;
        const bf16* xp = (const bf16*)(ws + WS_X1B) + o; const bf16* ip = (const bf16*)(ws + WS_OP) + o;
        xr[q][0] = *(const v4u*)xp; xr[q][1] = *(const v4u*)(xp + 8); orr[q][0] = *(const v4u*)ip; orr[q][1] = *(const v4u*)(ip + 8); }
    const float* g2 = a.in[23] + lane * 16; const float* b2 = a.in[24] + lane * 16;
    f32x4 gg[4], bb[4];
#pragma unroll
    for (int i = 0; i < 4; ++i) { gg[i] = *(const f32x4*)(g2 + 4 * i); bb[i] = *(const f32x4*)(b2 + 4 * i); }
#pragma unroll
    for (int q = 0; q < NT; ++q) {
        float xf[16], acc[16];
        { float t0a[8], t1a[8]; unpack8(xr[q][0], t0a); unpack8(xr[q][1], t1a);
#pragma unroll
          for (int i = 0; i < 8; ++i) { xf[i] = t0a[i]; xf[8 + i] = t1a[i]; } }
        { float t0a[8], t1a[8]; unpack8(orr[q][0], t0a); unpack8(orr[q][1], t1a);
#pragma unroll
          for (int i = 0; i < 8; ++i) { acc[i] = t0a[i]; acc[8 + i] = t1a[i]; } }
        float s = 0.f;
#pragma unroll
        for (int i = 0; i < 16; ++i) { acc[i] += ALPHA * xf[i]; s += acc[i]; }
        const float mean = wave_sum(s) * (1.0f / 1024.0f); float qq = 0.f;
#pragma unroll
        for (int i = 0; i < 16; ++i) { acc[i] -= mean; qq += acc[i] * acc[i]; }
        const float rstd = rsqrtf(wave_sum(qq) * (1.0f / 1024.0f) + LN_EPS);
        float* op = a.out + (size_t)(t0 + q * tstride) * 1024 + lane * 16;
#pragma unroll
        for (int i = 0; i < 4; ++i) {
            f32x4 y; y[0] = acc[4 * i] * rstd * gg[i][0] + bb[i][0]; y[1] = acc[4 * i + 1] * rstd * gg[i][1] + bb[i][1]; y[2] = acc[4 * i + 2] * rstd * gg[i][2] + bb[i][2]; y[3] = acc[4 * i + 3] * rstd * gg[i][3] + bb[i][3];
            *(f32x4*)(op + 4 * i) = y;
        }
    }
}

enum Phase { PH_PREP = 0, PH_PROJ, PH_S5Z, PH_S5SCAN, PH_S5Y, PH_HGRN, PH_GLU, PH_MERGE, PH_OUT, PH_LN1, PH_SCORES, PH_TOPK, PH_GU, PH_COEF, PH_GV, PH_LN2, PH_COUNT };

template <class Epi> DEVI void run_gemm(LAS unsigned char* lds, const bf16* A, const bf16* Bt, int M, int N, int K, int lda, int ldb, const Epi& E) {
    pg8::Gemm g; g.A = A; g.Bt = Bt; g.M = M; g.N = N; g.K = K; g.lda = lda; g.ldb = ldb; g.sA = 0; g.sB = 0; g.nz = 1;
    pg8::StaticOrder S; S.init(M, N, gridDim.x, blockIdx.x, 1);
    pg8::gemm_phase<Epi, pg8::StaticOrder, true, true>(lds, g, S, E);
}
template <class Epi> DEVI void run_gemm_batched(LAS unsigned char* lds, const bf16* A, const bf16* Bt, int M, int N, int K, int lda, int ldb, size_t sA, size_t sB, int nz, const Epi& E, int cidx = -1) {
    pg8::Gemm g; g.A = A; g.Bt = Bt; g.M = M; g.N = N; g.K = K; g.lda = lda; g.ldb = ldb; g.sA = sA; g.sB = sB; g.nz = nz;
    pg8::StaticOrder S; S.init(M, N, gridDim.x, cidx < 0 ? (int)blockIdx.x : cidx, nz);
    pg8::gemm_phase<Epi, pg8::StaticOrder, true, true>(lds, g, S, E);
}

#ifndef MK_COOP
#define MK_COOP 1
#endif
__global__ void __launch_bounds__(512, 2) mk_fwd(Args a) {
    extern __shared__ __attribute__((aligned(16))) unsigned char smem[];
    LAS unsigned char* lds = (LAS unsigned char*)smem;
    cg::grid_group grid = cg::this_grid();
    const int tid = threadIdx.x, lane = tid & 63, wave = __builtin_amdgcn_readfirstlane(tid >> 6), G = gridDim.x;
    unsigned char* ws = a.ws;
    volatile LAS unsigned* bst = (volatile LAS unsigned*)(lds + LDS_BYTES - 16);
    if (tid < 2) bst[tid] = 0u;
    __syncthreads();
    const XcdBarrier xb = xcd_barrier_post((unsigned*)(ws + WS_CTL), bst);
#ifndef REP_PH
#define REP_PH -1
#endif
#ifndef REP_N
#define REP_N 1
#endif
#define PH_BEGIN(P) if (a.ph_lo <= (P) && (P) < a.ph_hi) { if (a.ph_lo < (P)) { if (MK_COOP && (P) == PH_PROJ) grid.sync(); else xcd_barrier(xb); } for (int rep_ = 0; rep_ < ((P) == REP_PH ? REP_N : 1); ++rep_) {
#define PH_END } }
    PH_BEGIN(PH_PREP) phase_prep(a, lds); for (int it = blockIdx.x; it < S5G * 8; it += G) s5_tables_item(a, lds, it); PH_END
    PH_BEGIN(PH_PROJ) EpiProj E; E.ws = ws; E.lb_logits = a.in[12];
        run_gemm(lds, (const bf16*)(ws + WS_XB), (const bf16*)(ws + WS_WINT), T, INC, 1024, 1024, 1024, E); PH_END
    PH_BEGIN(PH_S5Z)
        for (int it = blockIdx.x; it < 256; it += G) if ((it & 3) != 3) hgrn_segment<false>(a, lds, it);
        __syncthreads();
        EpiS5Z E; E.ws = ws;
        run_gemm_batched(lds, (const bf16*)(ws + WS_U5), (const bf16*)(ws + WS_WZ), 1024, 256, 1024, UK, 1024, (size_t)1024 * UK, (size_t)256 * 1024, S5G, E, G - 1 - (int)blockIdx.x); PH_END
    PH_BEGIN(PH_S5SCAN) s5_scan(a); PH_END
    PH_BEGIN(PH_S5Y) EpiS5Y E; E.ws = ws;
        run_gemm_batched(lds, (const bf16*)(ws + WS_U5), (const bf16*)(ws + WS_TY), 1024, 1024, UK, UK, UK, (size_t)1024 * UK, (size_t)1024 * UK, S5G, E); PH_END
    PH_BEGIN(PH_HGRN) for (int it = blockIdx.x; it < 256; it += G) hgrn_segment<true>(a, lds, it); PH_END
    PH_BEGIN(PH_GLU) EpiGlu E; E.ws = ws; E.bias = a.in[11];
        run_gemm(lds, (const bf16*)(ws + WS_Y2), (const bf16*)(ws + WS_WGLUT), T, 512, 512, 512, 512, E); PH_END
    PH_BEGIN(PH_MERGE) EpiMerge E; E.ws = ws;
        pg8::Gemm g; g.A = (const bf16*)(ws + WS_YAB); g.Bt = (const bf16*)(ws + WS_WPAT); g.M = T; g.N = 1024; g.K = 512; g.lda = 1024; g.ldb = 1024; g.sA = 512; g.sB = 512; g.nz = 2;
        pg8::ChainOrder S; S.init(T, 1024, G, blockIdx.x, 1);
        pg8::gemm_phase<EpiMerge, pg8::ChainOrder, true, true>(lds, g, S, E); PH_END
    PH_BEGIN(PH_OUT) EpiOut E; E.ws = ws; E.x = a.in[0];
        run_gemm(lds, (const bf16*)(ws + WS_MG), (const bf16*)(ws + WS_WOT), T, 1024, 1024, 1024, 1024, E); PH_END
    PH_BEGIN(PH_LN1) for (int r = blockIdx.x * 8 + wave; r < T; r += 8 * G * 4) ln1_rows<4>(a, r, 8 * G, lane); PH_END
    PH_BEGIN(PH_SCORES) EpiScores E; E.ws = ws;
        run_gemm(lds, (const bf16*)(ws + WS_X1B), (const bf16*)(ws + WS_WFT), T, 2048, 1024, 1024, 1024, E); PH_END
    PH_BEGIN(PH_TOPK) LAS float* stg = (LAS float*)(lds + wave * 9216);
        for (int it = blockIdx.x * 8 + wave; it < (T / 64) * PH; it += 8 * G) topk_block(a, stg, it, lane); PH_END
    PH_BEGIN(PH_GU) sliced_phase<0>(a, lds, wave, lane);
#ifdef PROBE_GU2
        sliced_phase<0>(a, lds, wave, lane, 64 * 16);
#endif
    PH_END
    PH_BEGIN(PH_COEF) coef_phase(a); PH_END
    PH_BEGIN(PH_GV) sliced_phase<1>(a, lds, wave, lane);
#ifdef PROBE_GV2
        sliced_phase<1>(a, lds, wave, lane, 64 * 16);
#endif
    PH_END
    PH_BEGIN(PH_LN2) for (int t = blockIdx.x * 8 + wave; t < T; t += 8 * G * 4) ln2_tokens<4>(a, t, 8 * G, lane); PH_END
}

#ifndef MK_ONE_LAUNCH
#define MK_ONE_LAUNCH 1
#endif

extern "C" void kernel_launch(void* const* d_in, const int* in_sizes, int n_in, void* d_out, int out_size, void* d_ws, size_t ws_size, hipStream_t stream) {
    static int grid = 0;
    if (grid == 0) {
        if (n_in != 25 || out_size != T * D || ws_size < WS_END) { fprintf(stderr, "kernel_launch: unexpected problem (n_in %d, out %d, ws %zu)\n", n_in, out_size, ws_size); grid = -1; return; }
        int dev = 0, cus = 0, per_cu = 0;
        if (hipGetDevice(&dev) != hipSuccess || hipDeviceGetAttribute(&cus, hipDeviceAttributeMultiprocessorCount, dev) != hipSuccess) { grid = -1; return; }
        if (hipFuncSetAttribute((const void*)mk_fwd, hipFuncAttributeMaxDynamicSharedMemorySize, LDS_BYTES) != hipSuccess) { fprintf(stderr, "kernel_launch: hipFuncSetAttribute failed\n"); grid = -1; return; }
        if (hipOccupancyMaxActiveBlocksPerMultiprocessor(&per_cu, (const void*)mk_fwd, 512, LDS_BYTES) != hipSuccess || per_cu < 1) { fprintf(stderr, "kernel_launch: occupancy query says %d\n", per_cu); per_cu = 1; }
        (void)hipGetLastError();
        grid = cus;
    }
    if (grid < 0) return;
    Args a{};
    for (int i = 0; i < 25; ++i) a.in[i] = (const float*)d_in[i];
    a.out = (float*)d_out; a.ws = (unsigned char*)d_ws;
#if MK_ONE_LAUNCH
    if (hipMemsetAsync((char*)d_ws + WS_CTL, 0, CTL_WORDS * 4, stream) != hipSuccess) { fprintf(stderr, "kernel_launch: memset of the barrier words failed\n"); return; }
    a.ph_lo = 0; a.ph_hi = PH_COUNT;
#if MK_COOP
    void* kargs[] = {&a};
    hipError_t e = hipLaunchCooperativeKernel((const void*)mk_fwd, dim3(grid), dim3(512), kargs, LDS_BYTES, stream);
    if (e != hipSuccess) fprintf(stderr, "kernel_launch: cooperative launch failed: %s (grid %d)\n", hipGetErrorString(e), grid);
#else
    hipLaunchKernelGGL(mk_fwd, dim3(grid), dim3(512), LDS_BYTES, stream, a);
#endif
#else
    for (int ph = 0; ph < PH_COUNT; ++ph) {
        a.ph_lo = ph; a.ph_hi = ph + 1;
        hipLaunchKernelGGL(mk_fwd, dim3(grid), dim3(512), LDS_BYTES, stream, a);
    }
#endif
}
```

```cpp
#include <hip/hip_runtime.h>
#include <hip/hip_cooperative_groups.h>
#include <cstdio>
#include <cstdint>
namespace cg = cooperative_groups;

#define DEVI __device__ __forceinline__
#define LAS __attribute__((address_space(3)))
typedef unsigned short bf16;
typedef unsigned v4u __attribute__((ext_vector_type(4)));
typedef unsigned v2u __attribute__((ext_vector_type(2)));
typedef float f32x4 __attribute__((ext_vector_type(4)));
typedef float f32x2 __attribute__((ext_vector_type(2)));
typedef short bf16x8 __attribute__((ext_vector_type(8)));
typedef float f32x16 __attribute__((ext_vector_type(16)));

constexpr int D = 1024, BATCH = 16, SEQ = 4096, T = BATCH * SEQ;
constexpr int S5W = 512, S5H = 16, S5G = 32, S5P = 64;
constexpr int HW = 512, HD = 128, HH = 4;
constexpr int PH = 8, PK = 16, PNK = 128, PNE = 16384;
constexpr int INC = 4608;
constexpr float ALPHA = 1.189207115002721f;
constexpr float LN_EPS = 1e-5f, RMS_EPS = 1e-6f;
constexpr int NCH = 64;
constexpr int UK = 1152;

constexpr size_t MiB = 1u << 20;
constexpr size_t WS_XB = 0;
constexpr size_t WS_Y2 = 0;
constexpr size_t WS_YAB = 64 * MiB;
constexpr size_t WS_X1B = 0;
constexpr size_t WS_U5 = 128 * MiB;
constexpr size_t WS_IDS = 128 * MiB;
constexpr size_t WS_GATES = 160 * MiB;
constexpr size_t WS_Q = 200 * MiB;
constexpr size_t WS_LF = 264 * MiB;
constexpr size_t WS_MG = 264 * MiB;
constexpr size_t WS_VV = 392 * MiB;
constexpr size_t WS_GS = 456 * MiB;
constexpr size_t WS_GA = 520 * MiB;
constexpr size_t WS_GB = 648 * MiB;
constexpr size_t WS_H1 = 392 * MiB;
constexpr size_t WS_SC = 264 * MiB;
constexpr size_t WS_PD = 264 * MiB;
constexpr size_t WS_OP = 264 * MiB;
constexpr size_t WS_CF = 520 * MiB;
constexpr size_t WS_WINT = 776 * MiB;
constexpr size_t WS_WGLUT = 785 * MiB;
constexpr size_t WS_WPAT = 786 * MiB;
constexpr size_t WS_WOT = 788 * MiB;
constexpr size_t WS_WFT = 790 * MiB;
constexpr size_t WS_WZ = 794 * MiB;
constexpr size_t WS_TY = 810 * MiB;
constexpr size_t WS_PU = 882 * MiB;
constexpr size_t WS_PV = 914 * MiB;
constexpr size_t WS_Z = 946 * MiB;
constexpr size_t WS_L64 = 962 * MiB;
constexpr size_t WS_HGS = 963 * MiB;
constexpr size_t WS_HGD = 979 * MiB;
constexpr size_t WS_US = 979 * MiB + 256 * 1024;
constexpr size_t WS_XS = 979 * MiB + 512 * 1024;
constexpr size_t WS_X1Q = 192 * MiB;
constexpr size_t WS_CTL = 980 * MiB;
constexpr size_t WS_END = 981 * MiB;

#ifndef PEER_FP8
#define PEER_FP8 1
#endif
constexpr float PU_SCALE = 256.0f, PV_SCALE = 16.0f;
#ifndef PEER_U_INT8
#define PEER_U_INT8 1
#endif
constexpr int CTL_WORDS = 8192;
constexpr int CW_GU = 4096, CW_GV = 4096 + 64 * 8;
constexpr int LDS_BYTES = 147456;

DEVI unsigned f2bf(float f) { unsigned u = __float_as_uint(f); return (u + 0x7fffu + ((u >> 16) & 1u)) >> 16; }
DEVI unsigned pk2(float lo, float hi) { return f2bf(lo) | (f2bf(hi) << 16); }
typedef _Float16 h16x2 __attribute__((ext_vector_type(2)));
DEVI unsigned pkh2(float a, float b) { const h16x2 v = {(_Float16)a, (_Float16)b}; return __builtin_bit_cast(unsigned, v); }
DEVI float h2f(unsigned short b) { return (float)__builtin_bit_cast(_Float16, b); }
DEVI float bflo(unsigned w) { return __uint_as_float(w << 16); }
DEVI float bfhi(unsigned w) { return __uint_as_float(w & 0xffff0000u); }
DEVI float bf2f(bf16 b) { return __uint_as_float(((unsigned)b) << 16); }
DEVI float sigm(float x) { return __builtin_amdgcn_rcpf(1.0f + __builtin_amdgcn_exp2f(-1.4426950408889634f * x)); }
DEVI float silu(float x) { return x * sigm(x); }
DEVI float gelu_t(float x) { return x * sigm(1.5957691216057308f * (x + 0.044715f * x * x * x)); }
DEVI float wave_sum(float v) {
#pragma unroll
    for (int o = 1; o < 64; o <<= 1) v += __shfl_xor(v, o);
    return v;
}
DEVI float wave_max(float v) {
#pragma unroll
    for (int o = 1; o < 64; o <<= 1) v = fmaxf(v, __shfl_xor(v, o));
    return v;
}

struct Args { const float* in[25]; float* out; unsigned char* ws; int ph_lo, ph_hi; };

#define XB_TMO      128
#define XB_XCNT(j)  (256  + 64 * (j))
#define XB_XSUB(j)  (1280 + 64 * (j))
#define XB_XGEN(j)  (2304 + 64 * (j))
#define XB_TOP      3328
#define XB_TOPGEN   3392
#define XCD_BAR_WORDS 3456
#define XB_SPIN_CAP (1u << 20)

__device__ __forceinline__ unsigned xb_ld(unsigned* p)              { return __hip_atomic_load(p, __ATOMIC_RELAXED, __HIP_MEMORY_SCOPE_AGENT); }
__device__ __forceinline__ unsigned xb_add(unsigned* p, unsigned v) { return __hip_atomic_fetch_add(p, v, __ATOMIC_RELAXED, __HIP_MEMORY_SCOPE_AGENT); }
__device__ __forceinline__ unsigned xb_xcc_id() { return (unsigned)__builtin_amdgcn_s_getreg((3 << 11) | 20) & 0xFu; }
#define XB_SPIN(cond, bar) do { unsigned _sp = 0; while (cond) { __builtin_amdgcn_s_sleep(1); \
    if ((++_sp & 255u) == 0u) { if (xb_ld(&(bar)[XB_TMO])) break; if (_sp > XB_SPIN_CAP) { atomicAdd(&(bar)[XB_TMO], 1u); break; } } } } while (0)

struct XcdBarrier {
    unsigned* bar; unsigned x;
    volatile LAS unsigned* st;
};

__device__ __forceinline__ XcdBarrier xcd_barrier_post(unsigned* bar, volatile LAS unsigned* st) {
    XcdBarrier b; b.bar = bar; b.x = xb_xcc_id(); b.st = st;
    if (threadIdx.x == 0) (void)xb_add(&bar[XB_XCNT(b.x)], 1u);
    return b;
}
__device__ __forceinline__ void xcd_barrier_complete(unsigned* bar, unsigned x, unsigned& nloc, unsigned& nx) {
    const unsigned G = gridDim.x * gridDim.y * gridDim.z;
    unsigned sum, cnt, mine, sp = 0u;
    for (;;) {
        sum = 0u; cnt = 0u; mine = 0u;
#pragma unroll
        for (unsigned j = 0; j < 16; ++j) { const unsigned c = xb_ld(&bar[XB_XCNT(j)]); sum += c; cnt += (c > 0u) ? 1u : 0u; mine = (j == x) ? c : mine; }
        if (sum == G) break;
        __builtin_amdgcn_s_sleep(1);
        if ((++sp & 255u) == 0u) { if (xb_ld(&bar[XB_TMO])) break; if (sp > XB_SPIN_CAP) { atomicAdd(&bar[XB_TMO], 1u); break; } }
    }
    nloc = mine > 0u ? mine : 1u; nx = cnt > 0u ? cnt : 1u;
}

__device__ __forceinline__ void xcd_barrier(const XcdBarrier& b) {
    asm volatile("s_waitcnt vmcnt(0)" ::: "memory");
    __syncthreads();
    if (threadIdx.x == 0) {
        unsigned* bar = b.bar;
        __builtin_amdgcn_s_waitcnt(0);
        unsigned nloc = b.st[0], nx = b.st[1];
        if (nloc == 0u) { xcd_barrier_complete(bar, b.x, nloc, nx); b.st[0] = nloc; b.st[1] = nx; }
        const unsigned old = xb_add(&bar[XB_XSUB(b.x)], 1u);
        const unsigned gen = old / nloc;
        if (old + 1u == (gen + 1u) * nloc) {
            __builtin_amdgcn_fence(__ATOMIC_RELEASE, "agent");
            asm volatile("s_waitcnt vmcnt(0)" ::: "memory");
            const unsigned og = xb_add(&bar[XB_TOP], 1u);
            const unsigned tg = og / nx;
            if (og + 1u == (tg + 1u) * nx) xb_add(&bar[XB_TOPGEN], 1u);
            else XB_SPIN(xb_ld(&bar[XB_TOPGEN]) == tg, bar);
            __builtin_amdgcn_fence(__ATOMIC_ACQUIRE, "agent");
            xb_add(&bar[XB_XGEN(b.x)], 1u);
            asm volatile("s_waitcnt vmcnt(0)" ::: "memory");
        } else {
            XB_SPIN(xb_ld(&bar[XB_XGEN(b.x)]) == gen, bar);
            __builtin_amdgcn_fence(__ATOMIC_ACQUIRE, "agent");
            asm volatile("s_waitcnt vmcnt(0)" ::: "memory");
        }
    }
    __syncthreads();
}


namespace pg8 {
#define PG8_LAS __attribute__((address_space(3)))
typedef unsigned short bf16_t;
constexpr int BM = 256, BK = 64, HALF = 128, HTB = HALF * BK * 2  , STAGE_BYTES = 8 * HTB, NXCD = 8, WGM = 8;

__host__ __device__ __forceinline__ int lds_byte(int r, int c) { const int st = (r >> 4) * 2 + (c >> 5), rr = r & 15, cc = c & 31, ob = rr * 64 + cc * 2; return st * 1024 + (ob ^ (((ob >> 9) & 1) << 5)); }
__host__ __device__ __forceinline__ void stage_rc(int b, int& R, int& C) { const int st = b / 1024, sb = b % 1024, swz = sb ^ (((sb >> 9) & 1) << 5); R = (st >> 1) * 16 + swz / 64; C = (st & 1) * 32 + (swz % 64) / 2; }
__host__ __device__ __forceinline__ int perm32(int rho) { const int n = rho >> 4, i = rho & 15; return 8 * (i >> 2) + 4 * n + (i & 3); }

struct Unit { int pm, pn, z; };
struct Gemm { const bf16_t* A; const bf16_t* Bt; int M, N, K, lda, ldb; size_t sA, sB; int nz; };

struct StaticOrder {
    int nM, nN, nwg, G, c, nz;
    __host__ __device__ void init(int M, int N, int G_, int c_, int nz_ = 1) { nM = M / BM; nN = N / BM; nwg = nM * nN; G = G_; c = c_; nz = nz_; }
    __host__ __device__ bool next(int i, Unit& u) const {
        const long L0 = (long)i * G + c; if (L0 >= (long)nwg * nz) return false;
        u.z = (int)(L0 / nwg); int wgid = (int)(L0 % nwg); { const int q = nwg / NXCD, r = nwg % NXCD, xcd = wgid % NXCD, off = wgid / NXCD; wgid = (xcd < r ? xcd * (q + 1) : r * (q + 1) + (xcd - r) * q) + off; }
        const int nig = WGM * nN, gid = wgid / nig, fm = gid * WGM, gsz = (nM - fm) < WGM ? (nM - fm) : WGM;
        u.pm = fm + ((wgid % nig) % gsz); u.pn = (wgid % nig) / gsz; return true;
    }
    __device__ __forceinline__ void a_ready(const Unit&) const {}
    __device__ __forceinline__ void done(const Unit&) const {}
};

struct ChainOrder : StaticOrder {
    __host__ __device__ bool next(int i, Unit& u) const { if (!StaticOrder::next(i >> 1, u)) return false; u.z = i & 1; return true; }
};
__device__ __forceinline__ unsigned cvt_pk_bf16(float lo, float hi) { unsigned r; asm volatile("v_cvt_pk_bf16_f32 %0, %1, %2" : "=v"(r) : "v"(lo), "v"(hi)); return r; }

template <class Epi, class Sched, bool ALIGN_EPI = false, bool SP2 = false>
__device__ __forceinline__ void gemm_phase(PG8_LAS unsigned char* lds, const Gemm g, const Sched& S, const Epi& E) {
    const int tid = threadIdx.x, wid = __builtin_amdgcn_readfirstlane(tid >> 6), lane = tid & 63, wr = wid >> 2, wc = wid & 3, fr = lane & 15, fq = lane >> 4;
    const int K = g.K, nt = K / BK;
    unsigned voffA[2], voffB[2];
#pragma unroll
    for (int i = 0; i < 2; ++i) { int R, C; stage_rc(tid * 16 + i * 8192, R, C); const int Rb = Epi::PERM ? ((R & ~31) + perm32(R & 31)) : R;
        voffA[i] = (unsigned)(R * g.lda + C) * 2u; voffB[i] = (unsigned)(Rb * g.ldb + C) * 2u; }
    const size_t kstep = (size_t)(BK * 2);
    const size_t hstepA = (size_t)HALF * g.lda * 2, hstepB = (size_t)HALF * g.ldb * 2;
    const size_t tstepA = 2 * hstepA, tstepB = 2 * hstepB;
    const unsigned ldsw = (unsigned)wid * 1024u;
    const int aoff = lds_byte(wr * 64 + fr, fq * 8), boff = lds_byte(wc * 32 + fr, fq * 8);
#define PG8_SA(b, h) (((b) * 2 + (h)) * HTB)
#define PG8_SB(b, h) ((4 + (b) * 2 + (h)) * HTB)
#define PG8_STAGE(bufoff, gbase, voff) do { _Pragma("unroll") for (int _i = 0; _i < 2; ++_i) \
        __builtin_amdgcn_global_load_lds((const unsigned*)((const char*)(gbase) + (voff)[_i]), (PG8_LAS unsigned*)(lds + (bufoff) + ldsw + _i * 8192), 16, 0, 0); } while (0)
#define PG8_LDA(dst, b, h) do { _Pragma("unroll") for (int m = 0; m < 4; ++m) _Pragma("unroll") for (int k = 0; k < 2; ++k) dst[m][k] = *(const PG8_LAS bf16x8*)(lds + PG8_SA(b, h) + aoff + m * 2048 + k * 1024); } while (0)
#define PG8_LDB(dst, b, h) do { _Pragma("unroll") for (int n = 0; n < 2; ++n) _Pragma("unroll") for (int k = 0; k < 2; ++k) dst[n][k] = *(const PG8_LAS bf16x8*)(lds + PG8_SB(b, h) + boff + n * 2048 + k * 1024); } while (0)
#define PG8_MMA(ai, bj, At, Bt) do { __builtin_amdgcn_s_setprio(1); _Pragma("unroll") for (int m = 0; m < 4; ++m) _Pragma("unroll") for (int n = 0; n < 2; ++n) _Pragma("unroll") for (int k = 0; k < 2; ++k) \
        acc[ai][bj][m][n] = __builtin_amdgcn_mfma_f32_16x16x32_bf16(Bt[n][k], At[m][k], acc[ai][bj][m][n], 0, 0, 0); __builtin_amdgcn_s_setprio(0); } while (0)
#define PG8_WAIT_V(n) asm volatile("s_waitcnt vmcnt(" #n ")" ::: "memory")
#define PG8_WAIT_L(n) asm volatile("s_waitcnt lgkmcnt(" #n ")" ::: "memory")
#define PG8_BAR __builtin_amdgcn_s_barrier()
#define PG8_SCHED __builtin_amdgcn_sched_barrier(0)
    Unit cur, nxt; int ui = 0;
    if (!S.next(0, cur)) return;
    f32x4 acc[2][2][4][2];
#pragma unroll
    for (int a = 0; a < 2; ++a)
#pragma unroll
        for (int b = 0; b < 2; ++b)
#pragma unroll
            for (int m = 0; m < 4; ++m)
#pragma unroll
                for (int n = 0; n < 2; ++n) acc[a][b][m][n] = (f32x4){0.f, 0.f, 0.f, 0.f};
    bf16x8 At[4][2], B0[2][2], B1[2][2];
    const char* cA = (const char*)(g.A + (size_t)cur.z * g.sA) + (size_t)cur.pm * tstepA; const char* cB = (const char*)(g.Bt + (size_t)cur.z * g.sB) + (size_t)cur.pn * tstepB;
    S.a_ready(cur);
    if constexpr (SP2) {
        PG8_STAGE(PG8_SB(0, 0), cB, voffB); PG8_STAGE(PG8_SB(0, 1), cB + hstepB, voffB); PG8_STAGE(PG8_SA(0, 0), cA, voffA); PG8_STAGE(PG8_SA(0, 1), cA + hstepA, voffA);
        if (wr == 1) PG8_BAR;
        PG8_WAIT_V(2); PG8_BAR;
        PG8_STAGE(PG8_SB(1, 0), cB + kstep, voffB); PG8_STAGE(PG8_SA(1, 0), cA + kstep, voffA); PG8_STAGE(PG8_SB(1, 1), cB + hstepB + kstep, voffB);
        PG8_WAIT_V(6); PG8_BAR;
    } else {
        PG8_STAGE(PG8_SB(0, 0), cB, voffB); PG8_STAGE(PG8_SA(0, 0), cA, voffA); PG8_STAGE(PG8_SB(0, 1), cB + hstepB, voffB); PG8_STAGE(PG8_SA(0, 1), cA + hstepA, voffA);
        if (wr == 1) PG8_BAR;
        PG8_WAIT_V(4); PG8_BAR;
        PG8_STAGE(PG8_SB(1, 0), cB + kstep, voffB); PG8_STAGE(PG8_SA(1, 0), cA + kstep, voffA); PG8_STAGE(PG8_SB(1, 1), cB + hstepB + kstep, voffB);
        PG8_WAIT_V(6); PG8_BAR;
    }
    for (;;) {
        const bool has_next = S.next(ui + 1, nxt);
        const char* nA = has_next ? (const char*)(g.A + (size_t)nxt.z * g.sA) + (size_t)nxt.pm * tstepA : cA; const char* nB = has_next ? (const char*)(g.Bt + (size_t)nxt.z * g.sB) + (size_t)nxt.pn * tstepB : cB;
        for (int t = 0; t < nt; t += 2) {
            const bool last = (t == nt - 2);
            const char* a1 = cA + (size_t)(t + 1) * kstep;
            const char* a2 = last ? nA : cA + (size_t)(t + 2) * kstep; const char* b2 = last ? nB : cB + (size_t)(t + 2) * kstep;
            const char* a3 = a2 + kstep; const char* b3 = b2 + kstep;
            if (last && has_next) S.a_ready(nxt);
            if constexpr (SP2) {
            PG8_LDB(B0, 0, 0); PG8_LDB(B1, 0, 1); PG8_SCHED; PG8_LDA(At, 0, 0); PG8_STAGE(PG8_SA(1, 1), a1 + hstepA, voffA);
            PG8_WAIT_V(8); PG8_WAIT_L(0); PG8_BAR; PG8_MMA(0, 0, At, B0); PG8_MMA(0, 1, At, B1); PG8_BAR; PG8_SCHED;
            PG8_LDA(At, 0, 1); PG8_STAGE(PG8_SB(0, 0), b2, voffB); PG8_STAGE(PG8_SB(0, 1), b2 + hstepB, voffB); PG8_STAGE(PG8_SA(0, 0), a2, voffA);
            PG8_WAIT_V(8); PG8_WAIT_L(0); PG8_BAR; PG8_MMA(1, 0, At, B0); PG8_MMA(1, 1, At, B1); PG8_BAR; PG8_SCHED;
            PG8_LDB(B0, 1, 0); PG8_LDB(B1, 1, 1); PG8_SCHED; PG8_LDA(At, 1, 0); PG8_STAGE(PG8_SA(0, 1), a2 + hstepA, voffA);
            PG8_WAIT_V(8); PG8_WAIT_L(0); PG8_BAR; PG8_MMA(0, 0, At, B0); PG8_MMA(0, 1, At, B1); PG8_BAR; PG8_SCHED;
            PG8_LDA(At, 1, 1); PG8_STAGE(PG8_SB(1, 0), b3, voffB); PG8_STAGE(PG8_SB(1, 1), b3 + hstepB, voffB); PG8_STAGE(PG8_SA(1, 0), a3, voffA);
            PG8_WAIT_V(8); PG8_WAIT_L(0); PG8_BAR; PG8_MMA(1, 0, At, B0); PG8_MMA(1, 1, At, B1); PG8_BAR; PG8_SCHED;
            } else {
            PG8_LDB(B0, 0, 0); PG8_SCHED; PG8_LDA(At, 0, 0); PG8_STAGE(PG8_SA(1, 1), a1 + hstepA, voffA);
            PG8_WAIT_L(8); PG8_BAR; PG8_WAIT_L(0); PG8_MMA(0, 0, At, B0); PG8_BAR; PG8_SCHED;
            PG8_LDB(B1, 0, 1); PG8_STAGE(PG8_SB(0, 0), b2, voffB);
            PG8_BAR; PG8_WAIT_L(0); PG8_MMA(0, 1, At, B1); PG8_BAR;
            PG8_LDA(At, 0, 1); PG8_STAGE(PG8_SA(0, 0), a2, voffA);
            PG8_BAR; PG8_WAIT_L(0); PG8_MMA(1, 0, At, B0); PG8_BAR; PG8_SCHED;
            PG8_STAGE(PG8_SB(0, 1), b2 + hstepB, voffB);
            PG8_WAIT_V(6); PG8_BAR; PG8_MMA(1, 1, At, B1); PG8_BAR;
            PG8_LDB(B0, 1, 0); PG8_SCHED; PG8_LDA(At, 1, 0); PG8_STAGE(PG8_SA(0, 1), a2 + hstepA, voffA);
            PG8_WAIT_L(8); PG8_BAR; PG8_WAIT_L(0); PG8_MMA(0, 0, At, B0); PG8_BAR; PG8_SCHED;
            PG8_LDB(B1, 1, 1); PG8_STAGE(PG8_SB(1, 0), b3, voffB);
            PG8_BAR; PG8_WAIT_L(0); PG8_MMA(0, 1, At, B1); PG8_BAR;
            PG8_LDA(At, 1, 1); PG8_STAGE(PG8_SA(1, 0), a3, voffA);
            PG8_BAR; PG8_WAIT_L(0); PG8_MMA(1, 0, At, B0); PG8_BAR; PG8_SCHED;
            PG8_STAGE(PG8_SB(1, 1), b3 + hstepB, voffB);
            PG8_WAIT_V(6); PG8_BAR; PG8_MMA(1, 1, At, B1); PG8_BAR;
            }
        }
        if constexpr (ALIGN_EPI) { if (wr == 0) PG8_BAR; }
        if constexpr (!Epi::AFTER_DRAIN) { E(acc, cur, wr, wc, fr, fq); S.done(cur); }
        if (!has_next) break;
        if (!Epi::CHAIN || nxt.z == 0) {
#pragma unroll
        for (int a = 0; a < 2; ++a)
#pragma unroll
            for (int b = 0; b < 2; ++b)
#pragma unroll
                for (int m = 0; m < 4; ++m)
#pragma unroll
                    for (int n = 0; n < 2; ++n) acc[a][b][m][n] = (f32x4){0.f, 0.f, 0.f, 0.f};
        }
        cur = nxt; cA = nA; cB = nB; ++ui;
        if constexpr (ALIGN_EPI) { if (wr == 1) PG8_BAR; }
    }
    PG8_WAIT_V(0);
    if constexpr (!ALIGN_EPI) { if (wr == 0) PG8_BAR; }
    PG8_BAR;
    if constexpr (Epi::AFTER_DRAIN) { E.fused(acc, cur, wr, wc, fr, fq, lds, wid, lane); S.done(cur); }
#undef PG8_SA
#undef PG8_SB
#undef PG8_STAGE
#undef PG8_LDA
#undef PG8_LDB
#undef PG8_MMA
#undef PG8_WAIT_V
#undef PG8_WAIT_L
#undef PG8_BAR
#undef PG8_SCHED
}
}

typedef f32x4 AccT[2][2][4][2];
DEVI v4u pack8(const f32x4& a, const f32x4& b) { v4u w; w.x = pk2(a[0], a[1]); w.y = pk2(a[2], a[3]); w.z = pk2(b[0], b[1]); w.w = pk2(b[2], b[3]); return w; }
DEVI void unpack8(const v4u& w, float (&f)[8]) { f[0] = bflo(w.x); f[1] = bfhi(w.x); f[2] = bflo(w.y); f[3] = bfhi(w.y); f[4] = bflo(w.z); f[5] = bfhi(w.z); f[6] = bflo(w.w); f[7] = bfhi(w.w); }

struct EpiProj {
    static constexpr bool PERM = true, AFTER_DRAIN = false, CHAIN = false;
    unsigned char* ws; const float* lb_logits;
    template <int TYPE> DEVI void run(const AccT& acc, const pg8::Unit& u, int wr, int wc, int fr, int fq) const {
        const int row0 = u.pm * 256 + wr * 64 + fr;
#pragma unroll
        for (int bj = 0; bj < 2; ++bj) {
            const int col = u.pn * 256 + bj * 128 + wc * 32 + 8 * fq;
            float lb[8];
            if (TYPE == 2) {
#pragma unroll
                for (int j = 0; j < 8; ++j) { const int fc = col - 1024 + j; lb[j] = 1.0f / (1.0f + __expf(lb_logits[512 + fc] - lb_logits[fc])); }
            }
#pragma unroll
            for (int ai = 0; ai < 2; ++ai)
#pragma unroll
                for (int m = 0; m < 4; ++m) {
                    const int row = row0 + ai * 128 + m * 16;
                    f32x4 v0 = acc[ai][bj][m][0], v1 = acc[ai][bj][m][1];
                    if (TYPE == 0) {
                        const int g = col >> 4, h0 = col & 15, b = row >> 12, t = row & 4095, c = t >> 6, j = t & 63;
                        bf16* p = (bf16*)(ws + WS_U5) + ((size_t)(g * 1024 + b * 64 + c) * UK + j * 16 + h0);
                        *(v4u*)p = pack8(v0, v1);
                    } else if (TYPE == 1 || TYPE == 4) {
#pragma unroll
                        for (int j = 0; j < 4; ++j) { v0[j] = silu(v0[j]); v1[j] = silu(v1[j]); }
                        if (TYPE == 1) *(v4u*)((bf16*)(ws + WS_Q) + (size_t)row * 512 + (col - 512)) = pack8(v0, v1);
                        else           *(v4u*)((bf16*)(ws + WS_GS) + (size_t)row * 512 + (col - 2048)) = pack8(v0, v1);
                    } else if (TYPE == 2) {
#pragma unroll
                        for (int j = 0; j < 4; ++j) { v0[j] = __logf(lb[j] + (1.0f - lb[j]) * sigm(v0[j])); v1[j] = __logf(lb[4 + j] + (1.0f - lb[4 + j]) * sigm(v1[j])); }
                        float* p = (float*)(ws + WS_LF) + (size_t)row * 512 + (col - 1024);
                        *(f32x4*)p = v0; *(f32x4*)(p + 4) = v1;
                    } else if (TYPE == 3) {
                        *(v4u*)((bf16*)(ws + WS_VV) + (size_t)row * 512 + (col - 1536)) = pack8(v0, v1);
                    } else {
#pragma unroll
                        for (int j = 0; j < 4; ++j) { v0[j] = sigm(v0[j]); v1[j] = sigm(v1[j]); }
                        if (TYPE == 5) *(v4u*)((bf16*)(ws + WS_GA) + (size_t)row * 1024 + (col - 2560)) = pack8(v0, v1);
                        else           *(v4u*)((bf16*)(ws + WS_GB) + (size_t)row * 1024 + (col - 3584)) = pack8(v0, v1);
                    }
                }
        }
    }
    DEVI void operator()(const AccT& acc, const pg8::Unit& u, int wr, int wc, int fr, int fq) const {
        const int pn = u.pn;
        if (pn < 2) run<0>(acc, u, wr, wc, fr, fq);
        else if (pn < 4) run<1>(acc, u, wr, wc, fr, fq);
        else if (pn < 6) run<2>(acc, u, wr, wc, fr, fq);
        else if (pn < 8) run<3>(acc, u, wr, wc, fr, fq);
        else if (pn < 10) run<4>(acc, u, wr, wc, fr, fq);
        else if (pn < 14) run<5>(acc, u, wr, wc, fr, fq);
        else run<6>(acc, u, wr, wc, fr, fq);
    }
};

struct EpiGlu {
    static constexpr bool PERM = true, AFTER_DRAIN = false, CHAIN = false;
    unsigned char* ws; const float* bias;
    DEVI void operator()(const AccT& acc, const pg8::Unit& u, int wr, int wc, int fr, int fq) const {
        const int row0 = u.pm * 256 + wr * 64 + fr;
#pragma unroll
        for (int bj = 0; bj < 2; ++bj) {
            const int col = u.pn * 256 + bj * 128 + wc * 32 + 8 * fq;
            const f32x4 b0 = *(const f32x4*)(bias + col), b1 = *(const f32x4*)(bias + col + 4);
            v4u yw[2][4];
#pragma unroll
            for (int ai = 0; ai < 2; ++ai)
#pragma unroll
                for (int m = 0; m < 4; ++m) yw[ai][m] = *(const v4u*)((const bf16*)(ws + WS_Y2) + (size_t)(row0 + ai * 128 + m * 16) * 512 + col);
            __builtin_amdgcn_sched_barrier(0);
#pragma unroll
            for (int ai = 0; ai < 2; ++ai)
#pragma unroll
                for (int m = 0; m < 4; ++m) {
                    const int row = row0 + ai * 128 + m * 16;
                    float y[8]; unpack8(yw[ai][m], y);
                    f32x4 v0 = acc[ai][bj][m][0] + b0, v1 = acc[ai][bj][m][1] + b1;
#pragma unroll
                    for (int j = 0; j < 4; ++j) { v0[j] = y[j] * sigm(v0[j]); v1[j] = y[4 + j] * sigm(v1[j]); }
                    *(v4u*)((bf16*)(ws + WS_YAB) + (size_t)row * 1024 + col) = pack8(v0, v1);
                }
            __builtin_amdgcn_sched_barrier(0);
        }
    }
};

struct EpiMerge {
    static constexpr bool PERM = true, AFTER_DRAIN = false, CHAIN = true;
    unsigned char* ws;
    DEVI void operator()(AccT& acc, const pg8::Unit& u, int wr, int wc, int fr, int fq) const {
        const int row0 = u.pm * 256 + wr * 64 + fr;
#pragma unroll
        for (int bj = 0; bj < 2; ++bj) {
            const int col = u.pn * 256 + bj * 128 + wc * 32 + 8 * fq;
#pragma unroll
            for (int ai = 0; ai < 2; ++ai) {
                v4u bw[4], aw[4];
#pragma unroll
                for (int m = 0; m < 4; ++m) { const size_t off = (size_t)(row0 + ai * 128 + m * 16) * 1024 + col;
                    bw[m] = *(const v4u*)((const bf16*)(ws + WS_GB) + off);
                    if (u.z == 0) aw[m] = *(const v4u*)((const bf16*)(ws + WS_GA) + off); }
                __builtin_amdgcn_sched_barrier(0);
#pragma unroll
                for (int m = 0; m < 4; ++m) {
                    const size_t off = (size_t)(row0 + ai * 128 + m * 16) * 1024 + col;
                    float gb[8]; unpack8(bw[m], gb);
                    if (u.z == 0) {
                        float ga[8]; unpack8(aw[m], ga);
#pragma unroll
                        for (int j = 0; j < 4; ++j) { acc[ai][bj][m][0][j] *= ga[j] * __builtin_amdgcn_rcpf(gb[j]); acc[ai][bj][m][1][j] *= ga[4 + j] * __builtin_amdgcn_rcpf(gb[4 + j]); }
                    } else {
                        f32x4 v0 = acc[ai][bj][m][0], v1 = acc[ai][bj][m][1];
#pragma unroll
                        for (int j = 0; j < 4; ++j) { v0[j] *= gb[j]; v1[j] *= gb[4 + j]; }
                        *(v4u*)((bf16*)(ws + WS_MG) + off) = pack8(v0, v1);
                    }
                }
                __builtin_amdgcn_sched_barrier(0);
            }
        }
    }
};

struct EpiOut {
    static constexpr bool PERM = true, AFTER_DRAIN = false, CHAIN = false;
    unsigned char* ws; const float* x;
    DEVI void operator()(const AccT& acc, const pg8::Unit& u, int wr, int wc, int fr, int fq) const {
        const int row0 = u.pm * 256 + wr * 64 + fr;
#pragma unroll
        for (int bj = 0; bj < 2; ++bj) {
            const int col = u.pn * 256 + bj * 128 + wc * 32 + 8 * fq;
#pragma unroll
            for (int ai = 0; ai < 2; ++ai) {
                f32x4 xr[4][2];
#pragma unroll
                for (int m = 0; m < 4; ++m) { const size_t off = (size_t)(row0 + ai * 128 + m * 16) * 1024 + col; xr[m][0] = *(const f32x4*)(x + off); xr[m][1] = *(const f32x4*)(x + off + 4); }
                __builtin_amdgcn_sched_barrier(0);
#pragma unroll
                for (int m = 0; m < 4; ++m) {
                    float* p = (float*)(ws + WS_H1) + (size_t)(row0 + ai * 128 + m * 16) * 1024 + col;
                    *(f32x4*)p = acc[ai][bj][m][0] + ALPHA * xr[m][0]; *(f32x4*)(p + 4) = acc[ai][bj][m][1] + ALPHA * xr[m][1];
                }
                __builtin_amdgcn_sched_barrier(0);
            }
        }
    }
};

struct EpiScores {
    static constexpr bool PERM = true, AFTER_DRAIN = false, CHAIN = false;
    unsigned char* ws;
    DEVI void operator()(const AccT& acc, const pg8::Unit& u, int wr, int wc, int fr, int fq) const {
        const int row0 = u.pm * 256 + wr * 64 + fr;
#pragma unroll
        for (int bj = 0; bj < 2; ++bj) {
            const int col = u.pn * 256 + bj * 128 + wc * 32 + 8 * fq;
#pragma unroll
            for (int ai = 0; ai < 2; ++ai)
#pragma unroll
                for (int m = 0; m < 4; ++m) {
                    const int row = row0 + ai * 128 + m * 16;
                    const f32x4 v0 = acc[ai][bj][m][0], v1 = acc[ai][bj][m][1];
                    v4u w; w.x = pkh2(v0[0], v0[1]); w.y = pkh2(v0[2], v0[3]); w.z = pkh2(v1[0], v1[1]); w.w = pkh2(v1[2], v1[3]);
                    *(v4u*)((unsigned short*)(ws + WS_SC) + (size_t)row * 2048 + col) = w;
                }
        }
    }
};

struct EpiS5Z {
    static constexpr bool PERM = true, AFTER_DRAIN = false, CHAIN = false;
    unsigned char* ws;
    DEVI void operator()(const AccT& acc, const pg8::Unit& u, int wr, int wc, int fr, int fq) const {
        const int row0 = u.pm * 256 + wr * 64 + fr, col = wc * 32 + 8 * fq;
        float* Z = (float*)(ws + WS_Z) + (size_t)u.z * 1024 * 128;
#pragma unroll
        for (int ai = 0; ai < 2; ++ai)
#pragma unroll
            for (int m = 0; m < 4; ++m) {
                const int row = row0 + ai * 128 + m * 16;
                float* p = Z + (size_t)row * 128 + col;
                *(f32x4*)p = acc[ai][0][m][0]; *(f32x4*)(p + 4) = acc[ai][0][m][1];
            }
    }
};
struct EpiS5Y {
    static constexpr bool PERM = true, AFTER_DRAIN = false, CHAIN = false;
    unsigned char* ws;
    DEVI void operator()(const AccT& acc, const pg8::Unit& u, int wr, int wc, int fr, int fq) const {
        const int row0 = u.pm * 256 + wr * 64 + fr;
        bf16* Y2 = (bf16*)(ws + WS_Y2);
#pragma unroll
        for (int bj = 0; bj < 2; ++bj) {
            const int n = u.pn * 256 + bj * 128 + wc * 32 + 8 * fq, i = n >> 4, h0 = n & 15;
#pragma unroll
            for (int ai = 0; ai < 2; ++ai)
#pragma unroll
                for (int m = 0; m < 4; ++m) {
                    const int r = row0 + ai * 128 + m * 16, b = r >> 6, c = r & 63;
                    f32x4 v0 = acc[ai][bj][m][0], v1 = acc[ai][bj][m][1];
#pragma unroll
                    for (int j = 0; j < 4; ++j) { v0[j] = gelu_t(v0[j]); v1[j] = gelu_t(v1[j]); }
                    *(v4u*)(Y2 + ((size_t)b * 4096 + c * 64 + i) * 512 + u.z * 16 + h0) = pack8(v0, v1);
                }
        }
    }
};

#define LDS_WAIT() asm volatile("s_waitcnt lgkmcnt(0)" ::: "memory")

DEVI void transpose_item(const float* W, int K, int N, bf16* WT, LAS float* scr, int item, int lane, int ldo = 0, int koff = 0) {
    if (ldo == 0) ldo = K;
    const int nblk = N / 32, kb = item / nblk, nb = item % nblk, k0 = 64 * kb, n0 = 32 * nb;
#pragma unroll 8
    for (int i = 0; i < 32; ++i) { const int kk = 2 * i + (lane >> 5); scr[kk * 33 + (lane & 31)] = W[(size_t)(k0 + kk) * N + n0 + (lane & 31)]; }
    LDS_WAIT();
    const int c = lane & 7;
#pragma unroll
    for (int j = 0; j < 4; ++j) { const int n = (lane >> 3) + 8 * j; const LAS float* s = scr + (8 * c) * 33 + n;
        v4u o; o.x = pk2(s[0 * 33], s[1 * 33]); o.y = pk2(s[2 * 33], s[3 * 33]); o.z = pk2(s[4 * 33], s[5 * 33]); o.w = pk2(s[6 * 33], s[7 * 33]);
        *(v4u*)(WT + (size_t)(n0 + n) * ldo + koff + k0 + 8 * c) = o; }
    LDS_WAIT();
}

DEVI void cvt_bf16_stream(const float* src, bf16* dst, size_t n8, size_t gtid, size_t gthreads) {
    for (size_t i = gtid; i < n8; i += gthreads) {
        const f32x4 a = *(const f32x4*)(src + i * 8), b = *(const f32x4*)(src + i * 8 + 4);
        *(v4u*)(dst + i * 8) = pack8(a, b);
    }
}

DEVI float clamp_fp8(float x) { return fminf(fmaxf(x, -448.0f), 448.0f); }
DEVI unsigned pk4_fp8(float a, float b, float c, float d) { a = clamp_fp8(a); b = clamp_fp8(b); c = clamp_fp8(c); d = clamp_fp8(d); int w = 0; w = __builtin_amdgcn_cvt_pk_fp8_f32(a, b, w, false); w = __builtin_amdgcn_cvt_pk_fp8_f32(c, d, w, true); return (unsigned)w; }
DEVI void cvt_fp8_stream(const float* src, unsigned char* dst, size_t n16, float scale, size_t gtid, size_t gthreads) {
    for (size_t i = gtid; i < n16; i += gthreads) {
        const f32x4 a = *(const f32x4*)(src + i * 16) * scale, b = *(const f32x4*)(src + i * 16 + 4) * scale, c = *(const f32x4*)(src + i * 16 + 8) * scale, d = *(const f32x4*)(src + i * 16 + 12) * scale;
        v4u o; o.x = pk4_fp8(a[0], a[1], a[2], a[3]); o.y = pk4_fp8(b[0], b[1], b[2], b[3]); o.z = pk4_fp8(c[0], c[1], c[2], c[3]); o.w = pk4_fp8(d[0], d[1], d[2], d[3]);
        *(v4u*)(dst + i * 16) = o;
    }
}

DEVI void cvt_fp8_sliced(const float* src, unsigned char* dst, float scale, size_t gtid, size_t gthreads) {
    for (size_t i = gtid; i < (size_t)PNE * D / 16; i += gthreads) {
        const size_t e = i >> 6; const int cg = (int)(i & 63), j = cg >> 3, within = (cg & 7) * 16;
        const f32x4 a = *(const f32x4*)(src + i * 16) * scale, b = *(const f32x4*)(src + i * 16 + 4) * scale, c = *(const f32x4*)(src + i * 16 + 8) * scale, d = *(const f32x4*)(src + i * 16 + 12) * scale;
        v4u o; o.x = pk4_fp8(a[0], a[1], a[2], a[3]); o.y = pk4_fp8(b[0], b[1], b[2], b[3]); o.z = pk4_fp8(c[0], c[1], c[2], c[3]); o.w = pk4_fp8(d[0], d[1], d[2], d[3]);
        *(v4u*)(dst + ((size_t)j * PNE + e) * 128 + within) = o;
    }
}

DEVI unsigned q4_i8(float a, float b, float c, float d) {
    const int ia = (int)rintf(a), ib = (int)rintf(b), ic = (int)rintf(c), id = (int)rintf(d);
    return (unsigned)(ia & 255) | ((unsigned)(ib & 255) << 8) | ((unsigned)(ic & 255) << 16) | ((unsigned)(id & 255) << 24);
}
DEVI void cvt_i8_rows(const float* src, unsigned char* dst, float* scales, int gw, int ngw, int lane) {
    for (int e = gw; e < PNE; e += ngw) {
        const float* rp = src + (size_t)e * 1024 + lane * 16;
        f32x4 v[4]; float m = 0.f;
#pragma unroll
        for (int q = 0; q < 4; ++q) { v[q] = *(const f32x4*)(rp + 4 * q); m = fmaxf(m, fmaxf(fmaxf(fabsf(v[q][0]), fabsf(v[q][1])), fmaxf(fabsf(v[q][2]), fabsf(v[q][3])))); }
        m = wave_max(m); m = fmaxf(m, 1e-30f);
        const float inv = 127.0f / m;
        v4u o;
#pragma unroll
        for (int q = 0; q < 4; ++q) o[q] = q4_i8(v[q][0] * inv, v[q][1] * inv, v[q][2] * inv, v[q][3] * inv);
        *(v4u*)(dst + ((size_t)(lane >> 3) * PNE + e) * 128 + (lane & 7) * 16) = o;
        if (lane == 0) scales[e] = m * (1.0f / 127.0f);
    }
}

DEVI void phase_prep(const Args& a, LAS unsigned char* lds) {
    const int tid = threadIdx.x, lane = tid & 63, wave = __builtin_amdgcn_readfirstlane(tid >> 6), G = gridDim.x;
    unsigned char* ws = a.ws;
    const size_t gtid = (size_t)blockIdx.x * 512 + tid, gthreads = (size_t)G * 512;
    cvt_bf16_stream(a.in[0], (bf16*)(ws + WS_XB), (size_t)T * D / 8, gtid, gthreads);
#if PEER_FP8
#if PEER_U_INT8
    cvt_i8_rows(a.in[21], ws + WS_PU, (float*)(ws + WS_US), blockIdx.x * 8 + wave, G * 8, lane);
#else
    cvt_fp8_sliced(a.in[21], ws + WS_PU, PU_SCALE, gtid, gthreads);
#endif
    cvt_fp8_sliced(a.in[22], ws + WS_PV, PV_SCALE, gtid, gthreads);
#else
    cvt_bf16_stream(a.in[21], (bf16*)(ws + WS_PU), (size_t)PNE * D / 8, gtid, gthreads);
    cvt_bf16_stream(a.in[22], (bf16*)(ws + WS_PV), (size_t)PNE * D / 8, gtid, gthreads);
#endif
    {
        LAS float* scr = (LAS float*)(lds + wave * 16384);
        const int gw = blockIdx.x * 8 + wave, NGW = G * 8;
        constexpr int I_IN = (1024 / 64) * (INC / 32), I_GLU = (512 / 64) * (512 / 32), I_PA = (512 / 64) * (1024 / 32), I_O = (1024 / 64) * (1024 / 32);
        constexpr int NIT = I_IN + I_GLU + 2 * I_PA + I_O;
        for (int it = gw; it < NIT; it += NGW) {
            int r = it;
            if (r < I_IN) { transpose_item(a.in[1], 1024, INC, (bf16*)(ws + WS_WINT), scr, r, lane); continue; } r -= I_IN;
            if (r < I_GLU) { transpose_item(a.in[10], 512, 512, (bf16*)(ws + WS_WGLUT), scr, r, lane); continue; } r -= I_GLU;
            if (r < I_PA) { transpose_item(a.in[14], 512, 1024, (bf16*)(ws + WS_WPAT), scr, r, lane, 1024, 0); continue; } r -= I_PA;
            if (r < I_PA) { transpose_item(a.in[15], 512, 1024, (bf16*)(ws + WS_WPAT), scr, r, lane, 1024, 512); continue; } r -= I_PA;
            transpose_item(a.in[16], 1024, 1024, (bf16*)(ws + WS_WOT), scr, r, lane);
        }
    }
    __syncthreads();
    {
        LAS float* wq = (LAS float*)lds;
        const float* wpq = a.in[19]; const float* keys = a.in[20];
        const int n = tid & 127, kh = __builtin_amdgcn_readfirstlane(tid >> 7);
        for (int item = blockIdx.x; item < 16 * 32; item += G) {
            const int slot = item >> 5, kt = item & 31;
            __syncthreads();
#pragma unroll
            for (int i = 0; i < 8; ++i) { const int idx = tid + 512 * i, kk = idx >> 7, d = idx & 127; wq[kk * 129 + d] = wpq[(size_t)(kt * 32 + kk) * 2048 + slot * 128 + d]; }
            __syncthreads();
            float acc[8];
#pragma unroll
            for (int kk = 0; kk < 8; ++kk) acc[kk] = 0.f;
            const float* kr = keys + ((size_t)(slot * 128 + n)) * 128;
            for (int d = 0; d < 128; d += 4) {
                const f32x4 kv = *(const f32x4*)(kr + d);
#pragma unroll
                for (int kk = 0; kk < 8; ++kk) { const LAS float* w = wq + (kh * 8 + kk) * 129 + d; acc[kk] += kv[0] * w[0] + kv[1] * w[1] + kv[2] * w[2] + kv[3] * w[3]; }
            }
            v4u o; o.x = pk2(acc[0], acc[1]); o.y = pk2(acc[2], acc[3]); o.z = pk2(acc[4], acc[5]); o.w = pk2(acc[6], acc[7]);
            *(v4u*)((bf16*)(ws + WS_WFT) + (size_t)(slot * 128 + n) * 1024 + kt * 32 + kh * 8) = o;
        }
    }
}

DEVI void s5_tables_item(const Args& a, LAS unsigned char* lds, int item) {
    const int tid = threadIdx.x, g = item >> 3, part = item & 7;
    unsigned char* ws = a.ws;
    LAS float* pwr = (LAS float*)lds;
    LAS float* pwi = pwr + 65 * 64;
    LAS float* Bbr = pwi + 65 * 64;
    LAS float* Bbi = Bbr + 1024;
    LAS float* Cr = Bbi + 1024;
    LAS float* Ci = Cr + 1024;
    LAS float* Kt = Ci + 1024;
    __syncthreads();
    if (tid < 64) {
        const int p = tid;
        const float dt = __expf(a.in[9][g]);
        const float lr = a.in[2][g * 64 + p], li = a.in[3][g * 64 + p];
        const float er = __expf(lr * dt); float sn, cs; sincosf(li * dt, &sn, &cs);
        const float Lr = er * cs, Li = er * sn;
        const float ar = Lr - 1.0f, ai = Li, den = lr * lr + li * li;
        const float cr = (ar * lr + ai * li) / den, ci = (ai * lr - ar * li) / den;
#pragma unroll
        for (int h = 0; h < 16; ++h) { const float br = a.in[4][(g * 64 + p) * 16 + h], bi = a.in[5][(g * 64 + p) * 16 + h];
            Bbr[p * 16 + h] = cr * br - ci * bi; Bbi[p * 16 + h] = cr * bi + ci * br; }
        float xr = 1.0f, xi = 0.0f;
        for (int d = 0; d <= 64; ++d) { pwr[d * 64 + p] = xr; pwi[d * 64 + p] = xi; const float nr = xr * Lr - xi * Li, ni = xr * Li + xi * Lr; xr = nr; xi = ni; }
        if (part == 0) { float* l64 = (float*)(ws + WS_L64) + (g * 64 + p) * 2; l64[0] = pwr[64 * 64 + p]; l64[1] = pwi[64 * 64 + p]; }
    }
    for (int i = tid; i < 1024; i += 512) { Cr[i] = a.in[6][g * 1024 + i]; Ci[i] = a.in[7][g * 1024 + i]; }
    __syncthreads();
    for (int pr = tid; pr < 1024; pr += 512) {
        const int d = pr >> 4, hp = pr & 15;
        float acc[16];
#pragma unroll
        for (int h = 0; h < 16; ++h) acc[h] = 0.f;
        for (int p = 0; p < 64; ++p) {
            const float c_r = Cr[hp * 64 + p], c_i = Ci[hp * 64 + p], w_r = pwr[d * 64 + p], w_i = pwi[d * 64 + p];
            const float cpr = c_r * w_r - c_i * w_i, cpi = c_r * w_i + c_i * w_r;
#pragma unroll
            for (int h = 0; h < 16; ++h) acc[h] += cpr * Bbr[p * 16 + h] - cpi * Bbi[p * 16 + h];
        }
#pragma unroll
        for (int h = 0; h < 16; ++h) Kt[pr * 16 + h] = acc[h];
    }
    __syncthreads();
    bf16* TY = (bf16*)(ws + WS_TY) + (size_t)g * 1024 * UK;
    for (int e = tid; e < 128 * 128; e += 512) {
        const int n = part * 128 + (e >> 7), k0 = (e & 127) * 8, i = n >> 4, hp = n & 15, j = k0 >> 4, h0 = k0 & 15;
        float v[8];
#pragma unroll
        for (int q = 0; q < 8; ++q) v[q] = 0.f;
        if (j <= i) {
            const LAS float* kp = Kt + ((i - j) * 16 + hp) * 16 + h0;
#pragma unroll
            for (int q = 0; q < 8; ++q) v[q] = kp[q];
            if (j == i && hp >= h0 && hp < h0 + 8) v[hp - h0] += a.in[8][g * 16 + hp];
        }
        v4u o; o.x = pk2(v[0], v[1]); o.y = pk2(v[2], v[3]); o.z = pk2(v[4], v[5]); o.w = pk2(v[6], v[7]);
        *(v4u*)(TY + (size_t)n * UK + k0) = o;
    }
    for (int e = tid; e < 128 * 64; e += 512) {
        const int n = part * 128 + (e >> 6), p = e & 63, i = n >> 4, hp = n & 15;
        const float c_r = Cr[hp * 64 + p], c_i = Ci[hp * 64 + p], w_r = pwr[(i + 1) * 64 + p], w_i = pwi[(i + 1) * 64 + p];
        TY[(size_t)n * UK + 1024 + p] = (bf16)f2bf(c_r * w_r - c_i * w_i);
        TY[(size_t)n * UK + 1088 + p] = (bf16)f2bf(-(c_r * w_i + c_i * w_r));
    }
    bf16* WZ = (bf16*)(ws + WS_WZ) + (size_t)g * 256 * 1024;
    for (int e = tid; e < 32 * 128; e += 512) {
        const int n = part * 32 + (e >> 7), k0 = (e & 127) * 8, j = k0 >> 4, h0 = k0 & 15;
        float v[8];
#pragma unroll
        for (int q = 0; q < 8; ++q) v[q] = 0.f;
        if (n < 128) {
            const int p = n & 63; const float w_r = pwr[(63 - j) * 64 + p], w_i = pwi[(63 - j) * 64 + p];
#pragma unroll
            for (int q = 0; q < 8; ++q) { const float b_r = Bbr[p * 16 + h0 + q], b_i = Bbi[p * 16 + h0 + q]; v[q] = (n < 64) ? (w_r * b_r - w_i * b_i) : (w_r * b_i + w_i * b_r); }
        }
        v4u o; o.x = pk2(v[0], v[1]); o.y = pk2(v[2], v[3]); o.z = pk2(v[4], v[5]); o.w = pk2(v[6], v[7]);
        *(v4u*)(WZ + (size_t)n * 1024 + k0) = o;
    }
}

DEVI void s5_scan(const Args& a) {
    unsigned char* ws = a.ws;
    for (int id = blockIdx.x * 512 + threadIdx.x; id < S5G * BATCH * 64; id += gridDim.x * 512) {
        const int p = id & 63, b = (id >> 6) & 15, g = id >> 10;
        const float* l64 = (const float*)(ws + WS_L64) + (g * 64 + p) * 2; const float Lr = l64[0], Li = l64[1];
        const float* zp = (const float*)(ws + WS_Z) + (size_t)(g * 1024 + b * 64) * 128 + p;
        bf16* up = (bf16*)(ws + WS_U5) + (size_t)(g * 1024 + b * 64) * UK + 1024 + p;
        float xr = 0.f, xi = 0.f;
#pragma unroll 8
        for (int c = 0; c < 64; ++c) {
            const float zr = zp[(size_t)c * 128], zi = zp[(size_t)c * 128 + 64];
            up[(size_t)c * UK] = (bf16)f2bf(xr); up[(size_t)c * UK + 64] = (bf16)f2bf(xi);
            const float nr = Lr * xr - Li * xi + zr, ni = Lr * xi + Li * xr + zi; xr = nr; xi = ni;
        }
    }
}

constexpr int HG_QT = 0, HG_KT = 17408, HG_KHT = 34816, HG_VT = 53248, HG_SBT = 71680, HG_P = 106496, HG_EB = 115712, HG_TOT = 116224;
DEVI int crow(int j, int hh) { return (j & 3) + 8 * (j >> 2) + 4 * hh; }
DEVI bf16x8 ldfrag(const LAS unsigned char* base, int row, int pitch, int col) { return *(const LAS bf16x8*)(base + (row * pitch + col) * 2); }

template <bool FULL> DEVI void hgrn_segment(const Args& a, LAS unsigned char* lds, int item) {
    const int tid = threadIdx.x, lane = tid & 63, wave = __builtin_amdgcn_readfirstlane(tid >> 6);
    const int seg = item & 3, h = (item >> 2) & 3, b = item >> 4;
    unsigned char* ws = a.ws;
    const int kcol = tid & 127, qd = tid >> 7, r32 = lane & 31, hh = lane >> 5;
    const int ti = wave >> 2, vi = wave & 3, ski = wave & 3, sv0 = (wave >> 2) * 2;
    const float* LF = (const float*)(ws + WS_LF); const bf16* Q = (const bf16*)(ws + WS_Q); const bf16* VV = (const bf16*)(ws + WS_VV); const bf16* GS = (const bf16*)(ws + WS_GS);
    bf16* YB = (bf16*)(ws + WS_YAB) + 512;
    float* HGS = (float*)(ws + WS_HGS); float* HGD = (float*)(ws + WS_HGD);
    LAS unsigned char* QT = lds + HG_QT; LAS unsigned char* KT = lds + HG_KT; LAS unsigned char* KHT = lds + HG_KHT; LAS unsigned char* VT = lds + HG_VT;
    LAS unsigned char* SBT = lds + HG_SBT; LAS unsigned char* PB = lds + HG_P;
    LAS float* EB = (LAS float*)(lds + HG_EB); LAS float* TOT = (LAS float*)(lds + HG_TOT); LAS float* O = (LAS float*)(lds + HG_QT);
    f32x16 S0, S1;
#pragma unroll
    for (int j = 0; j < 16; ++j) { S0[j] = 0.f; S1[j] = 0.f; }
    float sumlog = 0.f;
    __syncthreads();
    if (FULL) {
        for (int s2 = 0; s2 < seg; ++s2) {
            const int it2 = (b * 4 + h) * 4 + s2;
            const float* dS = HGS + (size_t)it2 * 16384; const float* Dl = HGD + it2 * 128;
#pragma unroll
            for (int j = 0; j < 16; ++j) { const int k = ski * 32 + crow(j, hh); const float d = Dl[k];
                S0[j] = d * S0[j] + dS[k * 128 + sv0 * 32 + r32]; S1[j] = d * S1[j] + dS[k * 128 + (sv0 + 1) * 32 + r32]; }
        }
#pragma unroll
        for (int g4 = 0; g4 < 4; ++g4) { const int k0 = ski * 32 + 8 * g4 + 4 * hh;
            v2u w0, w1; w0.x = pk2(S0[4 * g4], S0[4 * g4 + 1]); w0.y = pk2(S0[4 * g4 + 2], S0[4 * g4 + 3]); w1.x = pk2(S1[4 * g4], S1[4 * g4 + 1]); w1.y = pk2(S1[4 * g4 + 2], S1[4 * g4 + 3]);
            *(LAS v2u*)(SBT + ((sv0 * 32 + r32) * 136 + k0) * 2) = w0; *(LAS v2u*)(SBT + (((sv0 + 1) * 32 + r32) * 136 + k0) * 2) = w1; }
    }
    for (int cc = 0; cc < 16; ++cc) {
        const size_t row0 = (size_t)b * 4096 + (seg * 16 + cc) * 64;
        __syncthreads();
        float l[16], qv[16];
        {
            const size_t g0 = (row0 + qd * 16) * 512 + h * 128 + kcol;
            bf16 vraw[16];
#pragma unroll
            for (int i = 0; i < 16; ++i) { l[i] = LF[g0 + (size_t)i * 512]; vraw[i] = VV[g0 + (size_t)i * 512]; if (FULL) qv[i] = bf2f(Q[g0 + (size_t)i * 512]); }
            v4u w0, w1;
            w0.x = vraw[0] | ((unsigned)vraw[1] << 16); w0.y = vraw[2] | ((unsigned)vraw[3] << 16); w0.z = vraw[4] | ((unsigned)vraw[5] << 16); w0.w = vraw[6] | ((unsigned)vraw[7] << 16);
            w1.x = vraw[8] | ((unsigned)vraw[9] << 16); w1.y = vraw[10] | ((unsigned)vraw[11] << 16); w1.z = vraw[12] | ((unsigned)vraw[13] << 16); w1.w = vraw[14] | ((unsigned)vraw[15] << 16);
            *(LAS v4u*)(VT + (kcol * 72 + qd * 16) * 2) = w0; *(LAS v4u*)(VT + (kcol * 72 + qd * 16 + 8) * 2) = w1;
        }
        float pre[16]; { float run = 0.f;
#pragma unroll
            for (int i = 0; i < 16; ++i) { run += l[i]; pre[i] = run; }
            TOT[qd * 128 + kcol] = run; }
        __syncthreads();
        float off = 0.f, blast = 0.f;
#pragma unroll
        for (int q2 = 0; q2 < 4; ++q2) { const float tv = TOT[q2 * 128 + kcol]; blast += tv; off += (q2 < qd) ? tv : 0.f; }
        if (qd == 0) { EB[kcol] = __expf(blast); sumlog += blast; }
        {
            float kh[16];
#pragma unroll
            for (int i = 0; i < 16; ++i) {
                const float bc = off + pre[i], omf = 1.0f - __expf(l[i]);
                kh[i] = omf * __expf(blast - bc);
                if (FULL) { const int s = qd * 16 + i;
                    *(LAS bf16*)(QT + (s * 136 + kcol) * 2) = (bf16)f2bf(qv[i] * __expf(bc));
                    *(LAS bf16*)(KT + (s * 136 + kcol) * 2) = (bf16)f2bf(omf * __expf(-bc)); }
            }
            v4u w0, w1; w0.x = pk2(kh[0], kh[1]); w0.y = pk2(kh[2], kh[3]); w0.z = pk2(kh[4], kh[5]); w0.w = pk2(kh[6], kh[7]);
            w1.x = pk2(kh[8], kh[9]); w1.y = pk2(kh[10], kh[11]); w1.z = pk2(kh[12], kh[13]); w1.w = pk2(kh[14], kh[15]);
            *(LAS v4u*)(KHT + (kcol * 72 + qd * 16) * 2) = w0; *(LAS v4u*)(KHT + (kcol * 72 + qd * 16 + 8) * 2) = w1;
        }
        __syncthreads();
        f32x16 o;
#pragma unroll
        for (int j = 0; j < 16; ++j) o[j] = 0.f;
        if (FULL) {
            if (wave < 3) {
                const int sti = wave ? 1 : 0, ssi = wave == 2 ? 1 : 0;
                f32x16 sc;
#pragma unroll
                for (int j = 0; j < 16; ++j) sc[j] = 0.f;
#pragma unroll
                for (int ks = 0; ks < 8; ++ks) sc = __builtin_amdgcn_mfma_f32_32x32x16_bf16(ldfrag(QT, sti * 32 + r32, 136, ks * 16 + 8 * hh), ldfrag(KT, ssi * 32 + r32, 136, ks * 16 + 8 * hh), sc, 0, 0, 0);
                const int s = ssi * 32 + r32;
#pragma unroll
                for (int j = 0; j < 16; ++j) { const int t = sti * 32 + crow(j, hh); *(LAS bf16*)(PB + (t * 72 + s) * 2) = (bf16)f2bf(s <= t ? sc[j] : 0.f); }
            }
#pragma unroll
            for (int ks = 0; ks < 8; ++ks) o = __builtin_amdgcn_mfma_f32_32x32x16_bf16(ldfrag(QT, ti * 32 + r32, 136, ks * 16 + 8 * hh), ldfrag(SBT, vi * 32 + r32, 136, ks * 16 + 8 * hh), o, 0, 0, 0);
        }
        {
#pragma unroll
            for (int g4 = 0; g4 < 4; ++g4) { const f32x4 e = *(const LAS f32x4*)(EB + ski * 32 + 8 * g4 + 4 * hh);
#pragma unroll
                for (int q = 0; q < 4; ++q) { S0[4 * g4 + q] *= e[q]; S1[4 * g4 + q] *= e[q]; } }
#pragma unroll
            for (int ks = 0; ks < 4; ++ks) { const bf16x8 af = ldfrag(KHT, ski * 32 + r32, 72, ks * 16 + 8 * hh);
                S0 = __builtin_amdgcn_mfma_f32_32x32x16_bf16(af, ldfrag(VT, sv0 * 32 + r32, 72, ks * 16 + 8 * hh), S0, 0, 0, 0);
                S1 = __builtin_amdgcn_mfma_f32_32x32x16_bf16(af, ldfrag(VT, (sv0 + 1) * 32 + r32, 72, ks * 16 + 8 * hh), S1, 0, 0, 0); }
        }
        if (FULL) {
            __syncthreads();
            if (ti) {
#pragma unroll
                for (int ks = 0; ks < 4; ++ks) o = __builtin_amdgcn_mfma_f32_32x32x16_bf16(ldfrag(PB, ti * 32 + r32, 72, ks * 16 + 8 * hh), ldfrag(VT, vi * 32 + r32, 72, ks * 16 + 8 * hh), o, 0, 0, 0);
            } else {
#pragma unroll
                for (int ks = 0; ks < 2; ++ks) o = __builtin_amdgcn_mfma_f32_32x32x16_bf16(ldfrag(PB, r32, 72, ks * 16 + 8 * hh), ldfrag(VT, vi * 32 + r32, 72, ks * 16 + 8 * hh), o, 0, 0, 0);
            }
#pragma unroll
            for (int g4 = 0; g4 < 4; ++g4) { const int k0 = ski * 32 + 8 * g4 + 4 * hh;
                v2u w0, w1; w0.x = pk2(S0[4 * g4], S0[4 * g4 + 1]); w0.y = pk2(S0[4 * g4 + 2], S0[4 * g4 + 3]); w1.x = pk2(S1[4 * g4], S1[4 * g4 + 1]); w1.y = pk2(S1[4 * g4 + 2], S1[4 * g4 + 3]);
                *(LAS v2u*)(SBT + ((sv0 * 32 + r32) * 136 + k0) * 2) = w0; *(LAS v2u*)(SBT + (((sv0 + 1) * 32 + r32) * 136 + k0) * 2) = w1; }
#pragma unroll
            for (int j = 0; j < 16; ++j) O[(ti * 32 + crow(j, hh)) * 132 + vi * 32 + r32] = o[j];
            __syncthreads();
            {
                const int t = tid >> 3, sg = (tid & 7) * 16;
                float ov[16], ss = 0.f;
#pragma unroll
                for (int i = 0; i < 16; i += 4) { const f32x4 x = *(const LAS f32x4*)(O + t * 132 + sg + i); ov[i] = x[0]; ov[i + 1] = x[1]; ov[i + 2] = x[2]; ov[i + 3] = x[3]; }
#pragma unroll
                for (int i = 0; i < 16; ++i) ss += ov[i] * ov[i];
                ss += __shfl_xor(ss, 1); ss += __shfl_xor(ss, 2); ss += __shfl_xor(ss, 4);
                const float r = rsqrtf(ss * (1.0f / 128.0f) + RMS_EPS);
                const size_t go = (row0 + t) * 512 + h * 128 + sg, yo = (row0 + t) * 1024 + h * 128 + sg;
                const v4u g0 = *(const v4u*)(GS + go), g1 = *(const v4u*)(GS + go + 8);
                float gs0[8], gs1[8]; unpack8(g0, gs0); unpack8(g1, gs1);
                const float* gw = a.in[13] + h * 128 + sg;
#pragma unroll
                for (int i = 0; i < 8; ++i) { ov[i] = ov[i] * r * gw[i] * gs0[i]; ov[8 + i] = ov[8 + i] * r * gw[8 + i] * gs1[i]; }
                v4u w0, w1; w0.x = pk2(ov[0], ov[1]); w0.y = pk2(ov[2], ov[3]); w0.z = pk2(ov[4], ov[5]); w0.w = pk2(ov[6], ov[7]);
                w1.x = pk2(ov[8], ov[9]); w1.y = pk2(ov[10], ov[11]); w1.z = pk2(ov[12], ov[13]); w1.w = pk2(ov[14], ov[15]);
                *(v4u*)(YB + yo) = w0; *(v4u*)(YB + yo + 8) = w1;
            }
        }
    }
    if (!FULL) {
        float* dS = HGS + (size_t)item * 16384;
#pragma unroll
        for (int j = 0; j < 16; ++j) { const int k = ski * 32 + crow(j, hh); dS[k * 128 + sv0 * 32 + r32] = S0[j]; dS[k * 128 + (sv0 + 1) * 32 + r32] = S1[j]; }
        if (qd == 0) HGD[item * 128 + kcol] = __expf(sumlog);
    }
}

template <int NT> DEVI void ln1_rows(const Args& a, int r0, int rstride, int lane) {
    f32x4 v[NT][4];
#pragma unroll
    for (int q = 0; q < NT; ++q) { const float* hr = (const float*)(a.ws + WS_H1) + (size_t)(r0 + q * rstride) * 1024 + lane * 4;
#pragma unroll
        for (int j = 0; j < 4; ++j) v[q][j] = *(const f32x4*)(hr + 256 * j); }
    f32x4 gg[4], bb[4];
#pragma unroll
    for (int j = 0; j < 4; ++j) { gg[j] = *(const f32x4*)(a.in[17] + lane * 4 + 256 * j); bb[j] = *(const f32x4*)(a.in[18] + lane * 4 + 256 * j); }
#pragma unroll
    for (int q = 0; q < NT; ++q) {
        const int row = r0 + q * rstride;
        float s = 0.f;
#pragma unroll
        for (int j = 0; j < 4; ++j) s += (v[q][j][0] + v[q][j][1]) + (v[q][j][2] + v[q][j][3]);
        const float mean = wave_sum(s) * (1.0f / 1024.0f); float qq = 0.f;
#pragma unroll
        for (int j = 0; j < 4; ++j) { v[q][j] = v[q][j] - mean; qq += (v[q][j][0] * v[q][j][0] + v[q][j][1] * v[q][j][1]) + (v[q][j][2] * v[q][j][2] + v[q][j][3] * v[q][j][3]); }
        const float rstd = rsqrtf(wave_sum(qq) * (1.0f / 1024.0f) + LN_EPS);
        bf16* o = (bf16*)(a.ws + WS_X1B) + (size_t)row * 1024 + lane * 4;
        float am = 0.f;
#pragma unroll
        for (int j = 0; j < 4; ++j) {
            const f32x4 y = v[q][j] * rstd * gg[j] + bb[j]; v[q][j] = y;
            am = fmaxf(am, fmaxf(fmaxf(fabsf(y[0]), fabsf(y[1])), fmaxf(fabsf(y[2]), fabsf(y[3]))));
            v2u w; w.x = pk2(y[0], y[1]); w.y = pk2(y[2], y[3]);
            *(v2u*)(o + 256 * j) = w;
        }
#if PEER_U_INT8
        am = fmaxf(wave_max(am), 1e-30f);
        const float inv = 127.0f / am;
        unsigned char* qo = a.ws + WS_X1Q + (size_t)row * 1024 + lane * 4;
#pragma unroll
        for (int j = 0; j < 4; ++j) *(unsigned*)(qo + 256 * j) = q4_i8(v[q][j][0] * inv, v[q][j][1] * inv, v[q][j][2] * inv, v[q][j][3] * inv);
        if (lane == 0) ((float*)(a.ws + WS_XS))[row] = am * (1.0f / 127.0f);
#endif
    }
}

DEVI unsigned umax_(unsigned a, unsigned b) { return a > b ? a : b; }
DEVI unsigned umin_(unsigned a, unsigned b) { return a < b ? a : b; }
DEVI unsigned skey(float x) { const unsigned b = __float_as_uint(x); return b ^ (((int)b >> 31) | 0x80000000u); }
DEVI unsigned hkey(unsigned h) { return h ^ ((h & 0x8000u) ? 0xFFFFu : 0x8000u); }
DEVI float hkey_dec(unsigned k) { const unsigned kk = k >> 16; return h2f((unsigned short)(kk ^ ((kk & 0x8000u) ? 0x8000u : 0xFFFFu))); }
DEVI void ce_desc(unsigned& a, unsigned& b) { const unsigned mx = umax_(a, b), mn = umin_(a, b); a = mx; b = mn; }
DEVI void sort16_desc(unsigned (&g)[16]) {
#pragma unroll
    for (int k = 2; k <= 16; k <<= 1)
#pragma unroll
        for (int j = k >> 1; j > 0; j >>= 1)
#pragma unroll
            for (int i = 0; i < 16; ++i) { const int l = i ^ j; if (l > i) { if ((i & k) == 0) ce_desc(g[i], g[l]); else ce_desc(g[l], g[i]); } }
}
DEVI void merge16_desc(unsigned (&L)[16], const unsigned (&g)[16]) {
#pragma unroll
    for (int i = 0; i < 16; ++i) L[i] = umax_(L[i], g[15 - i]);
#pragma unroll
    for (int j = 8; j > 0; j >>= 1)
#pragma unroll
        for (int i = 0; i < 16; ++i) { const int l = i ^ j; if (l > i) ce_desc(L[i], L[l]); }
}
DEVI void topk_block(const Args& a, LAS float* stg, int task, int lane) {
    const int tb = task >> 3, h = task & 7;
    const unsigned short* sc = (const unsigned short*)(a.ws + WS_SC) + (size_t)tb * 64 * 2048 + h * 256;
    unsigned L[2][16];
#pragma unroll
    for (int p = 0; p < 2; ++p) {
#pragma unroll
        for (int i = 0; i < 16; ++i) L[p][i] = 0u;
        for (int sub = 0; sub < 2; ++sub) {
            v4u ld[8];
#pragma unroll
            for (int q = 0; q < 8; ++q) ld[q] = *(const v4u*)(sc + (size_t)(q * 8 + (lane >> 3)) * 2048 + p * 128 + sub * 64 + (lane & 7) * 8);
            __builtin_amdgcn_wave_barrier();
#pragma unroll
            for (int q = 0; q < 8; ++q) *(LAS v4u*)(stg + (q * 8 + (lane >> 3)) * 36 + (lane & 7) * 4) = ld[q];
            LDS_WAIT(); __builtin_amdgcn_wave_barrier();
#pragma unroll
            for (int q2 = 0; q2 < 4; ++q2) {
                const v4u v0 = *(const LAS v4u*)(stg + lane * 36 + q2 * 8), v1 = *(const LAS v4u*)(stg + lane * 36 + q2 * 8 + 4);
                unsigned g[16];
#pragma unroll
                for (int e = 0; e < 8; ++e) {
                    const unsigned h0 = (e & 1) ? (v0[e >> 1] >> 16) : (v0[e >> 1] & 0xFFFFu), h1 = (e & 1) ? (v1[e >> 1] >> 16) : (v1[e >> 1] & 0xFFFFu);
                    g[e] = (hkey(h0) << 16) | (unsigned)(sub * 64 + q2 * 16 + e); g[8 + e] = (hkey(h1) << 16) | (unsigned)(sub * 64 + q2 * 16 + 8 + e);
                }
                sort16_desc(g);
                merge16_desc(L[p], g);
            }
            LDS_WAIT(); __builtin_amdgcn_wave_barrier();
        }
    }
    unsigned C[16];
#pragma unroll
    for (int i = 0; i < 16; ++i) C[i] = 0u;
#pragma unroll
    for (int ia = 0; ia < 16; ++ia) {
        const float va = hkey_dec(L[0][ia]); const unsigned ea = (L[0][ia] & 127u) << 7;
#pragma unroll
        for (int ib = 0; ib < 16; ++ib) {
            if ((ia + 1) * (ib + 1) <= 16) {
                unsigned x = (skey(va + hkey_dec(L[1][ib])) & 0xFFFFC000u) | ea | (L[1][ib] & 127u);
#pragma unroll
                for (int i = 0; i < 16; ++i) { const unsigned t = umax_(C[i], x); x = umin_(C[i], x); C[i] = t; }
            }
        }
    }
    const unsigned short* srow = sc + (size_t)lane * 2048;
    float cv[16]; float mx = -3.0e38f;
#pragma unroll
    for (int i = 0; i < 16; ++i) { const unsigned e = C[i] & 0x3FFFu; cv[i] = h2f(srow[e >> 7]) + h2f(srow[128 + (e & 127u)]); mx = fmaxf(mx, cv[i]); }
    float es = 0.f;
#pragma unroll
    for (int i = 0; i < 16; ++i) { cv[i] = __expf(cv[i] - mx); es += cv[i]; }
    const float inv = 1.0f / es;
    const size_t item = ((size_t)tb * 64 + lane) * 8 + h;
    int* ids = (int*)(a.ws + WS_IDS) + item * 16; float* gts = (float*)(a.ws + WS_GATES) + item * 16;
#pragma unroll
    for (int i = 0; i < 16; i += 4) { *(v4u*)(ids + i) = (v4u){C[i] & 0x3FFFu, C[i + 1] & 0x3FFFu, C[i + 2] & 0x3FFFu, C[i + 3] & 0x3FFFu};
        *(f32x4*)(gts + i) = (f32x4){cv[i] * inv, cv[i + 1] * inv, cv[i + 2] * inv, cv[i + 3] * inv}; }
}

DEVI void cvt16_fp8(const v4u& r, float (&f)[16]) {
#pragma unroll
    for (int w = 0; w < 4; ++w) { const f32x2 lo = __builtin_amdgcn_cvt_pk_f32_fp8((int)r[w], false), hi = __builtin_amdgcn_cvt_pk_f32_fp8((int)r[w], true);
        f[4 * w] = lo[0]; f[4 * w + 1] = lo[1]; f[4 * w + 2] = hi[0]; f[4 * w + 3] = hi[1]; }
}
DEVI int bperm_i(int srclane, int v) { return __builtin_amdgcn_ds_bpermute(srclane << 2, v); }
DEVI void gx_issue(v4u (&row)[16], const unsigned char* tab, int id0, int id1, int g) {
#pragma unroll
    for (int it = 0; it < 16; ++it) { const int e = bperm_i((it * 8 + g) & 63, it < 8 ? id0 : id1); row[it] = *(const v4u*)(tab + (size_t)e * 128); }
}
#if PEER_U_INT8
DEVI void gu_math(const v4u (&row)[16], const v4u& xq, const v4u&, float* pd, int g, int i) {
    int d[16];
#pragma unroll
    for (int it = 0; it < 16; ++it) { int s = 0;
#pragma unroll
        for (int w = 0; w < 4; ++w) s = __builtin_amdgcn_sdot4((int)row[it][w], (int)xq[w], s, false);
        d[it] = s; }
    const bool b2 = i & 4, b1 = i & 2, b0 = i & 1;
    int y[2];
#pragma unroll
    for (int hh = 0; hh < 2; ++hh) {
        int w4[4], w2[2];
#pragma unroll
        for (int q = 0; q < 4; ++q) { const int send = b2 ? d[8 * hh + q] : d[8 * hh + q + 4], keep = b2 ? d[8 * hh + q + 4] : d[8 * hh + q]; w4[q] = keep + __shfl_xor(send, 4); }
#pragma unroll
        for (int q = 0; q < 2; ++q) { const int send = b1 ? w4[q] : w4[q + 2], keep = b1 ? w4[q + 2] : w4[q]; w2[q] = keep + __shfl_xor(send, 2); }
        { const int send = b0 ? w2[0] : w2[1], keep = b0 ? w2[1] : w2[0]; y[hh] = keep + __shfl_xor(send, 1); }
    }
    pd[i * 8 + g] = (float)y[0]; pd[(8 + i) * 8 + g] = (float)y[1];
}
#else
DEVI void gu_math(const v4u (&row)[16], const v4u& x0, const v4u& x1, float* pd, int g, int i) {
    float xs[16]; { float u0[8], u1[8]; unpack8(x0, u0); unpack8(x1, u1);
#pragma unroll
        for (int q = 0; q < 8; ++q) { xs[q] = u0[q]; xs[8 + q] = u1[q]; } }
    f32x2 xp2[8];
#pragma unroll
    for (int q = 0; q < 8; ++q) xp2[q] = (f32x2){xs[2 * q], xs[2 * q + 1]};
    float d[16];
#pragma unroll
    for (int it = 0; it < 16; ++it) { f32x2 sm = {0.f, 0.f};
#pragma unroll
        for (int w = 0; w < 4; ++w) { sm = __builtin_elementwise_fma(__builtin_amdgcn_cvt_pk_f32_fp8((int)row[it][w], false), xp2[2 * w], sm);
                                      sm = __builtin_elementwise_fma(__builtin_amdgcn_cvt_pk_f32_fp8((int)row[it][w], true), xp2[2 * w + 1], sm); }
        d[it] = sm[0] + sm[1];
        if ((it & 3) == 3) __builtin_amdgcn_sched_barrier(0); }
    const bool b2 = i & 4, b1 = i & 2, b0 = i & 1;
    float y[2];
#pragma unroll
    for (int hh = 0; hh < 2; ++hh) {
        float w4[4], w2[2];
#pragma unroll
        for (int q = 0; q < 4; ++q) { const float send = b2 ? d[8 * hh + q] : d[8 * hh + q + 4], keep = b2 ? d[8 * hh + q + 4] : d[8 * hh + q]; w4[q] = keep + __shfl_xor(send, 4); }
#pragma unroll
        for (int q = 0; q < 2; ++q) { const float send = b1 ? w4[q] : w4[q + 2], keep = b1 ? w4[q + 2] : w4[q]; w2[q] = keep + __shfl_xor(send, 2); }
        { const float send = b0 ? w2[0] : w2[1], keep = b0 ? w2[1] : w2[0]; y[hh] = keep + __shfl_xor(send, 1); }
    }
    pd[i * 8 + g] = y[0]; pd[(8 + i) * 8 + g] = y[1];
}
#endif
DEVI void gu_chunk(const Args& a, int j, int chunk, int wave, int lane) {
    unsigned char* ws = a.ws;
    const int g = lane >> 3, i = lane & 7;
    const unsigned char* tab = ws + WS_PU + (size_t)j * PNE * 128 + i * 16;
    float* PD = (float*)(ws + WS_PD) + (size_t)j * T * 128;
    const int* idbase = (const int*)(ws + WS_IDS);
#if PEER_U_INT8
    const unsigned char* xbase = ws + WS_X1Q + j * 128 + i * 16;
#define GU_X1(p) (*(const v4u*)(p))
#else
    const bf16* xbase = (const bf16*)(ws + WS_X1B) + j * 128 + i * 16;
#define GU_X1(p) (*(const v4u*)((p) + 8))
#endif
    const int t0 = chunk * 256 + wave * 32;
    v4u rowA[16], rowB[16];
    int ia0 = idbase[(size_t)t0 * 128 + lane], ia1 = idbase[(size_t)t0 * 128 + 64 + lane];
    int ib0 = idbase[(size_t)(t0 + 1) * 128 + lane], ib1 = idbase[(size_t)(t0 + 1) * 128 + 64 + lane];
    v4u xa0 = *(const v4u*)(xbase + (size_t)t0 * 1024), xa1 = GU_X1(xbase + (size_t)t0 * 1024), xb0, xb1;
    gx_issue(rowA, tab, ia0, ia1, g);
    for (int tt = 0; tt < 32; tt += 2) {
        const int t = t0 + tt; const bool more = tt + 2 < 32;
        if (more) { ia0 = idbase[(size_t)(t + 2) * 128 + lane]; ia1 = idbase[(size_t)(t + 2) * 128 + 64 + lane]; }
        xb0 = *(const v4u*)(xbase + (size_t)(t + 1) * 1024); xb1 = GU_X1(xbase + (size_t)(t + 1) * 1024);
        __builtin_amdgcn_sched_barrier(0);
        gx_issue(rowB, tab, ib0, ib1, g);
        __builtin_amdgcn_sched_barrier(0);
        gu_math(rowA, xa0, xa1, PD + (size_t)t * 128, g, i);
        __builtin_amdgcn_sched_barrier(0);
        if (more) { ib0 = idbase[(size_t)(t + 3) * 128 + lane]; ib1 = idbase[(size_t)(t + 3) * 128 + 64 + lane];
            xa0 = *(const v4u*)(xbase + (size_t)(t + 2) * 1024); xa1 = GU_X1(xbase + (size_t)(t + 2) * 1024); }
        __builtin_amdgcn_sched_barrier(0);
        if (more) gx_issue(rowA, tab, ia0, ia1, g);
        __builtin_amdgcn_sched_barrier(0);
        gu_math(rowB, xb0, xb1, PD + (size_t)(t + 1) * 128, g, i);
        __builtin_amdgcn_sched_barrier(0);
    }
}
DEVI void gv_math(const v4u (&row)[16], float c0, float c1, bf16* op, int g, int i, int lane) {
    const bool b5 = lane & 32, b4 = lane & 16, b3 = lane & 8;
    const int p = (b5 ? 4 : 0) + (b4 ? 2 : 0) + (b3 ? 1 : 0), colA = (p >> 1) * 4 + (p & 1);
    float cf[16];
#pragma unroll
    for (int it = 0; it < 16; ++it) cf[it] = __uint_as_float((unsigned)bperm_i((it * 8 + g) & 63, (int)__float_as_uint(it < 8 ? c0 : c1)));
#pragma unroll
    for (int pass = 0; pass < 2; ++pass) {
        f32x2 acc2[4];
#pragma unroll
        for (int c = 0; c < 4; ++c) acc2[c] = (f32x2){0.f, 0.f};
#pragma unroll
        for (int it = 0; it < 16; ++it) { const f32x2 c2 = {cf[it], cf[it]};
#pragma unroll
            for (int w = 0; w < 4; ++w) { const f32x2 v = pass ? __builtin_amdgcn_cvt_pk_f32_fp8((int)row[it][w], true) : __builtin_amdgcn_cvt_pk_f32_fp8((int)row[it][w], false); acc2[w] = __builtin_elementwise_fma(c2, v, acc2[w]); }
            if ((it & 3) == 3) __builtin_amdgcn_sched_barrier(0);
        }
        float acc[8];
#pragma unroll
        for (int c = 0; c < 4; ++c) { acc[2 * c] = acc2[c][0]; acc[2 * c + 1] = acc2[c][1]; }
        float w4[4], w2[2], y;
#pragma unroll
        for (int q = 0; q < 4; ++q) { const float send = b5 ? acc[q] : acc[q + 4], keep = b5 ? acc[q + 4] : acc[q]; w4[q] = keep + __shfl_xor(send, 32); }
#pragma unroll
        for (int q = 0; q < 2; ++q) { const float send = b4 ? w4[q] : w4[q + 2], keep = b4 ? w4[q + 2] : w4[q]; w2[q] = keep + __shfl_xor(send, 16); }
        { const float send = b3 ? w2[0] : w2[1], keep = b3 ? w2[1] : w2[0]; y = keep + __shfl_xor(send, 8); }
        op[i * 16 + colA + 2 * pass] = (bf16)f2bf(y);
    }
}
DEVI void gv_chunk(const Args& a, int j, int chunk, int wave, int lane) {
    unsigned char* ws = a.ws;
    const int g = lane >> 3, i = lane & 7;
    const unsigned char* tab = ws + WS_PV + (size_t)j * PNE * 128 + i * 16;
    const int* idbase = (const int*)(ws + WS_IDS); const float* cfbase = (const float*)(ws + WS_CF);
    bf16* obase = (bf16*)(ws + WS_OP) + j * 128;
    const int t0 = chunk * 256 + wave * 32;
    v4u rowA[16], rowB[16];
    int ia0 = idbase[(size_t)t0 * 128 + lane], ia1 = idbase[(size_t)t0 * 128 + 64 + lane];
    int ib0 = idbase[(size_t)(t0 + 1) * 128 + lane], ib1 = idbase[(size_t)(t0 + 1) * 128 + 64 + lane];
    float ca0 = cfbase[(size_t)t0 * 128 + lane], ca1 = cfbase[(size_t)t0 * 128 + 64 + lane], cb0, cb1;
    gx_issue(rowA, tab, ia0, ia1, g);
    for (int tt = 0; tt < 32; tt += 2) {
        const int t = t0 + tt; const bool more = tt + 2 < 32;
        if (more) { ia0 = idbase[(size_t)(t + 2) * 128 + lane]; ia1 = idbase[(size_t)(t + 2) * 128 + 64 + lane]; }
        cb0 = cfbase[(size_t)(t + 1) * 128 + lane]; cb1 = cfbase[(size_t)(t + 1) * 128 + 64 + lane];
        __builtin_amdgcn_sched_barrier(0);
        gx_issue(rowB, tab, ib0, ib1, g);
        __builtin_amdgcn_sched_barrier(0);
        gv_math(rowA, ca0, ca1, obase + (size_t)t * 1024, g, i, lane);
        __builtin_amdgcn_sched_barrier(0);
        if (more) { ib0 = idbase[(size_t)(t + 3) * 128 + lane]; ib1 = idbase[(size_t)(t + 3) * 128 + 64 + lane];
            ca0 = cfbase[(size_t)(t + 2) * 128 + lane]; ca1 = cfbase[(size_t)(t + 2) * 128 + 64 + lane]; }
        __builtin_amdgcn_sched_barrier(0);
        if (more) gx_issue(rowA, tab, ia0, ia1, g);
        __builtin_amdgcn_sched_barrier(0);
        gv_math(rowB, cb0, cb1, obase + (size_t)(t + 1) * 1024, g, i, lane);
        __builtin_amdgcn_sched_barrier(0);
    }
}
template <int WHICH> DEVI void sliced_phase(const Args& a, LAS unsigned char* lds, int wave, int lane, int ctr_off = 0) {
    unsigned* ctr = (unsigned*)(a.ws + WS_CTL) + (WHICH ? CW_GV : CW_GU) + ctr_off;
    volatile LAS unsigned* slot = (volatile LAS unsigned*)(lds + LDS_BYTES - 32);
#ifdef SLICE_BY_BLOCK
    const int xcc = (int)(blockIdx.x & 7u);
#else
    const int xcc = (int)(xb_xcc_id() & 7u);
#endif
    for (int pass = 0; pass < 8; ++pass) {
        const int j = (xcc + pass) & 7;
        for (;;) {
            __syncthreads();
            if (threadIdx.x == 0) *slot = __hip_atomic_fetch_add(ctr + 64 * j, 1u, __ATOMIC_RELAXED, __HIP_MEMORY_SCOPE_AGENT);
            __syncthreads();
            const unsigned c = *slot;
            if (c >= (unsigned)(T / 256)) break;
            if (WHICH) gv_chunk(a, j, (int)c, wave, lane); else gu_chunk(a, j, (int)c, wave, lane);
        }
    }
}
DEVI void coef_phase(const Args& a) {
    unsigned char* ws = a.ws;
    const float* PD = (const float*)(ws + WS_PD); const float* gts = (const float*)(ws + WS_GATES); float* CF = (float*)(ws + WS_CF);
    for (size_t i = (size_t)blockIdx.x * 512 + threadIdx.x; i < (size_t)T * 128 / 4; i += (size_t)gridDim.x * 512) {
        f32x4 s = *(const f32x4*)(PD + i * 4);
#pragma unroll
        for (int j = 1; j < 8; ++j) s += *(const f32x4*)(PD + (size_t)j * T * 128 + i * 4);
        const f32x4 gt = *(const f32x4*)(gts + i * 4);
        f32x4 o;
#if PEER_U_INT8
        const v4u ev = *(const v4u*)((const int*)(ws + WS_IDS) + i * 4);
        const float xsc = ((const float*)(ws + WS_XS))[i >> 5];
        const float* us = (const float*)(ws + WS_US);
#pragma unroll
        for (int q = 0; q < 4; ++q) o[q] = gt[q] * gelu_t(s[q] * xsc * us[ev[q]]) * (1.0f / PV_SCALE);
#else
#pragma unroll
        for (int q = 0; q < 4; ++q) o[q] = gt[q] * gelu_t(s[q] * (1.0f / PU_SCALE)) * (1.0f / PV_SCALE);
#endif
        *(f32x4*)(CF + i * 4) = o;
    }
}
template <int NT> DEVI void ln2_tokens(const Args& a, int t0, int tstride, int lane) {
    unsigned char* ws = a.ws;
    v4u xr[NT][2], orr[NT][2];
#pragma unroll
    for (int q = 0; q < NT; ++q) { const size_t o = (size_t)(t0 + q * tstride) * 1024 + lane * 16;
        const bf16* xp = (const bf16*)(ws + WS_X1B) + o; const bf16* ip = (const bf16*)(ws + WS_OP) + o;
        xr[q][0] = *(const v4u*)xp; xr[q][1] = *(const v4u*)(xp + 8); orr[q][0] = *(const v4u*)ip; orr[q][1] = *(const v4u*)(ip + 8); }
    const float* g2 = a.in[23] + lane * 16; const float* b2 = a.in[24] + lane * 16;
    f32x4 gg[4], bb[4];
#pragma unroll
    for (int i = 0; i < 4; ++i) { gg[i] = *(const f32x4*)(g2 + 4 * i); bb[i] = *(const f32x4*)(b2 + 4 * i); }
#pragma unroll
    for (int q = 0; q < NT; ++q) {
        float xf[16], acc[16];
        { float t0a[8], t1a[8]; unpack8(xr[q][0], t0a); unpack8(xr[q][1], t1a);
#pragma unroll
          for (int i = 0; i < 8; ++i) { xf[i] = t0a[i]; xf[8 + i] = t1a[i]; } }
        { float t0a[8], t1a[8]; unpack8(orr[q][0], t0a); unpack8(orr[q][1], t1a);
#pragma unroll
          for (int i = 0; i < 8; ++i) { acc[i] = t0a[i]; acc[8 + i] = t1a[i]; } }
        float s = 0.f;
#pragma unroll
        for (int i = 0; i < 16; ++i) { acc[i] += ALPHA * xf[i]; s += acc[i]; }
        const float mean = wave_sum(s) * (1.0f / 1024.0f); float qq = 0.f;
#pragma unroll
        for (int i = 0; i < 16; ++i) { acc[i] -= mean; qq += acc[i] * acc[i]; }
        const float rstd = rsqrtf(wave_sum(qq) * (1.0f / 1024.0f) + LN_EPS);
        float* op = a.out + (size_t)(t0 + q * tstride) * 1024 + lane * 16;
#pragma unroll
        for (int i = 0; i < 4; ++i) {
            f32x4 y; y[0] = acc[4 * i] * rstd * gg[i][0] + bb[i][0]; y[1] = acc[4 * i + 1] * rstd * gg[i][1] + bb[i][1]; y[2] = acc[4 * i + 2] * rstd * gg[i][2] + bb[i][2]; y[3] = acc[4 * i + 3] * rstd * gg[i][3] + bb[i][3];
            *(f32x4*)(op + 4 * i) = y;
        }
    }
}

enum Phase { PH_PREP = 0, PH_PROJ, PH_S5Z, PH_S5SCAN, PH_S5Y, PH_HGRN, PH_GLU, PH_MERGE, PH_OUT, PH_LN1, PH_SCORES, PH_TOPK, PH_GU, PH_COEF, PH_GV, PH_LN2, PH_COUNT };

template <class Epi> DEVI void run_gemm(LAS unsigned char* lds, const bf16* A, const bf16* Bt, int M, int N, int K, int lda, int ldb, const Epi& E) {
    pg8::Gemm g; g.A = A; g.Bt = Bt; g.M = M; g.N = N; g.K = K; g.lda = lda; g.ldb = ldb; g.sA = 0; g.sB = 0; g.nz = 1;
    pg8::StaticOrder S; S.init(M, N, gridDim.x, blockIdx.x, 1);
    pg8::gemm_phase<Epi, pg8::StaticOrder, true, true>(lds, g, S, E);
}
template <class Epi> DEVI void run_gemm_batched(LAS unsigned char* lds, const bf16* A, const bf16* Bt, int M, int N, int K, int lda, int ldb, size_t sA, size_t sB, int nz, const Epi& E, int cidx = -1) {
    pg8::Gemm g; g.A = A; g.Bt = Bt; g.M = M; g.N = N; g.K = K; g.lda = lda; g.ldb = ldb; g.sA = sA; g.sB = sB; g.nz = nz;
    pg8::StaticOrder S; S.init(M, N, gridDim.x, cidx < 0 ? (int)blockIdx.x : cidx, nz);
    pg8::gemm_phase<Epi, pg8::StaticOrder, true, true>(lds, g, S, E);
}

#ifndef MK_COOP
#define MK_COOP 1
#endif
__global__ void __launch_bounds__(512, 2) mk_fwd(Args a) {
    extern __shared__ __attribute__((aligned(16))) unsigned char smem[];
    LAS unsigned char* lds = (LAS unsigned char*)smem;
    cg::grid_group grid = cg::this_grid();
    const int tid = threadIdx.x, lane = tid & 63, wave = __builtin_amdgcn_readfirstlane(tid >> 6), G = gridDim.x;
    unsigned char* ws = a.ws;
    volatile LAS unsigned* bst = (volatile LAS unsigned*)(lds + LDS_BYTES - 16);
    if (tid < 2) bst[tid] = 0u;
    __syncthreads();
    const XcdBarrier xb = xcd_barrier_post((unsigned*)(ws + WS_CTL), bst);
#ifndef REP_PH
#define REP_PH -1
#endif
#ifndef REP_N
#define REP_N 1
#endif
#define PH_BEGIN(P) if (a.ph_lo <= (P) && (P) < a.ph_hi) { if (a.ph_lo < (P)) { if (MK_COOP && (P) == PH_PROJ) grid.sync(); else xcd_barrier(xb); } for (int rep_ = 0; rep_ < ((P) == REP_PH ? REP_N : 1); ++rep_) {
#define PH_END } }
    PH_BEGIN(PH_PREP) phase_prep(a, lds); for (int it = blockIdx.x; it < S5G * 8; it += G) s5_tables_item(a, lds, it); PH_END
    PH_BEGIN(PH_PROJ) EpiProj E; E.ws = ws; E.lb_logits = a.in[12];
        run_gemm(lds, (const bf16*)(ws + WS_XB), (const bf16*)(ws + WS_WINT), T, INC, 1024, 1024, 1024, E); PH_END
    PH_BEGIN(PH_S5Z)
        for (int it = blockIdx.x; it < 256; it += G) if ((it & 3) != 3) hgrn_segment<false>(a, lds, it);
        __syncthreads();
        EpiS5Z E; E.ws = ws;
        run_gemm_batched(lds, (const bf16*)(ws + WS_U5), (const bf16*)(ws + WS_WZ), 1024, 256, 1024, UK, 1024, (size_t)1024 * UK, (size_t)256 * 1024, S5G, E, G - 1 - (int)blockIdx.x); PH_END
    PH_BEGIN(PH_S5SCAN) s5_scan(a); PH_END
    PH_BEGIN(PH_S5Y) EpiS5Y E; E.ws = ws;
        run_gemm_batched(lds, (const bf16*)(ws + WS_U5), (const bf16*)(ws + WS_TY), 1024, 1024, UK, UK, UK, (size_t)1024 * UK, (size_t)1024 * UK, S5G, E); PH_END
    PH_BEGIN(PH_HGRN) for (int it = blockIdx.x; it < 256; it += G) hgrn_segment<true>(a, lds, it); PH_END
    PH_BEGIN(PH_GLU) EpiGlu E; E.ws = ws; E.bias = a.in[11];
        run_gemm(lds, (const bf16*)(ws + WS_Y2), (const bf16*)(ws + WS_WGLUT), T, 512, 512, 512, 512, E); PH_END
    PH_BEGIN(PH_MERGE) EpiMerge E; E.ws = ws;
        pg8::Gemm g; g.A = (const bf16*)(ws + WS_YAB); g.Bt = (const bf16*)(ws + WS_WPAT); g.M = T; g.N = 1024; g.K = 512; g.lda = 1024; g.ldb = 1024; g.sA = 512; g.sB = 512; g.nz = 2;
        pg8::ChainOrder S; S.init(T, 1024, G, blockIdx.x, 1);
        pg8::gemm_phase<EpiMerge, pg8::ChainOrder, true, true>(lds, g, S, E); PH_END
    PH_BEGIN(PH_OUT) EpiOut E; E.ws = ws; E.x = a.in[0];
        run_gemm(lds, (const bf16*)(ws + WS_MG), (const bf16*)(ws + WS_WOT), T, 1024, 1024, 1024, 1024, E); PH_END
    PH_BEGIN(PH_LN1) for (int r = blockIdx.x * 8 + wave; r < T; r += 8 * G * 4) ln1_rows<4>(a, r, 8 * G, lane); PH_END
    PH_BEGIN(PH_SCORES) EpiScores E; E.ws = ws;
        run_gemm(lds, (const bf16*)(ws + WS_X1B), (const bf16*)(ws + WS_WFT), T, 2048, 1024, 1024, 1024, E); PH_END
    PH_BEGIN(PH_TOPK) LAS float* stg = (LAS float*)(lds + wave * 9216);
        for (int it = blockIdx.x * 8 + wave; it < (T / 64) * PH; it += 8 * G) topk_block(a, stg, it, lane); PH_END
    PH_BEGIN(PH_GU) sliced_phase<0>(a, lds, wave, lane);
#ifdef PROBE_GU2
        sliced_phase<0>(a, lds, wave, lane, 64 * 16);
#endif
    PH_END
    PH_BEGIN(PH_COEF) coef_phase(a); PH_END
    PH_BEGIN(PH_GV) sliced_phase<1>(a, lds, wave, lane);
#ifdef PROBE_GV2
        sliced_phase<1>(a, lds, wave, lane, 64 * 16);
#endif
    PH_END
    PH_BEGIN(PH_LN2) for (int t = blockIdx.x * 8 + wave; t < T; t += 8 * G * 4) ln2_tokens<4>(a, t, 8 * G, lane); PH_END
}

#ifndef MK_ONE_LAUNCH
#define MK_ONE_LAUNCH 1
#endif

extern "C" void kernel_launch(void* const* d_in, const int* in_sizes, int n_in, void* d_out, int out_size, void* d_ws, size_t ws_size, hipStream_t stream) {
    static int grid = 0;
    if (grid == 0) {
        if (n_in != 25 || out_size != T * D || ws_size < WS_END) { fprintf(stderr, "kernel_launch: unexpected problem (n_in %d, out %d, ws %zu)\n", n_in, out_size, ws_size); grid = -1; return; }
        int dev = 0, cus = 0, per_cu = 0;
        if (hipGetDevice(&dev) != hipSuccess || hipDeviceGetAttribute(&cus, hipDeviceAttributeMultiprocessorCount, dev) != hipSuccess) { grid = -1; return; }
        if (hipFuncSetAttribute((const void*)mk_fwd, hipFuncAttributeMaxDynamicSharedMemorySize, LDS_BYTES) != hipSuccess) { fprintf(stderr, "kernel_launch: hipFuncSetAttribute failed\n"); grid = -1; return; }
        if (hipOccupancyMaxActiveBlocksPerMultiprocessor(&per_cu, (const void*)mk_fwd, 512, LDS_BYTES) != hipSuccess || per_cu < 1) { fprintf(stderr, "kernel_launch: occupancy query says %d\n", per_cu); per_cu = 1; }
        (void)hipGetLastError();
        grid = cus;
    }
    if (grid < 0) return;
    Args a{};
    for (int i = 0; i < 25; ++i) a.in[i] = (const float*)d_in[i];
    a.out = (float*)d_out; a.ws = (unsigned char*)d_ws;
#if MK_ONE_LAUNCH
    if (hipMemsetAsync((char*)d_ws + WS_CTL, 0, CTL_WORDS * 4, stream) != hipSuccess) { fprintf(stderr, "kernel_launch: memset of the barrier words failed\n"); return; }
    a.ph_lo = 0; a.ph_hi = PH_COUNT;
#if MK_COOP
    void* kargs[] = {&a};
    hipError_t e = hipLaunchCooperativeKernel((const void*)mk_fwd, dim3(grid), dim3(512), kargs, LDS_BYTES, stream);
    if (e != hipSuccess) fprintf(stderr, "kernel_launch: cooperative launch failed: %s (grid %d)\n", hipGetErrorString(e), grid);
#else
    hipLaunchKernelGGL(mk_fwd, dim3(grid), dim3(512), LDS_BYTES, stream, a);
#endif
#else
    for (int ph = 0; ph < PH_COUNT; ++ph) {
        a.ph_lo = ph; a.ph_hi = ph + 1;
        hipLaunchKernelGGL(mk_fwd, dim3(grid), dim3(512), LDS_BYTES, stream, a);
    }
#endif
}
```

```cpp
#include <hip/hip_runtime.h>
#include <hip/hip_cooperative_groups.h>
#include <cstdio>
#include <cstdint>
namespace cg = cooperative_groups;

#define DEVI __device__ __forceinline__
#define LAS __attribute__((address_space(3)))
typedef unsigned short bf16;
typedef unsigned v4u __attribute__((ext_vector_type(4)));
typedef unsigned v2u __attribute__((ext_vector_type(2)));
typedef float f32x4 __attribute__((ext_vector_type(4)));
typedef float f32x2 __attribute__((ext_vector_type(2)));
typedef short bf16x8 __attribute__((ext_vector_type(8)));
typedef float f32x16 __attribute__((ext_vector_type(16)));

constexpr int D = 1024, BATCH = 16, SEQ = 4096, T = BATCH * SEQ;
constexpr int S5W = 512, S5H = 16, S5G = 32, S5P = 64;
constexpr int HW = 512, HD = 128, HH = 4;
constexpr int PH = 8, PK = 16, PNK = 128, PNE = 16384;
constexpr int INC = 4608;
constexpr float ALPHA = 1.189207115002721f;
constexpr float LN_EPS = 1e-5f, RMS_EPS = 1e-6f;
constexpr int NCH = 64;
constexpr int UK = 1152;

constexpr size_t MiB = 1u << 20;
constexpr size_t WS_XB = 0;
constexpr size_t WS_Y2 = 0;
constexpr size_t WS_YAB = 64 * MiB;
constexpr size_t WS_X1B = 0;
constexpr size_t WS_U5 = 128 * MiB;
constexpr size_t WS_IDS = 128 * MiB;
constexpr size_t WS_GATES = 160 * MiB;
constexpr size_t WS_Q = 200 * MiB;
constexpr size_t WS_LF = 264 * MiB;
constexpr size_t WS_MG = 264 * MiB;
constexpr size_t WS_VV = 392 * MiB;
constexpr size_t WS_GS = 456 * MiB;
constexpr size_t WS_GA = 520 * MiB;
constexpr size_t WS_GB = 648 * MiB;
constexpr size_t WS_H1 = 392 * MiB;
constexpr size_t WS_SC = 264 * MiB;
constexpr size_t WS_PD = 264 * MiB;
constexpr size_t WS_OP = 264 * MiB;
constexpr size_t WS_CF = 520 * MiB;
constexpr size_t WS_WINT = 776 * MiB;
constexpr size_t WS_WGLUT = 785 * MiB;
constexpr size_t WS_WPAT = 786 * MiB;
constexpr size_t WS_WOT = 788 * MiB;
constexpr size_t WS_WFT = 790 * MiB;
constexpr size_t WS_WZ = 794 * MiB;
constexpr size_t WS_TY = 810 * MiB;
constexpr size_t WS_PU = 882 * MiB;
constexpr size_t WS_PV = 914 * MiB;
constexpr size_t WS_Z = 946 * MiB;
constexpr size_t WS_L64 = 962 * MiB;
constexpr size_t WS_HGS = 963 * MiB;
constexpr size_t WS_HGD = 979 * MiB;
constexpr size_t WS_US = 979 * MiB + 256 * 1024;
constexpr size_t WS_XS = 979 * MiB + 512 * 1024;
constexpr size_t WS_X1Q = 192 * MiB;
constexpr size_t WS_CTL = 980 * MiB;
constexpr size_t WS_END = 981 * MiB;

#ifndef PEER_FP8
#define PEER_FP8 1
#endif
constexpr float PU_SCALE = 256.0f, PV_SCALE = 16.0f;
#ifndef PEER_U_INT8
#define PEER_U_INT8 1
#endif
constexpr int CTL_WORDS = 8192;
constexpr int CW_GU = 4096, CW_GV = 4096 + 64 * 8;
constexpr int LDS_BYTES = 147456;

DEVI unsigned f2bf(float f) { unsigned u = __float_as_uint(f); return (u + 0x7fffu + ((u >> 16) & 1u)) >> 16; }
DEVI unsigned pk2(float lo, float hi) { return f2bf(lo) | (f2bf(hi) << 16); }
typedef _Float16 h16x2 __attribute__((ext_vector_type(2)));
DEVI unsigned pkh2(float a, float b) { const h16x2 v = {(_Float16)a, (_Float16)b}; return __builtin_bit_cast(unsigned, v); }
DEVI float h2f(unsigned short b) { return (float)__builtin_bit_cast(_Float16, b); }
DEVI float bflo(unsigned w) { return __uint_as_float(w << 16); }
DEVI float bfhi(unsigned w) { return __uint_as_float(w & 0xffff0000u); }
DEVI float bf2f(bf16 b) { return __uint_as_float(((unsigned)b) << 16); }
DEVI float sigm(float x) { return __builtin_amdgcn_rcpf(1.0f + __builtin_amdgcn_exp2f(-1.4426950408889634f * x)); }
DEVI float silu(float x) { return x * sigm(x); }
DEVI float gelu_t(float x) { return x * sigm(1.5957691216057308f * (x + 0.044715f * x * x * x)); }
DEVI float wave_sum(float v) {
#pragma unroll
    for (int o = 1; o < 64; o <<= 1) v += __shfl_xor(v, o);
    return v;
}
DEVI float wave_max(float v) {
#pragma unroll
    for (int o = 1; o < 64; o <<= 1) v = fmaxf(v, __shfl_xor(v, o));
    return v;
}

struct Args { const float* in[25]; float* out; unsigned char* ws; int ph_lo, ph_hi; };

#define XB_TMO      128
#define XB_XCNT(j)  (256  + 64 * (j))
#define XB_XSUB(j)  (1280 + 64 * (j))
#define XB_XGEN(j)  (2304 + 64 * (j))
#define XB_TOP      3328
#define XB_TOPGEN   3392
#define XCD_BAR_WORDS 3456
#define XB_SPIN_CAP (1u << 20)

__device__ __forceinline__ unsigned xb_ld(unsigned* p)              { return __hip_atomic_load(p, __ATOMIC_RELAXED, __HIP_MEMORY_SCOPE_AGENT); }
__device__ __forceinline__ unsigned xb_add(unsigned* p, unsigned v) { return __hip_atomic_fetch_add(p, v, __ATOMIC_RELAXED, __HIP_MEMORY_SCOPE_AGENT); }
__device__ __forceinline__ unsigned xb_xcc_id() { return (unsigned)__builtin_amdgcn_s_getreg((3 << 11) | 20) & 0xFu; }
#define XB_SPIN(cond, bar) do { unsigned _sp = 0; while (cond) { __builtin_amdgcn_s_sleep(1); \
    if ((++_sp & 255u) == 0u) { if (xb_ld(&(bar)[XB_TMO])) break; if (_sp > XB_SPIN_CAP) { atomicAdd(&(bar)[XB_TMO], 1u); break; } } } } while (0)

struct XcdBarrier {
    unsigned* bar; unsigned x;
    volatile LAS unsigned* st;
};

__device__ __forceinline__ XcdBarrier xcd_barrier_post(unsigned* bar, volatile LAS unsigned* st) {
    XcdBarrier b; b.bar = bar; b.x = xb_xcc_id(); b.st = st;
    if (threadIdx.x == 0) (void)xb_add(&bar[XB_XCNT(b.x)], 1u);
    return b;
}
__device__ __forceinline__ void xcd_barrier_complete(unsigned* bar, unsigned x, unsigned& nloc, unsigned& nx) {
    const unsigned G = gridDim.x * gridDim.y * gridDim.z;
    unsigned sum, cnt, mine, sp = 0u;
    for (;;) {
        sum = 0u; cnt = 0u; mine = 0u;
#pragma unroll
        for (unsigned j = 0; j < 16; ++j) { const unsigned c = xb_ld(&bar[XB_XCNT(j)]); sum += c; cnt += (c > 0u) ? 1u : 0u; mine = (j == x) ? c : mine; }
        if (sum == G) break;
        __builtin_amdgcn_s_sleep(1);
        if ((++sp & 255u) == 0u) { if (xb_ld(&bar[XB_TMO])) break; if (sp > XB_SPIN_CAP) { atomicAdd(&bar[XB_TMO], 1u); break; } }
    }
    nloc = mine > 0u ? mine : 1u; nx = cnt > 0u ? cnt : 1u;
}

__device__ __forceinline__ void xcd_barrier(const XcdBarrier& b) {
    asm volatile("s_waitcnt vmcnt(0)" ::: "memory");
    __syncthreads();
    if (threadIdx.x == 0) {
        unsigned* bar = b.bar;
        __builtin_amdgcn_s_waitcnt(0);
        unsigned nloc = b.st[0], nx = b.st[1];
        if (nloc == 0u) { xcd_barrier_complete(bar, b.x, nloc, nx); b.st[0] = nloc; b.st[1] = nx; }
        const unsigned old = xb_add(&bar[XB_XSUB(b.x)], 1u);
        const unsigned gen = old / nloc;
        if (old + 1u == (gen + 1u) * nloc) {
            __builtin_amdgcn_fence(__ATOMIC_RELEASE, "agent");
            asm volatile("s_waitcnt vmcnt(0)" ::: "memory");
            const unsigned og = xb_add(&bar[XB_TOP], 1u);
            const unsigned tg = og / nx;
            if (og + 1u == (tg + 1u) * nx) xb_add(&bar[XB_TOPGEN], 1u);
            else XB_SPIN(xb_ld(&bar[XB_TOPGEN]) == tg, bar);
            __builtin_amdgcn_fence(__ATOMIC_ACQUIRE, "agent");
            xb_add(&bar[XB_XGEN(b.x)], 1u);
            asm volatile("s_waitcnt vmcnt(0)" ::: "memory");
        } else {
            XB_SPIN(xb_ld(&bar[XB_XGEN(b.x)]) == gen, bar);
            __builtin_amdgcn_fence(__ATOMIC_ACQUIRE, "agent");
            asm volatile("s_waitcnt vmcnt(0)" ::: "memory");
        }
    }
    __syncthreads();
}


namespace pg8 {
#define PG8_LAS __attribute__((address_space(3)))
typedef unsigned short bf16_t;
constexpr int BM = 256, BK = 64, HALF = 128, HTB = HALF * BK * 2  , STAGE_BYTES = 8 * HTB, NXCD = 8, WGM = 8;

__host__ __device__ __forceinline__ int lds_byte(int r, int c) { const int st = (r >> 4) * 2 + (c >> 5), rr = r & 15, cc = c & 31, ob = rr * 64 + cc * 2; return st * 1024 + (ob ^ (((ob >> 9) & 1) << 5)); }
__host__ __device__ __forceinline__ void stage_rc(int b, int& R, int& C) { const int st = b / 1024, sb = b % 1024, swz = sb ^ (((sb >> 9) & 1) << 5); R = (st >> 1) * 16 + swz / 64; C = (st & 1) * 32 + (swz % 64) / 2; }
__host__ __device__ __forceinline__ int perm32(int rho) { const int n = rho >> 4, i = rho & 15; return 8 * (i >> 2) + 4 * n + (i & 3); }

struct Unit { int pm, pn, z; };
struct Gemm { const bf16_t* A; const bf16_t* Bt; int M, N, K, lda, ldb; size_t sA, sB; int nz; };

struct StaticOrder {
    int nM, nN, nwg, G, c, nz;
    __host__ __device__ void init(int M, int N, int G_, int c_, int nz_ = 1) { nM = M / BM; nN = N / BM; nwg = nM * nN; G = G_; c = c_; nz = nz_; }
    __host__ __device__ bool next(int i, Unit& u) const {
        const long L0 = (long)i * G + c; if (L0 >= (long)nwg * nz) return false;
        u.z = (int)(L0 / nwg); int wgid = (int)(L0 % nwg); { const int q = nwg / NXCD, r = nwg % NXCD, xcd = wgid % NXCD, off = wgid / NXCD; wgid = (xcd < r ? xcd * (q + 1) : r * (q + 1) + (xcd - r) * q) + off; }
        const int nig = WGM * nN, gid = wgid / nig, fm = gid * WGM, gsz = (nM - fm) < WGM ? (nM - fm) : WGM;
        u.pm = fm + ((wgid % nig) % gsz); u.pn = (wgid % nig) / gsz; return true;
    }
    __device__ __forceinline__ void a_ready(const Unit&) const {}
    __device__ __forceinline__ void done(const Unit&) const {}
};

struct ChainOrder : StaticOrder {
    __host__ __device__ bool next(int i, Unit& u) const { if (!StaticOrder::next(i >> 1, u)) return false; u.z = i & 1; return true; }
};
__device__ __forceinline__ unsigned cvt_pk_bf16(float lo, float hi) { unsigned r; asm volatile("v_cvt_pk_bf16_f32 %0, %1, %2" : "=v"(r) : "v"(lo), "v"(hi)); return r; }

template <class Epi, class Sched, bool ALIGN_EPI = false, bool SP2 = false>
__device__ __forceinline__ void gemm_phase(PG8_LAS unsigned char* lds, const Gemm g, const Sched& S, const Epi& E) {
    const int tid = threadIdx.x, wid = __builtin_amdgcn_readfirstlane(tid >> 6), lane = tid & 63, wr = wid >> 2, wc = wid & 3, fr = lane & 15, fq = lane >> 4;
    const int K = g.K, nt = K / BK;
    unsigned voffA[2], voffB[2];
#pragma unroll
    for (int i = 0; i < 2; ++i) { int R, C; stage_rc(tid * 16 + i * 8192, R, C); const int Rb = Epi::PERM ? ((R & ~31) + perm32(R & 31)) : R;
        voffA[i] = (unsigned)(R * g.lda + C) * 2u; voffB[i] = (unsigned)(Rb * g.ldb + C) * 2u; }
    const size_t kstep = (size_t)(BK * 2);
    const size_t hstepA = (size_t)HALF * g.lda * 2, hstepB = (size_t)HALF * g.ldb * 2;
    const size_t tstepA = 2 * hstepA, tstepB = 2 * hstepB;
    const unsigned ldsw = (unsigned)wid * 1024u;
    const int aoff = lds_byte(wr * 64 + fr, fq * 8), boff = lds_byte(wc * 32 + fr, fq * 8);
#define PG8_SA(b, h) (((b) * 2 + (h)) * HTB)
#define PG8_SB(b, h) ((4 + (b) * 2 + (h)) * HTB)
#define PG8_STAGE(bufoff, gbase, voff) do { _Pragma("unroll") for (int _i = 0; _i < 2; ++_i) \
        __builtin_amdgcn_global_load_lds((const unsigned*)((const char*)(gbase) + (voff)[_i]), (PG8_LAS unsigned*)(lds + (bufoff) + ldsw + _i * 8192), 16, 0, 0); } while (0)
#define PG8_LDA(dst, b, h) do { _Pragma("unroll") for (int m = 0; m < 4; ++m) _Pragma("unroll") for (int k = 0; k < 2; ++k) dst[m][k] = *(const PG8_LAS bf16x8*)(lds + PG8_SA(b, h) + aoff + m * 2048 + k * 1024); } while (0)
#define PG8_LDB(dst, b, h) do { _Pragma("unroll") for (int n = 0; n < 2; ++n) _Pragma("unroll") for (int k = 0; k < 2; ++k) dst[n][k] = *(const PG8_LAS bf16x8*)(lds + PG8_SB(b, h) + boff + n * 2048 + k * 1024); } while (0)
#define PG8_MMA(ai, bj, At, Bt) do { __builtin_amdgcn_s_setprio(1); _Pragma("unroll") for (int m = 0; m < 4; ++m) _Pragma("unroll") for (int n = 0; n < 2; ++n) _Pragma("unroll") for (int k = 0; k < 2; ++k) \
        acc[ai][bj][m][n] = __builtin_amdgcn_mfma_f32_16x16x32_bf16(Bt[n][k], At[m][k], acc[ai][bj][m][n], 0, 0, 0); __builtin_amdgcn_s_setprio(0); } while (0)
#define PG8_WAIT_V(n) asm volatile("s_waitcnt vmcnt(" #n ")" ::: "memory")
#define PG8_WAIT_L(n) asm volatile("s_waitcnt lgkmcnt(" #n ")" ::: "memory")
#define PG8_BAR __builtin_amdgcn_s_barrier()
#define PG8_SCHED __builtin_amdgcn_sched_barrier(0)
    Unit cur, nxt; int ui = 0;
    if (!S.next(0, cur)) return;
    f32x4 acc[2][2][4][2];
#pragma unroll
    for (int a = 0; a < 2; ++a)
#pragma unroll
        for (int b = 0; b < 2; ++b)
#pragma unroll
            for (int m = 0; m < 4; ++m)
#pragma unroll
                for (int n = 0; n < 2; ++n) acc[a][b][m][n] = (f32x4){0.f, 0.f, 0.f, 0.f};
    bf16x8 At[4][2], B0[2][2], B1[2][2];
    const char* cA = (const char*)(g.A + (size_t)cur.z * g.sA) + (size_t)cur.pm * tstepA; const char* cB = (const char*)(g.Bt + (size_t)cur.z * g.sB) + (size_t)cur.pn * tstepB;
    S.a_ready(cur);
    if constexpr (SP2) {
        PG8_STAGE(PG8_SB(0, 0), cB, voffB); PG8_STAGE(PG8_SB(0, 1), cB + hstepB, voffB); PG8_STAGE(PG8_SA(0, 0), cA, voffA); PG8_STAGE(PG8_SA(0, 1), cA + hstepA, voffA);
        if (wr == 1) PG8_BAR;
        PG8_WAIT_V(2); PG8_BAR;
        PG8_STAGE(PG8_SB(1, 0), cB + kstep, voffB); PG8_STAGE(PG8_SA(1, 0), cA + kstep, voffA); PG8_STAGE(PG8_SB(1, 1), cB + hstepB + kstep, voffB);
        PG8_WAIT_V(6); PG8_BAR;
    } else {
        PG8_STAGE(PG8_SB(0, 0), cB, voffB); PG8_STAGE(PG8_SA(0, 0), cA, voffA); PG8_STAGE(PG8_SB(0, 1), cB + hstepB, voffB); PG8_STAGE(PG8_SA(0, 1), cA + hstepA, voffA);
        if (wr == 1) PG8_BAR;
        PG8_WAIT_V(4); PG8_BAR;
        PG8_STAGE(PG8_SB(1, 0), cB + kstep, voffB); PG8_STAGE(PG8_SA(1, 0), cA + kstep, voffA); PG8_STAGE(PG8_SB(1, 1), cB + hstepB + kstep, voffB);
        PG8_WAIT_V(6); PG8_BAR;
    }
    for (;;) {
        const bool has_next = S.next(ui + 1, nxt);
        const char* nA = has_next ? (const char*)(g.A + (size_t)nxt.z * g.sA) + (size_t)nxt.pm * tstepA : cA; const char* nB = has_next ? (const char*)(g.Bt + (size_t)nxt.z * g.sB) + (size_t)nxt.pn * tstepB : cB;
        for (int t = 0; t < nt; t += 2) {
            const bool last = (t == nt - 2);
            const char* a1 = cA + (size_t)(t + 1) * kstep;
            const char* a2 = last ? nA : cA + (size_t)(t + 2) * kstep; const char* b2 = last ? nB : cB + (size_t)(t + 2) * kstep;
            const char* a3 = a2 + kstep; const char* b3 = b2 + kstep;
            if (last && has_next) S.a_ready(nxt);
            if constexpr (SP2) {
            PG8_LDB(B0, 0, 0); PG8_LDB(B1, 0, 1); PG8_SCHED; PG8_LDA(At, 0, 0); PG8_STAGE(PG8_SA(1, 1), a1 + hstepA, voffA);
            PG8_WAIT_V(8); PG8_WAIT_L(0); PG8_BAR; PG8_MMA(0, 0, At, B0); PG8_MMA(0, 1, At, B1); PG8_BAR; PG8_SCHED;
            PG8_LDA(At, 0, 1); PG8_STAGE(PG8_SB(0, 0), b2, voffB); PG8_STAGE(PG8_SB(0, 1), b2 + hstepB, voffB); PG8_STAGE(PG8_SA(0, 0), a2, voffA);
            PG8_WAIT_V(8); PG8_WAIT_L(0); PG8_BAR; PG8_MMA(1, 0, At, B0); PG8_MMA(1, 1, At, B1); PG8_BAR; PG8_SCHED;
            PG8_LDB(B0, 1, 0); PG8_LDB(B1, 1, 1); PG8_SCHED; PG8_LDA(At, 1, 0); PG8_STAGE(PG8_SA(0, 1), a2 + hstepA, voffA);
            PG8_WAIT_V(8); PG8_WAIT_L(0); PG8_BAR; PG8_MMA(0, 0, At, B0); PG8_MMA(0, 1, At, B1); PG8_BAR; PG8_SCHED;
            PG8_LDA(At, 1, 1); PG8_STAGE(PG8_SB(1, 0), b3, voffB); PG8_STAGE(PG8_SB(1, 1), b3 + hstepB, voffB); PG8_STAGE(PG8_SA(1, 0), a3, voffA);
            PG8_WAIT_V(8); PG8_WAIT_L(0); PG8_BAR; PG8_MMA(1, 0, At, B0); PG8_MMA(1, 1, At, B1); PG8_BAR; PG8_SCHED;
            } else {
            PG8_LDB(B0, 0, 0); PG8_SCHED; PG8_LDA(At, 0, 0); PG8_STAGE(PG8_SA(1, 1), a1 + hstepA, voffA);
            PG8_WAIT_L(8); PG8_BAR; PG8_WAIT_L(0); PG8_MMA(0, 0, At, B0); PG8_BAR; PG8_SCHED;
            PG8_LDB(B1, 0, 1); PG8_STAGE(PG8_SB(0, 0), b2, voffB);
            PG8_BAR; PG8_WAIT_L(0); PG8_MMA(0, 1, At, B1); PG8_BAR;
            PG8_LDA(At, 0, 1); PG8_STAGE(PG8_SA(0, 0), a2, voffA);
            PG8_BAR; PG8_WAIT_L(0); PG8_MMA(1, 0, At, B0); PG8_BAR; PG8_SCHED;
            PG8_STAGE(PG8_SB(0, 1), b2 + hstepB, voffB);
            PG8_WAIT_V(6); PG8_BAR; PG8_MMA(1, 1, At, B1); PG8_BAR;
            PG8_LDB(B0, 1, 0); PG8_SCHED; PG8_LDA(At, 1, 0); PG8_STAGE(PG8_SA(0, 1), a2 + hstepA, voffA);
            PG8_WAIT_L(8); PG8_BAR; PG8_WAIT_L(0); PG8_MMA(0, 0, At, B0); PG8_BAR; PG8_SCHED;
            PG8_LDB(B1, 1, 1); PG8_STAGE(PG8_SB(1, 0), b3, voffB);
            PG8_BAR; PG8_WAIT_L(0); PG8_MMA(0, 1, At, B1); PG8_BAR;
            PG8_LDA(At, 1, 1); PG8_STAGE(PG8_SA(1, 0), a3, voffA);
            PG8_BAR; PG8_WAIT_L(0); PG8_MMA(1, 0, At, B0); PG8_BAR; PG8_SCHED;
            PG8_STAGE(PG8_SB(1, 1), b3 + hstepB, voffB);
            PG8_WAIT_V(6); PG8_BAR; PG8_MMA(1, 1, At, B1); PG8_BAR;
            }
        }
        if constexpr (ALIGN_EPI) { if (wr == 0) PG8_BAR; }
        if constexpr (!Epi::AFTER_DRAIN) { E(acc, cur, wr, wc, fr, fq); S.done(cur); }
        if (!has_next) break;
        if (!Epi::CHAIN || nxt.z == 0) {
#pragma unroll
        for (int a = 0; a < 2; ++a)
#pragma unroll
            for (int b = 0; b < 2; ++b)
#pragma unroll
                for (int m = 0; m < 4; ++m)
#pragma unroll
                    for (int n = 0; n < 2; ++n) acc[a][b][m][n] = (f32x4){0.f, 0.f, 0.f, 0.f};
        }
        cur = nxt; cA = nA; cB = nB; ++ui;
        if constexpr (ALIGN_EPI) { if (wr == 1) PG8_BAR; }
    }
    PG8_WAIT_V(0);
    if constexpr (!ALIGN_EPI) { if (wr == 0) PG8_BAR; }
    PG8_BAR;
    if constexpr (Epi::AFTER_DRAIN) { E.fused(acc, cur, wr, wc, fr, fq, lds, wid, lane); S.done(cur); }
#undef PG8_SA
#undef PG8_SB
#undef PG8_STAGE
#undef PG8_LDA
#undef PG8_LDB
#undef PG8_MMA
#undef PG8_WAIT_V
#undef PG8_WAIT_L
#undef PG8_BAR
#undef PG8_SCHED
}
}

typedef f32x4 AccT[2][2][4][2];
DEVI v4u pack8(const f32x4& a, const f32x4& b) { v4u w; w.x = pk2(a[0], a[1]); w.y = pk2(a[2], a[3]); w.z = pk2(b[0], b[1]); w.w = pk2(b[2], b[3]); return w; }
DEVI void unpack8(const v4u& w, float (&f)[8]) { f[0] = bflo(w.x); f[1] = bfhi(w.x); f[2] = bflo(w.y); f[3] = bfhi(w.y); f[4] = bflo(w.z); f[5] = bfhi(w.z); f[6] = bflo(w.w); f[7] = bfhi(w.w); }

struct EpiProj {
    static constexpr bool PERM = true, AFTER_DRAIN = false, CHAIN = false;
    unsigned char* ws; const float* lb_logits;
    template <int TYPE> DEVI void run(const AccT& acc, const pg8::Unit& u, int wr, int wc, int fr, int fq) const {
        const int row0 = u.pm * 256 + wr * 64 + fr;
#pragma unroll
        for (int bj = 0; bj < 2; ++bj) {
            const int col = u.pn * 256 + bj * 128 + wc * 32 + 8 * fq;
            float lb[8];
            if (TYPE == 2) {
#pragma unroll
                for (int j = 0; j < 8; ++j) { const int fc = col - 1024 + j; lb[j] = 1.0f / (1.0f + __expf(lb_logits[512 + fc] - lb_logits[fc])); }
            }
#pragma unroll
            for (int ai = 0; ai < 2; ++ai)
#pragma unroll
                for (int m = 0; m < 4; ++m) {
                    const int row = row0 + ai * 128 + m * 16;
                    f32x4 v0 = acc[ai][bj][m][0], v1 = acc[ai][bj][m][1];
                    if (TYPE == 0) {
                        const int g = col >> 4, h0 = col & 15, b = row >> 12, t = row & 4095, c = t >> 6, j = t & 63;
                        bf16* p = (bf16*)(ws + WS_U5) + ((size_t)(g * 1024 + b * 64 + c) * UK + j * 16 + h0);
                        *(v4u*)p = pack8(v0, v1);
                    } else if (TYPE == 1 || TYPE == 4) {
#pragma unroll
                        for (int j = 0; j < 4; ++j) { v0[j] = silu(v0[j]); v1[j] = silu(v1[j]); }
                        if (TYPE == 1) *(v4u*)((bf16*)(ws + WS_Q) + (size_t)row * 512 + (col - 512)) = pack8(v0, v1);
                        else           *(v4u*)((bf16*)(ws + WS_GS) + (size_t)row * 512 + (col - 2048)) = pack8(v0, v1);
                    } else if (TYPE == 2) {
#pragma unroll
                        for (int j = 0; j < 4; ++j) { v0[j] = __logf(lb[j] + (1.0f - lb[j]) * sigm(v0[j])); v1[j] = __logf(lb[4 + j] + (1.0f - lb[4 + j]) * sigm(v1[j])); }
                        float* p = (float*)(ws + WS_LF) + (size_t)row * 512 + (col - 1024);
                        *(f32x4*)p = v0; *(f32x4*)(p + 4) = v1;
                    } else if (TYPE == 3) {
                        *(v4u*)((bf16*)(ws + WS_VV) + (size_t)row * 512 + (col - 1536)) = pack8(v0, v1);
                    } else {
#pragma unroll
                        for (int j = 0; j < 4; ++j) { v0[j] = sigm(v0[j]); v1[j] = sigm(v1[j]); }
                        if (TYPE == 5) *(v4u*)((bf16*)(ws + WS_GA) + (size_t)row * 1024 + (col - 2560)) = pack8(v0, v1);
                        else           *(v4u*)((bf16*)(ws + WS_GB) + (size_t)row * 1024 + (col - 3584)) = pack8(v0, v1);
                    }
                }
        }
    }
    DEVI void operator()(const AccT& acc, const pg8::Unit& u, int wr, int wc, int fr, int fq) const {
        const int pn = u.pn;
        if (pn < 2) run<0>(acc, u, wr, wc, fr, fq);
        else if (pn < 4) run<1>(acc, u, wr, wc, fr, fq);
        else if (pn < 6) run<2>(acc, u, wr, wc, fr, fq);
        else if (pn < 8) run<3>(acc, u, wr, wc, fr, fq);
        else if (pn < 10) run<4>(acc, u, wr, wc, fr, fq);
        else if (pn < 14) run<5>(acc, u, wr, wc, fr, fq);
        else run<6>(acc, u, wr, wc, fr, fq);
    }
};

struct EpiGlu {
    static constexpr bool PERM = true, AFTER_DRAIN = false, CHAIN = false;
    unsigned char* ws; const float* bias;
    DEVI void operator()(const AccT& acc, const pg8::Unit& u, int wr, int wc, int fr, int fq) const {
        const int row0 = u.pm * 256 + wr * 64 + fr;
#pragma unroll
        for (int bj = 0; bj < 2; ++bj) {
            const int col = u.pn * 256 + bj * 128 + wc * 32 + 8 * fq;
            const f32x4 b0 = *(const f32x4*)(bias + col), b1 = *(const f32x4*)(bias + col + 4);
            v4u yw[2][4];
#pragma unroll
            for (int ai = 0; ai < 2; ++ai)
#pragma unroll
                for (int m = 0; m < 4; ++m) yw[ai][m] = *(const v4u*)((const bf16*)(ws + WS_Y2) + (size_t)(row0 + ai * 128 + m * 16) * 512 + col);
            __builtin_amdgcn_sched_barrier(0);
#pragma unroll
            for (int ai = 0; ai < 2; ++ai)
#pragma unroll
                for (int m = 0; m < 4; ++m) {
                    const int row = row0 + ai * 128 + m * 16;
                    float y[8]; unpack8(yw[ai][m], y);
                    f32x4 v0 = acc[ai][bj][m][0] + b0, v1 = acc[ai][bj][m][1] + b1;
#pragma unroll
                    for (int j = 0; j < 4; ++j) { v0[j] = y[j] * sigm(v0[j]); v1[j] = y[4 + j] * sigm(v1[j]); }
                    *(v4u*)((bf16*)(ws + WS_YAB) + (size_t)row * 1024 + col) = pack8(v0, v1);
                }
            __builtin_amdgcn_sched_barrier(0);
        }
    }
};

struct EpiMerge {
    static constexpr bool PERM = true, AFTER_DRAIN = false, CHAIN = true;
    unsigned char* ws;
    DEVI void operator()(AccT& acc, const pg8::Unit& u, int wr, int wc, int fr, int fq) const {
        const int row0 = u.pm * 256 + wr * 64 + fr;
#pragma unroll
        for (int bj = 0; bj < 2; ++bj) {
            const int col = u.pn * 256 + bj * 128 + wc * 32 + 8 * fq;
#pragma unroll
            for (int ai = 0; ai < 2; ++ai) {
                v4u bw[4], aw[4];
#pragma unroll
                for (int m = 0; m < 4; ++m) { const size_t off = (size_t)(row0 + ai * 128 + m * 16) * 1024 + col;
                    bw[m] = *(const v4u*)((const bf16*)(ws + WS_GB) + off);
                    if (u.z == 0) aw[m] = *(const v4u*)((const bf16*)(ws + WS_GA) + off); }
                __builtin_amdgcn_sched_barrier(0);
#pragma unroll
                for (int m = 0; m < 4; ++m) {
                    const size_t off = (size_t)(row0 + ai * 128 + m * 16) * 1024 + col;
                    float gb[8]; unpack8(bw[m], gb);
                    if (u.z == 0) {
                        float ga[8]; unpack8(aw[m], ga);
#pragma unroll
                        for (int j = 0; j < 4; ++j) { acc[ai][bj][m][0][j] *= ga[j] * __builtin_amdgcn_rcpf(gb[j]); acc[ai][bj][m][1][j] *= ga[4 + j] * __builtin_amdgcn_rcpf(gb[4 + j]); }
                    } else {
                        f32x4 v0 = acc[ai][bj][m][0], v1 = acc[ai][bj][m][1];
#pragma unroll
                        for (int j = 0; j < 4; ++j) { v0[j] *= gb[j]; v1[j] *= gb[4 + j]; }
                        *(v4u*)((bf16*)(ws + WS_MG) + off) = pack8(v0, v1);
                    }
                }
                __builtin_amdgcn_sched_barrier(0);
            }
        }
    }
};

struct EpiOut {
    static constexpr bool PERM = true, AFTER_DRAIN = false, CHAIN = false;
    unsigned char* ws; const float* x;
    DEVI void operator()(const AccT& acc, const pg8::Unit& u, int wr, int wc, int fr, int fq) const {
        const int row0 = u.pm * 256 + wr * 64 + fr;
#pragma unroll
        for (int bj = 0; bj < 2; ++bj) {
            const int col = u.pn * 256 + bj * 128 + wc * 32 + 8 * fq;
#pragma unroll
            for (int ai = 0; ai < 2; ++ai) {
                f32x4 xr[4][2];
#pragma unroll
                for (int m = 0; m < 4; ++m) { const size_t off = (size_t)(row0 + ai * 128 + m * 16) * 1024 + col; xr[m][0] = *(const f32x4*)(x + off); xr[m][1] = *(const f32x4*)(x + off + 4); }
                __builtin_amdgcn_sched_barrier(0);
#pragma unroll
                for (int m = 0; m < 4; ++m) {
                    float* p = (float*)(ws + WS_H1) + (size_t)(row0 + ai * 128 + m * 16) * 1024 + col;
                    *(f32x4*)p = acc[ai][bj][m][0] + ALPHA * xr[m][0]; *(f32x4*)(p + 4) = acc[ai][bj][m][1] + ALPHA * xr[m][1];
                }
                __builtin_amdgcn_sched_barrier(0);
            }
        }
    }
};

struct EpiScores {
    static constexpr bool PERM = true, AFTER_DRAIN = false, CHAIN = false;
    unsigned char* ws;
    DEVI void operator()(const AccT& acc, const pg8::Unit& u, int wr, int wc, int fr, int fq) const {
        const int row0 = u.pm * 256 + wr * 64 + fr;
#pragma unroll
        for (int bj = 0; bj < 2; ++bj) {
            const int col = u.pn * 256 + bj * 128 + wc * 32 + 8 * fq;
#pragma unroll
            for (int ai = 0; ai < 2; ++ai)
#pragma unroll
                for (int m = 0; m < 4; ++m) {
                    const int row = row0 + ai * 128 + m * 16;
                    const f32x4 v0 = acc[ai][bj][m][0], v1 = acc[ai][bj][m][1];
                    v4u w; w.x = pkh2(v0[0], v0[1]); w.y = pkh2(v0[2], v0[3]); w.z = pkh2(v1[0], v1[1]); w.w = pkh2(v1[2], v1[3]);
                    *(v4u*)((unsigned short*)(ws + WS_SC) + (size_t)row * 2048 + col) = w;
                }
        }
    }
};

struct EpiS5Z {
    static constexpr bool PERM = true, AFTER_DRAIN = false, CHAIN = false;
    unsigned char* ws;
    DEVI void operator()(const AccT& acc, const pg8::Unit& u, int wr, int wc, int fr, int fq) const {
        const int row0 = u.pm * 256 + wr * 64 + fr, col = wc * 32 + 8 * fq;
        float* Z = (float*)(ws + WS_Z) + (size_t)u.z * 1024 * 128;
#pragma unroll
        for (int ai = 0; ai < 2; ++ai)
#pragma unroll
            for (int m = 0; m < 4; ++m) {
                const int row = row0 + ai * 128 + m * 16;
                float* p = Z + (size_t)row * 128 + col;
                *(f32x4*)p = acc[ai][0][m][0]; *(f32x4*)(p + 4) = acc[ai][0][m][1];
            }
    }
};
struct EpiS5Y {
    static constexpr bool PERM = true, AFTER_DRAIN = false, CHAIN = false;
    unsigned char* ws;
    DEVI void operator()(const AccT& acc, const pg8::Unit& u, int wr, int wc, int fr, int fq) const {
        const int row0 = u.pm * 256 + wr * 64 + fr;
        bf16* Y2 = (bf16*)(ws + WS_Y2);
#pragma unroll
        for (int bj = 0; bj < 2; ++bj) {
            const int n = u.pn * 256 + bj * 128 + wc * 32 + 8 * fq, i = n >> 4, h0 = n & 15;
#pragma unroll
            for (int ai = 0; ai < 2; ++ai)
#pragma unroll
                for (int m = 0; m < 4; ++m) {
                    const int r = row0 + ai * 128 + m * 16, b = r >> 6, c = r & 63;
                    f32x4 v0 = acc[ai][bj][m][0], v1 = acc[ai][bj][m][1];
#pragma unroll
                    for (int j = 0; j < 4; ++j) { v0[j] = gelu_t(v0[j]); v1[j] = gelu_t(v1[j]); }
                    *(v4u*)(Y2 + ((size_t)b * 4096 + c * 64 + i) * 512 + u.z * 16 + h0) = pack8(v0, v1);
                }
        }
    }
};

#define LDS_WAIT() asm volatile("s_waitcnt lgkmcnt(0)" ::: "memory")

DEVI void transpose_item(const float* W, int K, int N, bf16* WT, LAS float* scr, int item, int lane, int ldo = 0, int koff = 0) {
    if (ldo == 0) ldo = K;
    const int nblk = N / 32, kb = item / nblk, nb = item % nblk, k0 = 64 * kb, n0 = 32 * nb;
#pragma unroll 8
    for (int i = 0; i < 32; ++i) { const int kk = 2 * i + (lane >> 5); scr[kk * 33 + (lane & 31)] = W[(size_t)(k0 + kk) * N + n0 + (lane & 31)]; }
    LDS_WAIT();
    const int c = lane & 7;
#pragma unroll
    for (int j = 0; j < 4; ++j) { const int n = (lane >> 3) + 8 * j; const LAS float* s = scr + (8 * c) * 33 + n;
        v4u o; o.x = pk2(s[0 * 33], s[1 * 33]); o.y = pk2(s[2 * 33], s[3 * 33]); o.z = pk2(s[4 * 33], s[5 * 33]); o.w = pk2(s[6 * 33], s[7 * 33]);
        *(v4u*)(WT + (size_t)(n0 + n) * ldo + koff + k0 + 8 * c) = o; }
    LDS_WAIT();
}

DEVI void cvt_bf16_stream(const float* src, bf16* dst, size_t n8, size_t gtid, size_t gthreads) {
    for (size_t i = gtid; i < n8; i += gthreads) {
        const f32x4 a = *(const f32x4*)(src + i * 8), b = *(const f32x4*)(src + i * 8 + 4);
        *(v4u*)(dst + i * 8) = pack8(a, b);
    }
}

DEVI float clamp_fp8(float x) { return fminf(fmaxf(x, -448.0f), 448.0f); }
DEVI unsigned pk4_fp8(float a, float b, float c, float d) { a = clamp_fp8(a); b = clamp_fp8(b); c = clamp_fp8(c); d = clamp_fp8(d); int w = 0; w = __builtin_amdgcn_cvt_pk_fp8_f32(a, b, w, false); w = __builtin_amdgcn_cvt_pk_fp8_f32(c, d, w, true); return (unsigned)w; }
DEVI void cvt_fp8_stream(const float* src, unsigned char* dst, size_t n16, float scale, size_t gtid, size_t gthreads) {
    for (size_t i = gtid; i < n16; i += gthreads) {
        const f32x4 a = *(const f32x4*)(src + i * 16) * scale, b = *(const f32x4*)(src + i * 16 + 4) * scale, c = *(const f32x4*)(src + i * 16 + 8) * scale, d = *(const f32x4*)(src + i * 16 + 12) * scale;
        v4u o; o.x = pk4_fp8(a[0], a[1], a[2], a[3]); o.y = pk4_fp8(b[0], b[1], b[2], b[3]); o.z = pk4_fp8(c[0], c[1], c[2], c[3]); o.w = pk4_fp8(d[0], d[1], d[2], d[3]);
        *(v4u*)(dst + i * 16) = o;
    }
}

DEVI void cvt_fp8_sliced(const float* src, unsigned char* dst, float scale, size_t gtid, size_t gthreads) {
    for (size_t i = gtid; i < (size_t)PNE * D / 16; i += gthreads) {
        const size_t e = i >> 6; const int cg = (int)(i & 63), j = cg >> 3, within = (cg & 7) * 16;
        const f32x4 a = *(const f32x4*)(src + i * 16) * scale, b = *(const f32x4*)(src + i * 16 + 4) * scale, c = *(const f32x4*)(src + i * 16 + 8) * scale, d = *(const f32x4*)(src + i * 16 + 12) * scale;
        v4u o; o.x = pk4_fp8(a[0], a[1], a[2], a[3]); o.y = pk4_fp8(b[0], b[1], b[2], b[3]); o.z = pk4_fp8(c[0], c[1], c[2], c[3]); o.w = pk4_fp8(d[0], d[1], d[2], d[3]);
        *(v4u*)(dst + ((size_t)j * PNE + e) * 128 + within) = o;
    }
}

DEVI unsigned q4_i8(float a, float b, float c, float d) {
    const int ia = (int)rintf(a), ib = (int)rintf(b), ic = (int)rintf(c), id = (int)rintf(d);
    return (unsigned)(ia & 255) | ((unsigned)(ib & 255) << 8) | ((unsigned)(ic & 255) << 16) | ((unsigned)(id & 255) << 24);
}
DEVI void cvt_i8_rows(const float* src, unsigned char* dst, float* scales, int gw, int ngw, int lane) {
    for (int e0 = gw; e0 < PNE; e0 += 4 * ngw) {
        f32x4 v[4][4];
#pragma unroll
        for (int r = 0; r < 4; ++r) { const int er = (e0 + r * ngw < PNE) ? e0 + r * ngw : e0; const float* rp = src + (size_t)er * 1024 + lane * 16;
#pragma unroll
            for (int q = 0; q < 4; ++q) v[r][q] = *(const f32x4*)(rp + 4 * q); }
#pragma unroll
        for (int r = 0; r < 4; ++r) {
            const int e = e0 + r * ngw; if (e >= PNE) continue; float m = 0.f;
#pragma unroll
            for (int q = 0; q < 4; ++q) m = fmaxf(m, fmaxf(fmaxf(fabsf(v[r][q][0]), fabsf(v[r][q][1])), fmaxf(fabsf(v[r][q][2]), fabsf(v[r][q][3]))));
            m = wave_max(m); m = fmaxf(m, 1e-30f);
            const float inv = 127.0f / m;
            v4u o;
#pragma unroll
            for (int q = 0; q < 4; ++q) o[q] = q4_i8(v[r][q][0] * inv, v[r][q][1] * inv, v[r][q][2] * inv, v[r][q][3] * inv);
            *(v4u*)(dst + ((size_t)(lane >> 3) * PNE + e) * 128 + (lane & 7) * 16) = o;
            if (lane == 0) scales[e] = m * (1.0f / 127.0f);
        }
    }
}

DEVI void phase_prep(const Args& a, LAS unsigned char* lds) {
    const int tid = threadIdx.x, lane = tid & 63, wave = __builtin_amdgcn_readfirstlane(tid >> 6), G = gridDim.x;
    unsigned char* ws = a.ws;
    const size_t gtid = (size_t)blockIdx.x * 512 + tid, gthreads = (size_t)G * 512;
    cvt_bf16_stream(a.in[0], (bf16*)(ws + WS_XB), (size_t)T * D / 8, gtid, gthreads);
#if PEER_FP8
#if PEER_U_INT8
    cvt_i8_rows(a.in[21], ws + WS_PU, (float*)(ws + WS_US), blockIdx.x * 8 + wave, G * 8, lane);
#else
    cvt_fp8_sliced(a.in[21], ws + WS_PU, PU_SCALE, gtid, gthreads);
#endif
    cvt_fp8_sliced(a.in[22], ws + WS_PV, PV_SCALE, gtid, gthreads);
#else
    cvt_bf16_stream(a.in[21], (bf16*)(ws + WS_PU), (size_t)PNE * D / 8, gtid, gthreads);
    cvt_bf16_stream(a.in[22], (bf16*)(ws + WS_PV), (size_t)PNE * D / 8, gtid, gthreads);
#endif
    {
        LAS float* scr = (LAS float*)(lds + wave * 16384);
        const int gw = blockIdx.x * 8 + wave, NGW = G * 8;
        constexpr int I_IN = (1024 / 64) * (INC / 32), I_GLU = (512 / 64) * (512 / 32), I_PA = (512 / 64) * (1024 / 32), I_O = (1024 / 64) * (1024 / 32);
        constexpr int NIT = I_IN + I_GLU + 2 * I_PA + I_O;
        for (int it = gw; it < NIT; it += NGW) {
            int r = it;
            if (r < I_IN) { transpose_item(a.in[1], 1024, INC, (bf16*)(ws + WS_WINT), scr, r, lane); continue; } r -= I_IN;
            if (r < I_GLU) { transpose_item(a.in[10], 512, 512, (bf16*)(ws + WS_WGLUT), scr, r, lane); continue; } r -= I_GLU;
            if (r < I_PA) { transpose_item(a.in[14], 512, 1024, (bf16*)(ws + WS_WPAT), scr, r, lane, 1024, 0); continue; } r -= I_PA;
            if (r < I_PA) { transpose_item(a.in[15], 512, 1024, (bf16*)(ws + WS_WPAT), scr, r, lane, 1024, 512); continue; } r -= I_PA;
            transpose_item(a.in[16], 1024, 1024, (bf16*)(ws + WS_WOT), scr, r, lane);
        }
    }
    __syncthreads();
    {
        LAS float* wq = (LAS float*)lds;
        LAS float* ky = wq + 32 * 132;
        const float* wpq = a.in[19]; const float* keys = a.in[20];
        const int n = tid & 127, kh = __builtin_amdgcn_readfirstlane(tid >> 7);
        for (int item = blockIdx.x; item < 16 * 32; item += G) {
            const int slot = item >> 5, kt = item & 31;
            __syncthreads();
#pragma unroll
            for (int i = 0; i < 2; ++i) { const int idx = tid + 512 * i, kk = idx >> 5, d4 = (idx & 31) * 4;
                *(LAS f32x4*)(wq + kk * 132 + d4) = *(const f32x4*)(wpq + (size_t)(kt * 32 + kk) * 2048 + slot * 128 + d4); }
#pragma unroll
            for (int i = 0; i < 8; ++i) { const int idx = tid + 512 * i, nn = idx >> 5, d4 = (idx & 31) * 4;
                *(LAS f32x4*)(ky + nn * 132 + d4) = *(const f32x4*)(keys + ((size_t)(slot * 128 + nn)) * 128 + d4); }
            __syncthreads();
            float acc[8];
#pragma unroll
            for (int kk = 0; kk < 8; ++kk) acc[kk] = 0.f;
#pragma unroll 4
            for (int d = 0; d < 128; d += 4) {
                const f32x4 kv = *(const LAS f32x4*)(ky + n * 132 + d);
#pragma unroll
                for (int kk = 0; kk < 8; ++kk) { const f32x4 w = *(const LAS f32x4*)(wq + (kh * 8 + kk) * 132 + d); acc[kk] += kv[0] * w[0] + kv[1] * w[1] + kv[2] * w[2] + kv[3] * w[3]; }
            }
            v4u o; o.x = pk2(acc[0], acc[1]); o.y = pk2(acc[2], acc[3]); o.z = pk2(acc[4], acc[5]); o.w = pk2(acc[6], acc[7]);
            *(v4u*)((bf16*)(ws + WS_WFT) + (size_t)(slot * 128 + n) * 1024 + kt * 32 + kh * 8) = o;
        }
    }
}

DEVI void s5_tables_item(const Args& a, LAS unsigned char* lds, int item) {
    const int tid = threadIdx.x, g = item >> 3, part = item & 7;
    unsigned char* ws = a.ws;
    LAS float* pwr = (LAS float*)lds;
    LAS float* pwi = pwr + 65 * 64;
    LAS float* Bbr = pwi + 65 * 64;
    LAS float* Bbi = Bbr + 1024;
    LAS float* Cr = Bbi + 1024;
    LAS float* Ci = Cr + 1040;
    LAS float* Kt = Ci + 1040;
    __syncthreads();
    if (tid < 64) {
        const int p = tid;
        const float dt = __expf(a.in[9][g]);
        const float lr = a.in[2][g * 64 + p], li = a.in[3][g * 64 + p];
        const float er = __expf(lr * dt); float sn, cs; sincosf(li * dt, &sn, &cs);
        const float Lr = er * cs, Li = er * sn;
        const float ar = Lr - 1.0f, ai = Li, den = lr * lr + li * li;
        const float cr = (ar * lr + ai * li) / den, ci = (ai * lr - ar * li) / den;
#pragma unroll
        for (int h = 0; h < 16; ++h) { const float br = a.in[4][(g * 64 + p) * 16 + h], bi = a.in[5][(g * 64 + p) * 16 + h];
            Bbr[p * 16 + h] = cr * br - ci * bi; Bbi[p * 16 + h] = cr * bi + ci * br; }
        float xr = 1.0f, xi = 0.0f;
        for (int d = 0; d <= 64; ++d) { pwr[d * 64 + p] = xr; pwi[d * 64 + p] = xi; const float nr = xr * Lr - xi * Li, ni = xr * Li + xi * Lr; xr = nr; xi = ni; }
        if (part == 0) { float* l64 = (float*)(ws + WS_L64) + (g * 64 + p) * 2; l64[0] = pwr[64 * 64 + p]; l64[1] = pwi[64 * 64 + p]; }
    }
    for (int i = tid; i < 1024; i += 512) { Cr[(i >> 6) * 65 + (i & 63)] = a.in[6][g * 1024 + i]; Ci[(i >> 6) * 65 + (i & 63)] = a.in[7][g * 1024 + i]; }
    __syncthreads();
    for (int pr = tid; pr < 1024; pr += 512) {
        const int d = pr >> 4, hp = pr & 15;
        float acc[16];
#pragma unroll
        for (int h = 0; h < 16; ++h) acc[h] = 0.f;
        for (int p = 0; p < 64; ++p) {
            const float c_r = Cr[hp * 65 + p], c_i = Ci[hp * 65 + p], w_r = pwr[d * 64 + p], w_i = pwi[d * 64 + p];
            const float cpr = c_r * w_r - c_i * w_i, cpi = c_r * w_i + c_i * w_r;
#pragma unroll
            for (int h = 0; h < 16; ++h) acc[h] += cpr * Bbr[p * 16 + h] - cpi * Bbi[p * 16 + h];
        }
#pragma unroll
        for (int h = 0; h < 16; ++h) Kt[pr * 16 + h] = acc[h];
    }
    __syncthreads();
    bf16* TY = (bf16*)(ws + WS_TY) + (size_t)g * 1024 * UK;
    for (int e = tid; e < 128 * 128; e += 512) {
        const int n = part * 128 + (e >> 7), k0 = (e & 127) * 8, i = n >> 4, hp = n & 15, j = k0 >> 4, h0 = k0 & 15;
        float v[8];
#pragma unroll
        for (int q = 0; q < 8; ++q) v[q] = 0.f;
        if (j <= i) {
            const LAS float* kp = Kt + ((i - j) * 16 + hp) * 16 + h0;
#pragma unroll
            for (int q = 0; q < 8; ++q) v[q] = kp[q];
            if (j == i && hp >= h0 && hp < h0 + 8) v[hp - h0] += a.in[8][g * 16 + hp];
        }
        v4u o; o.x = pk2(v[0], v[1]); o.y = pk2(v[2], v[3]); o.z = pk2(v[4], v[5]); o.w = pk2(v[6], v[7]);
        *(v4u*)(TY + (size_t)n * UK + k0) = o;
    }
    for (int e = tid; e < 128 * 64; e += 512) {
        const int n = part * 128 + (e >> 6), p = e & 63, i = n >> 4, hp = n & 15;
        const float c_r = Cr[hp * 65 + p], c_i = Ci[hp * 65 + p], w_r = pwr[(i + 1) * 64 + p], w_i = pwi[(i + 1) * 64 + p];
        TY[(size_t)n * UK + 1024 + p] = (bf16)f2bf(c_r * w_r - c_i * w_i);
        TY[(size_t)n * UK + 1088 + p] = (bf16)f2bf(-(c_r * w_i + c_i * w_r));
    }
    bf16* WZ = (bf16*)(ws + WS_WZ) + (size_t)g * 256 * 1024;
    for (int e = tid; e < 32 * 128; e += 512) {
        const int n = part * 32 + (e >> 7), k0 = (e & 127) * 8, j = k0 >> 4, h0 = k0 & 15;
        float v[8];
#pragma unroll
        for (int q = 0; q < 8; ++q) v[q] = 0.f;
        if (n < 128) {
            const int p = n & 63; const float w_r = pwr[(63 - j) * 64 + p], w_i = pwi[(63 - j) * 64 + p];
#pragma unroll
            for (int q = 0; q < 8; ++q) { const float b_r = Bbr[p * 16 + h0 + q], b_i = Bbi[p * 16 + h0 + q]; v[q] = (n < 64) ? (w_r * b_r - w_i * b_i) : (w_r * b_i + w_i * b_r); }
        }
        v4u o; o.x = pk2(v[0], v[1]); o.y = pk2(v[2], v[3]); o.z = pk2(v[4], v[5]); o.w = pk2(v[6], v[7]);
        *(v4u*)(WZ + (size_t)n * 1024 + k0) = o;
    }
}

DEVI void s5_scan(const Args& a) {
    unsigned char* ws = a.ws;
    for (int id = blockIdx.x * 512 + threadIdx.x; id < S5G * BATCH * 64; id += gridDim.x * 512) {
        const int p = id & 63, b = (id >> 6) & 15, g = id >> 10;
        const float* l64 = (const float*)(ws + WS_L64) + (g * 64 + p) * 2; const float Lr = l64[0], Li = l64[1];
        const float* zp = (const float*)(ws + WS_Z) + (size_t)(g * 1024 + b * 64) * 128 + p;
        bf16* up = (bf16*)(ws + WS_U5) + (size_t)(g * 1024 + b * 64) * UK + 1024 + p;
        float xr = 0.f, xi = 0.f;
#pragma unroll 8
        for (int c = 0; c < 64; ++c) {
            const float zr = zp[(size_t)c * 128], zi = zp[(size_t)c * 128 + 64];
            up[(size_t)c * UK] = (bf16)f2bf(xr); up[(size_t)c * UK + 64] = (bf16)f2bf(xi);
            const float nr = Lr * xr - Li * xi + zr, ni = Lr * xi + Li * xr + zi; xr = nr; xi = ni;
        }
    }
}

constexpr int HG_QT = 0, HG_KT = 17408, HG_KHT = 34816, HG_VT = 53248, HG_SBT = 71680, HG_P = 106496, HG_EB = 115712, HG_TOT = 116224;
DEVI int crow(int j, int hh) { return (j & 3) + 8 * (j >> 2) + 4 * hh; }
DEVI bf16x8 ldfrag(const LAS unsigned char* base, int row, int pitch, int col) { return *(const LAS bf16x8*)(base + (row * pitch + col) * 2); }

template <bool FULL> DEVI void hgrn_segment(const Args& a, LAS unsigned char* lds, int item) {
    const int tid = threadIdx.x, lane = tid & 63, wave = __builtin_amdgcn_readfirstlane(tid >> 6);
    const int seg = item & 3, h = (item >> 2) & 3, b = item >> 4;
    unsigned char* ws = a.ws;
    const int kcol = tid & 127, qd = tid >> 7, r32 = lane & 31, hh = lane >> 5;
    const int ti = wave >> 2, vi = wave & 3, ski = wave & 3, sv0 = (wave >> 2) * 2;
    const float* LF = (const float*)(ws + WS_LF); const bf16* Q = (const bf16*)(ws + WS_Q); const bf16* VV = (const bf16*)(ws + WS_VV); const bf16* GS = (const bf16*)(ws + WS_GS);
    bf16* YB = (bf16*)(ws + WS_YAB) + 512;
    float* HGS = (float*)(ws + WS_HGS); float* HGD = (float*)(ws + WS_HGD);
    LAS unsigned char* QT = lds + HG_QT; LAS unsigned char* KT = lds + HG_KT; LAS unsigned char* KHT = lds + HG_KHT; LAS unsigned char* VT = lds + HG_VT;
    LAS unsigned char* SBT = lds + HG_SBT; LAS unsigned char* PB = lds + HG_P;
    LAS float* EB = (LAS float*)(lds + HG_EB); LAS float* TOT = (LAS float*)(lds + HG_TOT); LAS float* O = (LAS float*)(lds + HG_QT);
    f32x16 S0, S1;
#pragma unroll
    for (int j = 0; j < 16; ++j) { S0[j] = 0.f; S1[j] = 0.f; }
    float sumlog = 0.f;
    __syncthreads();
    if (FULL) {
        for (int s2 = 0; s2 < seg; ++s2) {
            const int it2 = (b * 4 + h) * 4 + s2;
            const float* dS = HGS + (size_t)it2 * 16384; const float* Dl = HGD + it2 * 128;
#pragma unroll
            for (int j = 0; j < 16; ++j) { const int k = ski * 32 + crow(j, hh); const float d = Dl[k];
                S0[j] = d * S0[j] + dS[k * 128 + sv0 * 32 + r32]; S1[j] = d * S1[j] + dS[k * 128 + (sv0 + 1) * 32 + r32]; }
        }
#pragma unroll
        for (int g4 = 0; g4 < 4; ++g4) { const int k0 = ski * 32 + 8 * g4 + 4 * hh;
            v2u w0, w1; w0.x = pk2(S0[4 * g4], S0[4 * g4 + 1]); w0.y = pk2(S0[4 * g4 + 2], S0[4 * g4 + 3]); w1.x = pk2(S1[4 * g4], S1[4 * g4 + 1]); w1.y = pk2(S1[4 * g4 + 2], S1[4 * g4 + 3]);
            *(LAS v2u*)(SBT + ((sv0 * 32 + r32) * 136 + k0) * 2) = w0; *(LAS v2u*)(SBT + (((sv0 + 1) * 32 + r32) * 136 + k0) * 2) = w1; }
    }
    for (int cc = 0; cc < 16; ++cc) {
        const size_t row0 = (size_t)b * 4096 + (seg * 16 + cc) * 64;
        __syncthreads();
        float l[16], qv[16];
        {
            const size_t g0 = (row0 + qd * 16) * 512 + h * 128 + kcol;
            bf16 vraw[16];
#pragma unroll
            for (int i = 0; i < 16; ++i) { l[i] = LF[g0 + (size_t)i * 512]; vraw[i] = VV[g0 + (size_t)i * 512]; if (FULL) qv[i] = bf2f(Q[g0 + (size_t)i * 512]); }
            v4u w0, w1;
            w0.x = vraw[0] | ((unsigned)vraw[1] << 16); w0.y = vraw[2] | ((unsigned)vraw[3] << 16); w0.z = vraw[4] | ((unsigned)vraw[5] << 16); w0.w = vraw[6] | ((unsigned)vraw[7] << 16);
            w1.x = vraw[8] | ((unsigned)vraw[9] << 16); w1.y = vraw[10] | ((unsigned)vraw[11] << 16); w1.z = vraw[12] | ((unsigned)vraw[13] << 16); w1.w = vraw[14] | ((unsigned)vraw[15] << 16);
            *(LAS v4u*)(VT + (kcol * 72 + qd * 16) * 2) = w0; *(LAS v4u*)(VT + (kcol * 72 + qd * 16 + 8) * 2) = w1;
        }
        float pre[16]; { float run = 0.f;
#pragma unroll
            for (int i = 0; i < 16; ++i) { run += l[i]; pre[i] = run; }
            TOT[qd * 128 + kcol] = run; }
        __syncthreads();
        float off = 0.f, blast = 0.f;
#pragma unroll
        for (int q2 = 0; q2 < 4; ++q2) { const float tv = TOT[q2 * 128 + kcol]; blast += tv; off += (q2 < qd) ? tv : 0.f; }
        if (qd == 0) { EB[kcol] = __expf(blast); sumlog += blast; }
        {
            float kh[16];
#pragma unroll
            for (int i = 0; i < 16; ++i) {
                const float bc = off + pre[i], omf = 1.0f - __expf(l[i]);
                kh[i] = omf * __expf(blast - bc);
                if (FULL) { const int s = qd * 16 + i;
                    *(LAS bf16*)(QT + (s * 136 + kcol) * 2) = (bf16)f2bf(qv[i] * __expf(bc));
                    *(LAS bf16*)(KT + (s * 136 + kcol) * 2) = (bf16)f2bf(omf * __expf(-bc)); }
            }
            v4u w0, w1; w0.x = pk2(kh[0], kh[1]); w0.y = pk2(kh[2], kh[3]); w0.z = pk2(kh[4], kh[5]); w0.w = pk2(kh[6], kh[7]);
            w1.x = pk2(kh[8], kh[9]); w1.y = pk2(kh[10], kh[11]); w1.z = pk2(kh[12], kh[13]); w1.w = pk2(kh[14], kh[15]);
            *(LAS v4u*)(KHT + (kcol * 72 + qd * 16) * 2) = w0; *(LAS v4u*)(KHT + (kcol * 72 + qd * 16 + 8) * 2) = w1;
        }
        __syncthreads();
        f32x16 o;
#pragma unroll
        for (int j = 0; j < 16; ++j) o[j] = 0.f;
        if (FULL) {
            if (wave < 3) {
                const int sti = wave ? 1 : 0, ssi = wave == 2 ? 1 : 0;
                f32x16 sc;
#pragma unroll
                for (int j = 0; j < 16; ++j) sc[j] = 0.f;
#pragma unroll
                for (int ks = 0; ks < 8; ++ks) sc = __builtin_amdgcn_mfma_f32_32x32x16_bf16(ldfrag(QT, sti * 32 + r32, 136, ks * 16 + 8 * hh), ldfrag(KT, ssi * 32 + r32, 136, ks * 16 + 8 * hh), sc, 0, 0, 0);
                const int s = ssi * 32 + r32;
#pragma unroll
                for (int j = 0; j < 16; ++j) { const int t = sti * 32 + crow(j, hh); *(LAS bf16*)(PB + (t * 72 + s) * 2) = (bf16)f2bf(s <= t ? sc[j] : 0.f); }
            }
#pragma unroll
            for (int ks = 0; ks < 8; ++ks) o = __builtin_amdgcn_mfma_f32_32x32x16_bf16(ldfrag(QT, ti * 32 + r32, 136, ks * 16 + 8 * hh), ldfrag(SBT, vi * 32 + r32, 136, ks * 16 + 8 * hh), o, 0, 0, 0);
        }
        {
#pragma unroll
            for (int g4 = 0; g4 < 4; ++g4) { const f32x4 e = *(const LAS f32x4*)(EB + ski * 32 + 8 * g4 + 4 * hh);
#pragma unroll
                for (int q = 0; q < 4; ++q) { S0[4 * g4 + q] *= e[q]; S1[4 * g4 + q] *= e[q]; } }
#pragma unroll
            for (int ks = 0; ks < 4; ++ks) { const bf16x8 af = ldfrag(KHT, ski * 32 + r32, 72, ks * 16 + 8 * hh);
                S0 = __builtin_amdgcn_mfma_f32_32x32x16_bf16(af, ldfrag(VT, sv0 * 32 + r32, 72, ks * 16 + 8 * hh), S0, 0, 0, 0);
                S1 = __builtin_amdgcn_mfma_f32_32x32x16_bf16(af, ldfrag(VT, (sv0 + 1) * 32 + r32, 72, ks * 16 + 8 * hh), S1, 0, 0, 0); }
        }
        if (FULL) {
            __syncthreads();
            if (ti) {
#pragma unroll
                for (int ks = 0; ks < 4; ++ks) o = __builtin_amdgcn_mfma_f32_32x32x16_bf16(ldfrag(PB, ti * 32 + r32, 72, ks * 16 + 8 * hh), ldfrag(VT, vi * 32 + r32, 72, ks * 16 + 8 * hh), o, 0, 0, 0);
            } else {
#pragma unroll
                for (int ks = 0; ks < 2; ++ks) o = __builtin_amdgcn_mfma_f32_32x32x16_bf16(ldfrag(PB, r32, 72, ks * 16 + 8 * hh), ldfrag(VT, vi * 32 + r32, 72, ks * 16 + 8 * hh), o, 0, 0, 0);
            }
#pragma unroll
            for (int g4 = 0; g4 < 4; ++g4) { const int k0 = ski * 32 + 8 * g4 + 4 * hh;
                v2u w0, w1; w0.x = pk2(S0[4 * g4], S0[4 * g4 + 1]); w0.y = pk2(S0[4 * g4 + 2], S0[4 * g4 + 3]); w1.x = pk2(S1[4 * g4], S1[4 * g4 + 1]); w1.y = pk2(S1[4 * g4 + 2], S1[4 * g4 + 3]);
                *(LAS v2u*)(SBT + ((sv0 * 32 + r32) * 136 + k0) * 2) = w0; *(LAS v2u*)(SBT + (((sv0 + 1) * 32 + r32) * 136 + k0) * 2) = w1; }
#pragma unroll
            for (int j = 0; j < 16; ++j) O[(ti * 32 + crow(j, hh)) * 132 + vi * 32 + r32] = o[j];
            __syncthreads();
            {
                const int t = tid >> 3, sg = (tid & 7) * 16;
                float ov[16], ss = 0.f;
#pragma unroll
                for (int i = 0; i < 16; i += 4) { const f32x4 x = *(const LAS f32x4*)(O + t * 132 + sg + i); ov[i] = x[0]; ov[i + 1] = x[1]; ov[i + 2] = x[2]; ov[i + 3] = x[3]; }
#pragma unroll
                for (int i = 0; i < 16; ++i) ss += ov[i] * ov[i];
                ss += __shfl_xor(ss, 1); ss += __shfl_xor(ss, 2); ss += __shfl_xor(ss, 4);
                const float r = rsqrtf(ss * (1.0f / 128.0f) + RMS_EPS);
                const size_t go = (row0 + t) * 512 + h * 128 + sg, yo = (row0 + t) * 1024 + h * 128 + sg;
                const v4u g0 = *(const v4u*)(GS + go), g1 = *(const v4u*)(GS + go + 8);
                float gs0[8], gs1[8]; unpack8(g0, gs0); unpack8(g1, gs1);
                const float* gw = a.in[13] + h * 128 + sg;
#pragma unroll
                for (int i = 0; i < 8; ++i) { ov[i] = ov[i] * r * gw[i] * gs0[i]; ov[8 + i] = ov[8 + i] * r * gw[8 + i] * gs1[i]; }
                v4u w0, w1; w0.x = pk2(ov[0], ov[1]); w0.y = pk2(ov[2], ov[3]); w0.z = pk2(ov[4], ov[5]); w0.w = pk2(ov[6], ov[7]);
                w1.x = pk2(ov[8], ov[9]); w1.y = pk2(ov[10], ov[11]); w1.z = pk2(ov[12], ov[13]); w1.w = pk2(ov[14], ov[15]);
                *(v4u*)(YB + yo) = w0; *(v4u*)(YB + yo + 8) = w1;
            }
        }
    }
    if (!FULL) {
        float* dS = HGS + (size_t)item * 16384;
#pragma unroll
        for (int j = 0; j < 16; ++j) { const int k = ski * 32 + crow(j, hh); dS[k * 128 + sv0 * 32 + r32] = S0[j]; dS[k * 128 + (sv0 + 1) * 32 + r32] = S1[j]; }
        if (qd == 0) HGD[item * 128 + kcol] = __expf(sumlog);
    }
}

template <int NT> DEVI void ln1_rows(const Args& a, int r0, int rstride, int lane) {
    f32x4 v[NT][4];
#pragma unroll
    for (int q = 0; q < NT; ++q) { const float* hr = (const float*)(a.ws + WS_H1) + (size_t)(r0 + q * rstride) * 1024 + lane * 4;
#pragma unroll
        for (int j = 0; j < 4; ++j) v[q][j] = *(const f32x4*)(hr + 256 * j); }
    f32x4 gg[4], bb[4];
#pragma unroll
    for (int j = 0; j < 4; ++j) { gg[j] = *(const f32x4*)(a.in[17] + lane * 4 + 256 * j); bb[j] = *(const f32x4*)(a.in[18] + lane * 4 + 256 * j); }
#pragma unroll
    for (int q = 0; q < NT; ++q) {
        const int row = r0 + q * rstride;
        float s = 0.f;
#pragma unroll
        for (int j = 0; j < 4; ++j) s += (v[q][j][0] + v[q][j][1]) + (v[q][j][2] + v[q][j][3]);
        const float mean = wave_sum(s) * (1.0f / 1024.0f); float qq = 0.f;
#pragma unroll
        for (int j = 0; j < 4; ++j) { v[q][j] = v[q][j] - mean; qq += (v[q][j][0] * v[q][j][0] + v[q][j][1] * v[q][j][1]) + (v[q][j][2] * v[q][j][2] + v[q][j][3] * v[q][j][3]); }
        const float rstd = rsqrtf(wave_sum(qq) * (1.0f / 1024.0f) + LN_EPS);
        bf16* o = (bf16*)(a.ws + WS_X1B) + (size_t)row * 1024 + lane * 4;
        float am = 0.f;
#pragma unroll
        for (int j = 0; j < 4; ++j) {
            const f32x4 y = v[q][j] * rstd * gg[j] + bb[j]; v[q][j] = y;
            am = fmaxf(am, fmaxf(fmaxf(fabsf(y[0]), fabsf(y[1])), fmaxf(fabsf(y[2]), fabsf(y[3]))));
            v2u w; w.x = pk2(y[0], y[1]); w.y = pk2(y[2], y[3]);
            *(v2u*)(o + 256 * j) = w;
        }
#if PEER_U_INT8
        am = fmaxf(wave_max(am), 1e-30f);
        const float inv = 127.0f / am;
        unsigned char* qo = a.ws + WS_X1Q + (size_t)row * 1024 + lane * 4;
#pragma unroll
        for (int j = 0; j < 4; ++j) *(unsigned*)(qo + 256 * j) = q4_i8(v[q][j][0] * inv, v[q][j][1] * inv, v[q][j][2] * inv, v[q][j][3] * inv);
        if (lane == 0) ((float*)(a.ws + WS_XS))[row] = am * (1.0f / 127.0f);
#endif
    }
}

DEVI unsigned umax_(unsigned a, unsigned b) { return a > b ? a : b; }
DEVI unsigned umin_(unsigned a, unsigned b) { return a < b ? a : b; }
DEVI unsigned skey(float x) { const unsigned b = __float_as_uint(x); return b ^ (((int)b >> 31) | 0x80000000u); }
DEVI unsigned hkey(unsigned h) { return h ^ ((h & 0x8000u) ? 0xFFFFu : 0x8000u); }
DEVI float hkey_dec(unsigned k) { const unsigned kk = k >> 16; return h2f((unsigned short)(kk ^ ((kk & 0x8000u) ? 0x8000u : 0xFFFFu))); }
DEVI void ce_desc(unsigned& a, unsigned& b) { const unsigned mx = umax_(a, b), mn = umin_(a, b); a = mx; b = mn; }
DEVI void sort16_desc(unsigned (&g)[16]) {
#pragma unroll
    for (int k = 2; k <= 16; k <<= 1)
#pragma unroll
        for (int j = k >> 1; j > 0; j >>= 1)
#pragma unroll
            for (int i = 0; i < 16; ++i) { const int l = i ^ j; if (l > i) { if ((i & k) == 0) ce_desc(g[i], g[l]); else ce_desc(g[l], g[i]); } }
}
DEVI void merge16_desc(unsigned (&L)[16], const unsigned (&g)[16]) {
#pragma unroll
    for (int i = 0; i < 16; ++i) L[i] = umax_(L[i], g[15 - i]);
#pragma unroll
    for (int j = 8; j > 0; j >>= 1)
#pragma unroll
        for (int i = 0; i < 16; ++i) { const int l = i ^ j; if (l > i) ce_desc(L[i], L[l]); }
}
DEVI void topk_block(const Args& a, LAS float* stg, int task, int lane) {
    const int tb = task >> 3, h = task & 7;
    const unsigned short* sc = (const unsigned short*)(a.ws + WS_SC) + (size_t)tb * 64 * 2048 + h * 256;
    unsigned L[2][16];
#pragma unroll
    for (int p = 0; p < 2; ++p) {
#pragma unroll
        for (int i = 0; i < 16; ++i) L[p][i] = 0u;
        for (int sub = 0; sub < 2; ++sub) {
            v4u ld[8];
#pragma unroll
            for (int q = 0; q < 8; ++q) ld[q] = *(const v4u*)(sc + (size_t)(q * 8 + (lane >> 3)) * 2048 + p * 128 + sub * 64 + (lane & 7) * 8);
            __builtin_amdgcn_wave_barrier();
#pragma unroll
            for (int q = 0; q < 8; ++q) *(LAS v4u*)(stg + (q * 8 + (lane >> 3)) * 36 + (lane & 7) * 4) = ld[q];
            LDS_WAIT(); __builtin_amdgcn_wave_barrier();
#pragma unroll
            for (int q2 = 0; q2 < 4; ++q2) {
                const v4u v0 = *(const LAS v4u*)(stg + lane * 36 + q2 * 8), v1 = *(const LAS v4u*)(stg + lane * 36 + q2 * 8 + 4);
                unsigned g[16];
#pragma unroll
                for (int e = 0; e < 8; ++e) {
                    const unsigned h0 = (e & 1) ? (v0[e >> 1] >> 16) : (v0[e >> 1] & 0xFFFFu), h1 = (e & 1) ? (v1[e >> 1] >> 16) : (v1[e >> 1] & 0xFFFFu);
                    g[e] = (hkey(h0) << 16) | (unsigned)(sub * 64 + q2 * 16 + e); g[8 + e] = (hkey(h1) << 16) | (unsigned)(sub * 64 + q2 * 16 + 8 + e);
                }
                sort16_desc(g);
                merge16_desc(L[p], g);
            }
            LDS_WAIT(); __builtin_amdgcn_wave_barrier();
        }
    }
    unsigned C[16];
#pragma unroll
    for (int i = 0; i < 16; ++i) C[i] = 0u;
#pragma unroll
    for (int ia = 0; ia < 16; ++ia) {
        const float va = hkey_dec(L[0][ia]); const unsigned ea = (L[0][ia] & 127u) << 7;
#pragma unroll
        for (int ib = 0; ib < 16; ++ib) {
            if ((ia + 1) * (ib + 1) <= 16) {
                unsigned x = (skey(va + hkey_dec(L[1][ib])) & 0xFFFFC000u) | ea | (L[1][ib] & 127u);
#pragma unroll
                for (int i = 0; i < 16; ++i) { const unsigned t = umax_(C[i], x); x = umin_(C[i], x); C[i] = t; }
            }
        }
    }
    const unsigned short* srow = sc + (size_t)lane * 2048;
    float cv[16]; float mx = -3.0e38f;
#pragma unroll
    for (int i = 0; i < 16; ++i) { const unsigned e = C[i] & 0x3FFFu; cv[i] = h2f(srow[e >> 7]) + h2f(srow[128 + (e & 127u)]); mx = fmaxf(mx, cv[i]); }
    float es = 0.f;
#pragma unroll
    for (int i = 0; i < 16; ++i) { cv[i] = __expf(cv[i] - mx); es += cv[i]; }
    const float inv = 1.0f / es;
    const size_t item = ((size_t)tb * 64 + lane) * 8 + h;
    int* ids = (int*)(a.ws + WS_IDS) + item * 16; float* gts = (float*)(a.ws + WS_GATES) + item * 16;
#pragma unroll
    for (int i = 0; i < 16; i += 4) { *(v4u*)(ids + i) = (v4u){C[i] & 0x3FFFu, C[i + 1] & 0x3FFFu, C[i + 2] & 0x3FFFu, C[i + 3] & 0x3FFFu};
        *(f32x4*)(gts + i) = (f32x4){cv[i] * inv, cv[i + 1] * inv, cv[i + 2] * inv, cv[i + 3] * inv}; }
}

DEVI void cvt16_fp8(const v4u& r, float (&f)[16]) {
#pragma unroll
    for (int w = 0; w < 4; ++w) { const f32x2 lo = __builtin_amdgcn_cvt_pk_f32_fp8((int)r[w], false), hi = __builtin_amdgcn_cvt_pk_f32_fp8((int)r[w], true);
        f[4 * w] = lo[0]; f[4 * w + 1] = lo[1]; f[4 * w + 2] = hi[0]; f[4 * w + 3] = hi[1]; }
}
DEVI int bperm_i(int srclane, int v) { return __builtin_amdgcn_ds_bpermute(srclane << 2, v); }
DEVI void gx_issue(v4u (&row)[16], const unsigned char* tab, int id0, int id1, int g) {
#pragma unroll
    for (int it = 0; it < 16; ++it) { const int e = bperm_i((it * 8 + g) & 63, it < 8 ? id0 : id1); row[it] = *(const v4u*)(tab + (size_t)e * 128); }
}
#if PEER_U_INT8
DEVI void gu_math(const v4u (&row)[16], const v4u& xq, const v4u&, float* pd, int g, int i) {
    int d[16];
#pragma unroll
    for (int it = 0; it < 16; ++it) { int s = 0;
#pragma unroll
        for (int w = 0; w < 4; ++w) s = __builtin_amdgcn_sdot4((int)row[it][w], (int)xq[w], s, false);
        d[it] = s; }
    const bool b2 = i & 4, b1 = i & 2, b0 = i & 1;
    int y[2];
#pragma unroll
    for (int hh = 0; hh < 2; ++hh) {
        int w4[4], w2[2];
#pragma unroll
        for (int q = 0; q < 4; ++q) { const int send = b2 ? d[8 * hh + q] : d[8 * hh + q + 4], keep = b2 ? d[8 * hh + q + 4] : d[8 * hh + q]; w4[q] = keep + __shfl_xor(send, 4); }
#pragma unroll
        for (int q = 0; q < 2; ++q) { const int send = b1 ? w4[q] : w4[q + 2], keep = b1 ? w4[q + 2] : w4[q]; w2[q] = keep + __shfl_xor(send, 2); }
        { const int send = b0 ? w2[0] : w2[1], keep = b0 ? w2[1] : w2[0]; y[hh] = keep + __shfl_xor(send, 1); }
    }
    pd[i * 8 + g] = (float)y[0]; pd[(8 + i) * 8 + g] = (float)y[1];
}
#else
DEVI void gu_math(const v4u (&row)[16], const v4u& x0, const v4u& x1, float* pd, int g, int i) {
    float xs[16]; { float u0[8], u1[8]; unpack8(x0, u0); unpack8(x1, u1);
#pragma unroll
        for (int q = 0; q < 8; ++q) { xs[q] = u0[q]; xs[8 + q] = u1[q]; } }
    f32x2 xp2[8];
#pragma unroll
    for (int q = 0; q < 8; ++q) xp2[q] = (f32x2){xs[2 * q], xs[2 * q + 1]};
    float d[16];
#pragma unroll
    for (int it = 0; it < 16; ++it) { f32x2 sm = {0.f, 0.f};
#pragma unroll
        for (int w = 0; w < 4; ++w) { sm = __builtin_elementwise_fma(__builtin_amdgcn_cvt_pk_f32_fp8((int)row[it][w], false), xp2[2 * w], sm);
                                      sm = __builtin_elementwise_fma(__builtin_amdgcn_cvt_pk_f32_fp8((int)row[it][w], true), xp2[2 * w + 1], sm); }
        d[it] = sm[0] + sm[1];
        if ((it & 3) == 3) __builtin_amdgcn_sched_barrier(0); }
    const bool b2 = i & 4, b1 = i & 2, b0 = i & 1;
    float y[2];
#pragma unroll
    for (int hh = 0; hh < 2; ++hh) {
        float w4[4], w2[2];
#pragma unroll
        for (int q = 0; q < 4; ++q) { const float send = b2 ? d[8 * hh + q] : d[8 * hh + q + 4], keep = b2 ? d[8 * hh + q + 4] : d[8 * hh + q]; w4[q] = keep + __shfl_xor(send, 4); }
#pragma unroll
        for (int q = 0; q < 2; ++q) { const float send = b1 ? w4[q] : w4[q + 2], keep = b1 ? w4[q + 2] : w4[q]; w2[q] = keep + __shfl_xor(send, 2); }
        { const float send = b0 ? w2[0] : w2[1], keep = b0 ? w2[1] : w2[0]; y[hh] = keep + __shfl_xor(send, 1); }
    }
    pd[i * 8 + g] = y[0]; pd[(8 + i) * 8 + g] = y[1];
}
#endif
DEVI void gu_chunk(const Args& a, int j, int chunk, int wave, int lane) {
    unsigned char* ws = a.ws;
    const int g = lane >> 3, i = lane & 7;
    const unsigned char* tab = ws + WS_PU + (size_t)j * PNE * 128 + i * 16;
    float* PD = (float*)(ws + WS_PD) + (size_t)j * T * 128;
    const int* idbase = (const int*)(ws + WS_IDS);
#if PEER_U_INT8
    const unsigned char* xbase = ws + WS_X1Q + j * 128 + i * 16;
#define GU_X1(p) (*(const v4u*)(p))
#else
    const bf16* xbase = (const bf16*)(ws + WS_X1B) + j * 128 + i * 16;
#define GU_X1(p) (*(const v4u*)((p) + 8))
#endif
    const int t0 = chunk * 256 + wave * 32;
    v4u rowA[16], rowB[16];
    int ia0 = idbase[(size_t)t0 * 128 + lane], ia1 = idbase[(size_t)t0 * 128 + 64 + lane];
    int ib0 = idbase[(size_t)(t0 + 1) * 128 + lane], ib1 = idbase[(size_t)(t0 + 1) * 128 + 64 + lane];
    v4u xa0 = *(const v4u*)(xbase + (size_t)t0 * 1024), xa1 = GU_X1(xbase + (size_t)t0 * 1024), xb0, xb1;
    gx_issue(rowA, tab, ia0, ia1, g);
    for (int tt = 0; tt < 32; tt += 2) {
        const int t = t0 + tt; const bool more = tt + 2 < 32;
        if (more) { ia0 = idbase[(size_t)(t + 2) * 128 + lane]; ia1 = idbase[(size_t)(t + 2) * 128 + 64 + lane]; }
        xb0 = *(const v4u*)(xbase + (size_t)(t + 1) * 1024); xb1 = GU_X1(xbase + (size_t)(t + 1) * 1024);
        __builtin_amdgcn_sched_barrier(0);
        gx_issue(rowB, tab, ib0, ib1, g);
        __builtin_amdgcn_sched_barrier(0);
        gu_math(rowA, xa0, xa1, PD + (size_t)t * 128, g, i);
        __builtin_amdgcn_sched_barrier(0);
        if (more) { ib0 = idbase[(size_t)(t + 3) * 128 + lane]; ib1 = idbase[(size_t)(t + 3) * 128 + 64 + lane];
            xa0 = *(const v4u*)(xbase + (size_t)(t + 2) * 1024); xa1 = GU_X1(xbase + (size_t)(t + 2) * 1024); }
        __builtin_amdgcn_sched_barrier(0);
        if (more) gx_issue(rowA, tab, ia0, ia1, g);
        __builtin_amdgcn_sched_barrier(0);
        gu_math(rowB, xb0, xb1, PD + (size_t)(t + 1) * 128, g, i);
        __builtin_amdgcn_sched_barrier(0);
    }
}
DEVI void gv_math(const v4u (&row)[16], float c0, float c1, bf16* op, int g, int i, int lane) {
    const bool b5 = lane & 32, b4 = lane & 16, b3 = lane & 8;
    const int p = (b5 ? 4 : 0) + (b4 ? 2 : 0) + (b3 ? 1 : 0), colA = (p >> 1) * 4 + (p & 1);
    float cf[16];
#pragma unroll
    for (int it = 0; it < 16; ++it) cf[it] = __uint_as_float((unsigned)bperm_i((it * 8 + g) & 63, (int)__float_as_uint(it < 8 ? c0 : c1)));
#pragma unroll
    for (int pass = 0; pass < 2; ++pass) {
        f32x2 acc2[4];
#pragma unroll
        for (int c = 0; c < 4; ++c) acc2[c] = (f32x2){0.f, 0.f};
#pragma unroll
        for (int it = 0; it < 16; ++it) { const f32x2 c2 = {cf[it], cf[it]};
#pragma unroll
            for (int w = 0; w < 4; ++w) { const f32x2 v = pass ? __builtin_amdgcn_cvt_pk_f32_fp8((int)row[it][w], true) : __builtin_amdgcn_cvt_pk_f32_fp8((int)row[it][w], false); acc2[w] = __builtin_elementwise_fma(c2, v, acc2[w]); }
            if ((it & 3) == 3) __builtin_amdgcn_sched_barrier(0);
        }
        float acc[8];
#pragma unroll
        for (int c = 0; c < 4; ++c) { acc[2 * c] = acc2[c][0]; acc[2 * c + 1] = acc2[c][1]; }
        float w4[4], w2[2], y;
#pragma unroll
        for (int q = 0; q < 4; ++q) { const float send = b5 ? acc[q] : acc[q + 4], keep = b5 ? acc[q + 4] : acc[q]; w4[q] = keep + __shfl_xor(send, 32); }
#pragma unroll
        for (int q = 0; q < 2; ++q) { const float send = b4 ? w4[q] : w4[q + 2], keep = b4 ? w4[q + 2] : w4[q]; w2[q] = keep + __shfl_xor(send, 16); }
        { const float send = b3 ? w2[0] : w2[1], keep = b3 ? w2[1] : w2[0]; y = keep + __shfl_xor(send, 8); }
        op[i * 16 + colA + 2 * pass] = (bf16)f2bf(y);
    }
}
DEVI void gv_chunk(const Args& a, int j, int chunk, int wave, int lane) {
    unsigned char* ws = a.ws;
    const int g = lane >> 3, i = lane & 7;
    const unsigned char* tab = ws + WS_PV + (size_t)j * PNE * 128 + i * 16;
    const int* idbase = (const int*)(ws + WS_IDS); const float* cfbase = (const float*)(ws + WS_CF);
    bf16* obase = (bf16*)(ws + WS_OP) + j * 128;
    const int t0 = chunk * 256 + wave * 32;
    v4u rowA[16], rowB[16];
    int ia0 = idbase[(size_t)t0 * 128 + lane], ia1 = idbase[(size_t)t0 * 128 + 64 + lane];
    int ib0 = idbase[(size_t)(t0 + 1) * 128 + lane], ib1 = idbase[(size_t)(t0 + 1) * 128 + 64 + lane];
    float ca0 = cfbase[(size_t)t0 * 128 + lane], ca1 = cfbase[(size_t)t0 * 128 + 64 + lane], cb0, cb1;
    gx_issue(rowA, tab, ia0, ia1, g);
    for (int tt = 0; tt < 32; tt += 2) {
        const int t = t0 + tt; const bool more = tt + 2 < 32;
        if (more) { ia0 = idbase[(size_t)(t + 2) * 128 + lane]; ia1 = idbase[(size_t)(t + 2) * 128 + 64 + lane]; }
        cb0 = cfbase[(size_t)(t + 1) * 128 + lane]; cb1 = cfbase[(size_t)(t + 1) * 128 + 64 + lane];
        __builtin_amdgcn_sched_barrier(0);
        gx_issue(rowB, tab, ib0, ib1, g);
        __builtin_amdgcn_sched_barrier(0);
        gv_math(rowA, ca0, ca1, obase + (size_t)t * 1024, g, i, lane);
        __builtin_amdgcn_sched_barrier(0);
        if (more) { ib0 = idbase[(size_t)(t + 3) * 128 + lane]; ib1 = idbase[(size_t)(t + 3) * 128 + 64 + lane];
            ca0 = cfbase[(size_t)(t + 2) * 128 + lane]; ca1 = cfbase[(size_t)(t + 2) * 128 + 64 + lane]; }
        __builtin_amdgcn_sched_barrier(0);
        if (more) gx_issue(rowA, tab, ia0, ia1, g);
        __builtin_amdgcn_sched_barrier(0);
        gv_math(rowB, cb0, cb1, obase + (size_t)(t + 1) * 1024, g, i, lane);
        __builtin_amdgcn_sched_barrier(0);
    }
}
template <int WHICH> DEVI void sliced_phase(const Args& a, LAS unsigned char* lds, int wave, int lane, int ctr_off = 0) {
    unsigned* ctr = (unsigned*)(a.ws + WS_CTL) + (WHICH ? CW_GV : CW_GU) + ctr_off;
    volatile LAS unsigned* slot = (volatile LAS unsigned*)(lds + LDS_BYTES - 32);
#ifdef SLICE_BY_BLOCK
    const int xcc = (int)(blockIdx.x & 7u);
#else
    const int xcc = (int)(xb_xcc_id() & 7u);
#endif
    for (int pass = 0; pass < 8; ++pass) {
        const int j = (xcc + pass) & 7;
        for (;;) {
            __syncthreads();
            if (threadIdx.x == 0) *slot = __hip_atomic_fetch_add(ctr + 64 * j, 1u, __ATOMIC_RELAXED, __HIP_MEMORY_SCOPE_AGENT);
            __syncthreads();
            const unsigned c = *slot;
            if (c >= (unsigned)(T / 256)) break;
            if (WHICH) gv_chunk(a, j, (int)c, wave, lane); else gu_chunk(a, j, (int)c, wave, lane);
        }
    }
}
DEVI void coef_phase(const Args& a) {
    unsigned char* ws = a.ws;
    const float* PD = (const float*)(ws + WS_PD); const float* gts = (const float*)(ws + WS_GATES); float* CF = (float*)(ws + WS_CF);
    for (size_t i = (size_t)blockIdx.x * 512 + threadIdx.x; i < (size_t)T * 128 / 4; i += (size_t)gridDim.x * 512) {
        f32x4 s = *(const f32x4*)(PD + i * 4);
#pragma unroll
        for (int j = 1; j < 8; ++j) s += *(const f32x4*)(PD + (size_t)j * T * 128 + i * 4);
        const f32x4 gt = *(const f32x4*)(gts + i * 4);
        f32x4 o;
#if PEER_U_INT8
        const v4u ev = *(const v4u*)((const int*)(ws + WS_IDS) + i * 4);
        const float xsc = ((const float*)(ws + WS_XS))[i >> 5];
        const float* us = (const float*)(ws + WS_US);
#pragma unroll
        for (int q = 0; q < 4; ++q) o[q] = gt[q] * gelu_t(s[q] * xsc * us[ev[q]]) * (1.0f / PV_SCALE);
#else
#pragma unroll
        for (int q = 0; q < 4; ++q) o[q] = gt[q] * gelu_t(s[q] * (1.0f / PU_SCALE)) * (1.0f / PV_SCALE);
#endif
        *(f32x4*)(CF + i * 4) = o;
    }
}
template <int NT> DEVI void ln2_tokens(const Args& a, int t0, int tstride, int lane) {
    unsigned char* ws = a.ws;
    v4u xr[NT][2], orr[NT][2];
#pragma unroll
    for (int q = 0; q < NT; ++q) { const size_t o = (size_t)(t0 + q * tstride) * 1024 + lane * 16;
        const bf16* xp = (const bf16*)(ws + WS_X1B) + o; const bf16* ip = (const bf16*)(ws + WS_OP) + o;
        xr[q][0] = *(const v4u*)xp; xr[q][1] = *(const v4u*)(xp + 8); orr[q][0] = *(const v4u*)ip; orr[q][1] = *(const v4u*)(ip + 8); }
    const float* g2 = a.in[23] + lane * 16; const float* b2 = a.in[24] + lane * 16;
    f32x4 gg[4], bb[4];
#pragma unroll
    for (int i = 0; i < 4; ++i) { gg[i] = *(const f32x4*)(g2 + 4 * i); bb[i] = *(const f32x4*)(b2 + 4 * i); }
#pragma unroll
    for (int q = 0; q < NT; ++q) {
        float xf[16], acc[16];
        { float t0a[8], t1a[8]; unpack8(xr[q][0], t0a); unpack8(xr[q][1], t1a);
#pragma unroll
          for (int i = 0; i < 8; ++i) { xf[i] = t0a[i]; xf[8 + i] = t1a[i]; } }
        { float t0a[8], t1a[8]; unpack8(orr[q][0], t0a); unpack8(orr[q][1], t1a);
#pragma unroll
          for (int i = 0; i < 8; ++i) { acc[i] = t0a[i]; acc[8 + i] = t1a[i]; } }
        float s = 0.f;
#pragma unroll
        for (int i = 0; i < 16; ++i) { acc[i] += ALPHA * xf[i]; s += acc[i]; }
        const float mean = wave_sum(s) * (1.0f / 1024.0f); float qq = 0.f;
#pragma unroll
        for (int i = 0; i < 16; ++i) { acc[i] -= mean; qq += acc[i] * acc[i]; }
        const float rstd = rsqrtf(wave_sum(qq) * (1.0f / 1024.0f) + LN_EPS);
        float* op = a.out + (size_t)(t0 + q * tstride) * 1024 + lane * 16;
#pragma unroll
        for (int i = 0; i < 4; ++i) {
            f32x4 y; y[0] = acc[4 * i] * rstd * gg[i][0] + bb[i][0]; y[1] = acc[4 * i + 1] * rstd * gg[i][1] + bb[i][1]; y[2] = acc[4 * i + 2] * rstd * gg[i][2] + bb[i][2]; y[3] = acc[4 * i + 3] * rstd * gg[i][3] + bb[i][3];
            *(f32x4*)(op + 4 * i) = y;
        }
    }
}

enum Phase { PH_PREP = 0, PH_PROJ, PH_S5Z, PH_S5SCAN, PH_S5Y, PH_HGRN, PH_GLU, PH_MERGE, PH_OUT, PH_LN1, PH_SCORES, PH_TOPK, PH_GU, PH_COEF, PH_GV, PH_LN2, PH_COUNT };

template <class Epi> DEVI void run_gemm(LAS unsigned char* lds, const bf16* A, const bf16* Bt, int M, int N, int K, int lda, int ldb, const Epi& E) {
    pg8::Gemm g; g.A = A; g.Bt = Bt; g.M = M; g.N = N; g.K = K; g.lda = lda; g.ldb = ldb; g.sA = 0; g.sB = 0; g.nz = 1;
    pg8::StaticOrder S; S.init(M, N, gridDim.x, blockIdx.x, 1);
    pg8::gemm_phase<Epi, pg8::StaticOrder, true, true>(lds, g, S, E);
}
template <class Epi> DEVI void run_gemm_batched(LAS unsigned char* lds, const bf16* A, const bf16* Bt, int M, int N, int K, int lda, int ldb, size_t sA, size_t sB, int nz, const Epi& E, int cidx = -1) {
    pg8::Gemm g; g.A = A; g.Bt = Bt; g.M = M; g.N = N; g.K = K; g.lda = lda; g.ldb = ldb; g.sA = sA; g.sB = sB; g.nz = nz;
    pg8::StaticOrder S; S.init(M, N, gridDim.x, cidx < 0 ? (int)blockIdx.x : cidx, nz);
    pg8::gemm_phase<Epi, pg8::StaticOrder, true, true>(lds, g, S, E);
}

#ifndef MK_COOP
#define MK_COOP 1
#endif
__global__ void __launch_bounds__(512, 2) mk_fwd(Args a) {
    extern __shared__ __attribute__((aligned(16))) unsigned char smem[];
    LAS unsigned char* lds = (LAS unsigned char*)smem;
    cg::grid_group grid = cg::this_grid();
    const int tid = threadIdx.x, lane = tid & 63, wave = __builtin_amdgcn_readfirstlane(tid >> 6), G = gridDim.x;
    unsigned char* ws = a.ws;
    volatile LAS unsigned* bst = (volatile LAS unsigned*)(lds + LDS_BYTES - 16);
    if (tid < 2) bst[tid] = 0u;
    __syncthreads();
    const XcdBarrier xb = xcd_barrier_post((unsigned*)(ws + WS_CTL), bst);
#ifndef REP_PH
#define REP_PH -1
#endif
#ifndef REP_N
#define REP_N 1
#endif
#define PH_BEGIN(P) if (a.ph_lo <= (P) && (P) < a.ph_hi) { if (a.ph_lo < (P)) { if (MK_COOP && (P) == PH_PROJ) grid.sync(); else xcd_barrier(xb); } for (int rep_ = 0; rep_ < ((P) == REP_PH ? REP_N : 1); ++rep_) {
#define PH_END } }
    PH_BEGIN(PH_PREP) phase_prep(a, lds); for (int it = blockIdx.x; it < S5G * 8; it += G) s5_tables_item(a, lds, it); PH_END
    PH_BEGIN(PH_PROJ) EpiProj E; E.ws = ws; E.lb_logits = a.in[12];
        run_gemm(lds, (const bf16*)(ws + WS_XB), (const bf16*)(ws + WS_WINT), T, INC, 1024, 1024, 1024, E); PH_END
    PH_BEGIN(PH_S5Z)
        for (int it = blockIdx.x; it < 256; it += G) if ((it & 3) != 3) hgrn_segment<false>(a, lds, it);
        __syncthreads();
        EpiS5Z E; E.ws = ws;
        run_gemm_batched(lds, (const bf16*)(ws + WS_U5), (const bf16*)(ws + WS_WZ), 1024, 256, 1024, UK, 1024, (size_t)1024 * UK, (size_t)256 * 1024, S5G, E, G - 1 - (int)blockIdx.x); PH_END
    PH_BEGIN(PH_S5SCAN) s5_scan(a); PH_END
    PH_BEGIN(PH_S5Y) EpiS5Y E; E.ws = ws;
        run_gemm_batched(lds, (const bf16*)(ws + WS_U5), (const bf16*)(ws + WS_TY), 1024, 1024, UK, UK, UK, (size_t)1024 * UK, (size_t)1024 * UK, S5G, E); PH_END
    PH_BEGIN(PH_HGRN) for (int it = blockIdx.x; it < 256; it += G) hgrn_segment<true>(a, lds, it); PH_END
    PH_BEGIN(PH_GLU) EpiGlu E; E.ws = ws; E.bias = a.in[11];
        run_gemm(lds, (const bf16*)(ws + WS_Y2), (const bf16*)(ws + WS_WGLUT), T, 512, 512, 512, 512, E); PH_END
    PH_BEGIN(PH_MERGE) EpiMerge E; E.ws = ws;
        pg8::Gemm g; g.A = (const bf16*)(ws + WS_YAB); g.Bt = (const bf16*)(ws + WS_WPAT); g.M = T; g.N = 1024; g.K = 512; g.lda = 1024; g.ldb = 1024; g.sA = 512; g.sB = 512; g.nz = 2;
        pg8::ChainOrder S; S.init(T, 1024, G, blockIdx.x, 1);
        pg8::gemm_phase<EpiMerge, pg8::ChainOrder, true, true>(lds, g, S, E); PH_END
    PH_BEGIN(PH_OUT) EpiOut E; E.ws = ws; E.x = a.in[0];
        run_gemm(lds, (const bf16*)(ws + WS_MG), (const bf16*)(ws + WS_WOT), T, 1024, 1024, 1024, 1024, E); PH_END
    PH_BEGIN(PH_LN1) for (int r = blockIdx.x * 8 + wave; r < T; r += 8 * G * 4) ln1_rows<4>(a, r, 8 * G, lane); PH_END
    PH_BEGIN(PH_SCORES) EpiScores E; E.ws = ws;
        run_gemm(lds, (const bf16*)(ws + WS_X1B), (const bf16*)(ws + WS_WFT), T, 2048, 1024, 1024, 1024, E); PH_END
    PH_BEGIN(PH_TOPK) LAS float* stg = (LAS float*)(lds + wave * 9216);
        for (int it = blockIdx.x * 8 + wave; it < (T / 64) * PH; it += 8 * G) topk_block(a, stg, it, lane); PH_END
    PH_BEGIN(PH_GU) sliced_phase<0>(a, lds, wave, lane);
#ifdef PROBE_GU2
        sliced_phase<0>(a, lds, wave, lane, 64 * 16);
#endif
    PH_END
    PH_BEGIN(PH_COEF) coef_phase(a); PH_END
    PH_BEGIN(PH_GV) sliced_phase<1>(a, lds, wave, lane);
#ifdef PROBE_GV2
        sliced_phase<1>(a, lds, wave, lane, 64 * 16);
#endif
    PH_END
    PH_BEGIN(PH_LN2) for (int t = blockIdx.x * 8 + wave; t < T; t += 8 * G * 4) ln2_tokens<4>(a, t, 8 * G, lane); PH_END
}

#ifndef MK_ONE_LAUNCH
#define MK_ONE_LAUNCH 1
#endif

extern "C" void kernel_launch(void* const* d_in, const int* in_sizes, int n_in, void* d_out, int out_size, void* d_ws, size_t ws_size, hipStream_t stream) {
    static int grid = 0;
    if (grid == 0) {
        if (n_in != 25 || out_size != T * D || ws_size < WS_END) { fprintf(stderr, "kernel_launch: unexpected problem (n_in %d, out %d, ws %zu)\n", n_in, out_size, ws_size); grid = -1; return; }
        int dev = 0, cus = 0, per_cu = 0;
        if (hipGetDevice(&dev) != hipSuccess || hipDeviceGetAttribute(&cus, hipDeviceAttributeMultiprocessorCount, dev) != hipSuccess) { grid = -1; return; }
        if (hipFuncSetAttribute((const void*)mk_fwd, hipFuncAttributeMaxDynamicSharedMemorySize, LDS_BYTES) != hipSuccess) { fprintf(stderr, "kernel_launch: hipFuncSetAttribute failed\n"); grid = -1; return; }
        if (hipOccupancyMaxActiveBlocksPerMultiprocessor(&per_cu, (const void*)mk_fwd, 512, LDS_BYTES) != hipSuccess || per_cu < 1) { fprintf(stderr, "kernel_launch: occupancy query says %d\n", per_cu); per_cu = 1; }
        (void)hipGetLastError();
        grid = cus;
    }
    if (grid < 0) return;
    Args a{};
    for (int i = 0; i < 25; ++i) a.in[i] = (const float*)d_in[i];
    a.out = (float*)d_out; a.ws = (unsigned char*)d_ws;
#if MK_ONE_LAUNCH
    if (hipMemsetAsync((char*)d_ws + WS_CTL, 0, CTL_WORDS * 4, stream) != hipSuccess) { fprintf(stderr, "kernel_launch: memset of the barrier words failed\n"); return; }
    a.ph_lo = 0; a.ph_hi = PH_COUNT;
#if MK_COOP
    void* kargs[] = {&a};
    hipError_t e = hipLaunchCooperativeKernel((const void*)mk_fwd, dim3(grid), dim3(512), kargs, LDS_BYTES, stream);
    if (e != hipSuccess) fprintf(stderr, "kernel_launch: cooperative launch failed: %s (grid %d)\n", hipGetErrorString(e), grid);
#else
    hipLaunchKernelGGL(mk_fwd, dim3(grid), dim3(512), LDS_BYTES, stream, a);
#endif
#else
    for (int ph = 0; ph < PH_COUNT; ++ph) {
        a.ph_lo = ph; a.ph_hi = ph + 1;
        hipLaunchKernelGGL(mk_fwd, dim3(grid), dim3(512), LDS_BYTES, stream, a);
    }
#endif
}
```

```cpp
#include <hip/hip_runtime.h>
#include <hip/hip_cooperative_groups.h>
#include <cstdio>
#include <cstdint>
namespace cg = cooperative_groups;

#define DEVI __device__ __forceinline__
#define LAS __attribute__((address_space(3)))
typedef unsigned short bf16;
typedef unsigned v4u __attribute__((ext_vector_type(4)));
typedef unsigned v2u __attribute__((ext_vector_type(2)));
typedef float f32x4 __attribute__((ext_vector_type(4)));
typedef float f32x2 __attribute__((ext_vector_type(2)));
typedef short bf16x8 __attribute__((ext_vector_type(8)));
typedef float f32x16 __attribute__((ext_vector_type(16)));
typedef int i32x4 __attribute__((ext_vector_type(4)));

constexpr int D = 1024, BATCH = 16, SEQ = 4096, T = BATCH * SEQ;
constexpr int S5W = 512, S5H = 16, S5G = 32, S5P = 64;
constexpr int HW = 512, HD = 128, HH = 4;
constexpr int PH = 8, PK = 16, PNK = 128, PNE = 16384;
constexpr int INC = 4608;
constexpr float ALPHA = 1.189207115002721f;
constexpr float LN_EPS = 1e-5f, RMS_EPS = 1e-6f;
constexpr int NCH = 64;
constexpr int UK = 1152;

constexpr size_t MiB = 1u << 20;
constexpr size_t WS_XB = 0;
constexpr size_t WS_Y2 = 0;
constexpr size_t WS_YAB = 64 * MiB;
constexpr size_t WS_X1B = 0;
constexpr size_t WS_U5 = 128 * MiB;
constexpr size_t WS_IDS = 128 * MiB;
constexpr size_t WS_GATES = 160 * MiB;
constexpr size_t WS_Q = 200 * MiB;
constexpr size_t WS_LF = 264 * MiB;
constexpr size_t WS_MG = 264 * MiB;
constexpr size_t WS_VV = 392 * MiB;
constexpr size_t WS_GS = 456 * MiB;
constexpr size_t WS_GA = 520 * MiB;
constexpr size_t WS_GB = 648 * MiB;
constexpr size_t WS_H1 = 392 * MiB;
constexpr size_t WS_SC = 264 * MiB;
constexpr size_t WS_PD = 264 * MiB;
constexpr size_t WS_OP = 264 * MiB;
constexpr size_t WS_CF = 520 * MiB;
constexpr size_t WS_WINT = 776 * MiB;
constexpr size_t WS_WGLUT = 785 * MiB;
constexpr size_t WS_WPAT = 786 * MiB;
constexpr size_t WS_WOT = 788 * MiB;
constexpr size_t WS_WFT = 790 * MiB;
constexpr size_t WS_WZ = 794 * MiB;
constexpr size_t WS_TY = 810 * MiB;
constexpr size_t WS_PU = 882 * MiB;
constexpr size_t WS_PV = 914 * MiB;
constexpr size_t WS_Z = 946 * MiB;
constexpr size_t WS_L64 = 962 * MiB;
constexpr size_t WS_HGS = 963 * MiB;
constexpr size_t WS_HGD = 979 * MiB;
constexpr size_t WS_US = 979 * MiB + 256 * 1024;
constexpr size_t WS_XS = 979 * MiB + 512 * 1024;
constexpr size_t WS_XSC = 979 * MiB + 768 * 1024;
constexpr size_t WS_WSC = 962 * MiB + 32 * 1024;
constexpr size_t WS_WFS = 962 * MiB + 64 * 1024;
constexpr size_t WS_X1Q = 192 * MiB;
constexpr size_t WS_CTL = 980 * MiB;
constexpr size_t WS_END = 981 * MiB;

#ifndef PEER_FP8
#define PEER_FP8 1
#endif
constexpr float PU_SCALE = 256.0f, PV_SCALE = 16.0f;
#ifndef SCORES_INT8
#define SCORES_INT8 0
#endif
#ifndef PROJ_INT8
#define PROJ_INT8 1
#endif
#ifndef PEER_U_INT8
#define PEER_U_INT8 1
#endif
constexpr int CTL_WORDS = 8192;
constexpr int CW_GU = 4096, CW_GV = 4096 + 64 * 8;
constexpr int LDS_BYTES = 147456;

DEVI unsigned f2bf(float f) { unsigned u = __float_as_uint(f); return (u + 0x7fffu + ((u >> 16) & 1u)) >> 16; }
DEVI unsigned pk2(float lo, float hi) { return f2bf(lo) | (f2bf(hi) << 16); }
typedef _Float16 h16x2 __attribute__((ext_vector_type(2)));
DEVI unsigned pkh2(float a, float b) { const h16x2 v = {(_Float16)a, (_Float16)b}; return __builtin_bit_cast(unsigned, v); }
DEVI float h2f(unsigned short b) { return (float)__builtin_bit_cast(_Float16, b); }
DEVI float bflo(unsigned w) { return __uint_as_float(w << 16); }
DEVI float bfhi(unsigned w) { return __uint_as_float(w & 0xffff0000u); }
DEVI float bf2f(bf16 b) { return __uint_as_float(((unsigned)b) << 16); }
DEVI float sigm(float x) { return __builtin_amdgcn_rcpf(1.0f + __builtin_amdgcn_exp2f(-1.4426950408889634f * x)); }
DEVI float silu(float x) { return x * sigm(x); }
DEVI float gelu_t(float x) { return x * sigm(1.5957691216057308f * (x + 0.044715f * x * x * x)); }
DEVI float wave_sum(float v) {
#pragma unroll
    for (int o = 1; o < 64; o <<= 1) v += __shfl_xor(v, o);
    return v;
}
DEVI float wave_max(float v) {
#pragma unroll
    for (int o = 1; o < 64; o <<= 1) v = fmaxf(v, __shfl_xor(v, o));
    return v;
}

struct Args { const float* in[25]; float* out; unsigned char* ws; int ph_lo, ph_hi; };

#define XB_TMO      128
#define XB_XCNT(j)  (256  + 64 * (j))
#define XB_XSUB(j)  (1280 + 64 * (j))
#define XB_XGEN(j)  (2304 + 64 * (j))
#define XB_TOP      3328
#define XB_TOPGEN   3392
#define XCD_BAR_WORDS 3456
#define XB_SPIN_CAP (1u << 20)

__device__ __forceinline__ unsigned xb_ld(unsigned* p)              { return __hip_atomic_load(p, __ATOMIC_RELAXED, __HIP_MEMORY_SCOPE_AGENT); }
__device__ __forceinline__ unsigned xb_add(unsigned* p, unsigned v) { return __hip_atomic_fetch_add(p, v, __ATOMIC_RELAXED, __HIP_MEMORY_SCOPE_AGENT); }
__device__ __forceinline__ unsigned xb_xcc_id() { return (unsigned)__builtin_amdgcn_s_getreg((3 << 11) | 20) & 0xFu; }
#define XB_SPIN(cond, bar) do { unsigned _sp = 0; while (cond) { __builtin_amdgcn_s_sleep(1); \
    if ((++_sp & 255u) == 0u) { if (xb_ld(&(bar)[XB_TMO])) break; if (_sp > XB_SPIN_CAP) { atomicAdd(&(bar)[XB_TMO], 1u); break; } } } } while (0)

struct XcdBarrier {
    unsigned* bar; unsigned x;
    volatile LAS unsigned* st;
};

__device__ __forceinline__ XcdBarrier xcd_barrier_post(unsigned* bar, volatile LAS unsigned* st) {
    XcdBarrier b; b.bar = bar; b.x = xb_xcc_id(); b.st = st;
    if (threadIdx.x == 0) (void)xb_add(&bar[XB_XCNT(b.x)], 1u);
    return b;
}
__device__ __forceinline__ void xcd_barrier_complete(unsigned* bar, unsigned x, unsigned& nloc, unsigned& nx) {
    const unsigned G = gridDim.x * gridDim.y * gridDim.z;
    unsigned sum, cnt, mine, sp = 0u;
    for (;;) {
        sum = 0u; cnt = 0u; mine = 0u;
#pragma unroll
        for (unsigned j = 0; j < 16; ++j) { const unsigned c = xb_ld(&bar[XB_XCNT(j)]); sum += c; cnt += (c > 0u) ? 1u : 0u; mine = (j == x) ? c : mine; }
        if (sum == G) break;
        __builtin_amdgcn_s_sleep(1);
        if ((++sp & 255u) == 0u) { if (xb_ld(&bar[XB_TMO])) break; if (sp > XB_SPIN_CAP) { atomicAdd(&bar[XB_TMO], 1u); break; } }
    }
    nloc = mine > 0u ? mine : 1u; nx = cnt > 0u ? cnt : 1u;
}

__device__ __forceinline__ void xcd_barrier(const XcdBarrier& b) {
    asm volatile("s_waitcnt vmcnt(0)" ::: "memory");
    __syncthreads();
    if (threadIdx.x == 0) {
        unsigned* bar = b.bar;
        __builtin_amdgcn_s_waitcnt(0);
        unsigned nloc = b.st[0], nx = b.st[1];
        if (nloc == 0u) { xcd_barrier_complete(bar, b.x, nloc, nx); b.st[0] = nloc; b.st[1] = nx; }
        const unsigned old = xb_add(&bar[XB_XSUB(b.x)], 1u);
        const unsigned gen = old / nloc;
        if (old + 1u == (gen + 1u) * nloc) {
            __builtin_amdgcn_fence(__ATOMIC_RELEASE, "agent");
            asm volatile("s_waitcnt vmcnt(0)" ::: "memory");
            const unsigned og = xb_add(&bar[XB_TOP], 1u);
            const unsigned tg = og / nx;
            if (og + 1u == (tg + 1u) * nx) xb_add(&bar[XB_TOPGEN], 1u);
            else XB_SPIN(xb_ld(&bar[XB_TOPGEN]) == tg, bar);
            __builtin_amdgcn_fence(__ATOMIC_ACQUIRE, "agent");
            xb_add(&bar[XB_XGEN(b.x)], 1u);
            asm volatile("s_waitcnt vmcnt(0)" ::: "memory");
        } else {
            XB_SPIN(xb_ld(&bar[XB_XGEN(b.x)]) == gen, bar);
            __builtin_amdgcn_fence(__ATOMIC_ACQUIRE, "agent");
            asm volatile("s_waitcnt vmcnt(0)" ::: "memory");
        }
    }
    __syncthreads();
}


namespace pg8 {
#ifdef PROBE_EPI_TIME
__device__ unsigned long long pg8_probe_dummy;
#endif
#define PG8_LAS __attribute__((address_space(3)))
typedef unsigned short bf16_t;
constexpr int BM = 256, BK = 64, HALF = 128, HTB = HALF * BK * 2  , STAGE_BYTES = 8 * HTB, NXCD = 8, WGM = 8;

__host__ __device__ __forceinline__ int lds_byte(int r, int c) { const int st = (r >> 4) * 2 + (c >> 5), rr = r & 15, cc = c & 31, ob = rr * 64 + cc * 2; return st * 1024 + (ob ^ (((ob >> 9) & 1) << 5)); }
__host__ __device__ __forceinline__ void stage_rc(int b, int& R, int& C) { const int st = b / 1024, sb = b % 1024, swz = sb ^ (((sb >> 9) & 1) << 5); R = (st >> 1) * 16 + swz / 64; C = (st & 1) * 32 + (swz % 64) / 2; }
__host__ __device__ __forceinline__ int perm32(int rho) { const int n = rho >> 4, i = rho & 15; return 8 * (i >> 2) + 4 * n + (i & 3); }

struct Unit { int pm, pn, z; };
struct Gemm { const bf16_t* A; const bf16_t* Bt; int M, N, K, lda, ldb; size_t sA, sB; int nz; };

struct StaticOrder {
    int nM, nN, nwg, G, c, nz;
    __host__ __device__ void init(int M, int N, int G_, int c_, int nz_ = 1) { nM = M / BM; nN = N / BM; nwg = nM * nN; G = G_; c = c_; nz = nz_; }
    __host__ __device__ bool next(int i, Unit& u) const {
        const long L0 = (long)i * G + c; if (L0 >= (long)nwg * nz) return false;
        u.z = (int)(L0 / nwg); int wgid = (int)(L0 % nwg); { const int q = nwg / NXCD, r = nwg % NXCD, xcd = wgid % NXCD, off = wgid / NXCD; wgid = (xcd < r ? xcd * (q + 1) : r * (q + 1) + (xcd - r) * q) + off; }
        const int nig = WGM * nN, gid = wgid / nig, fm = gid * WGM, gsz = (nM - fm) < WGM ? (nM - fm) : WGM;
        u.pm = fm + ((wgid % nig) % gsz); u.pn = (wgid % nig) / gsz; return true;
    }
    __device__ __forceinline__ void a_ready(const Unit&) const {}
    __device__ __forceinline__ void done(const Unit&) const {}
};

struct ChainOrder : StaticOrder {
    __host__ __device__ bool next(int i, Unit& u) const { if (!StaticOrder::next(i >> 1, u)) return false; u.z = i & 1; return true; }
};
__device__ __forceinline__ unsigned cvt_pk_bf16(float lo, float hi) { unsigned r; asm volatile("v_cvt_pk_bf16_f32 %0, %1, %2" : "=v"(r) : "v"(lo), "v"(hi)); return r; }

__device__ __forceinline__ f32x4 pg8_mma(const bf16x8& b, const bf16x8& a, const f32x4& c) { return __builtin_amdgcn_mfma_f32_16x16x32_bf16(b, a, c, 0, 0, 0); }
__device__ __forceinline__ i32x4 pg8_mma(const bf16x8& b, const bf16x8& a, const i32x4& c) { return __builtin_amdgcn_mfma_i32_16x16x64_i8(__builtin_bit_cast(i32x4, b), __builtin_bit_cast(i32x4, a), c, 0, 0, 0); }
template <class Epi, class Sched, bool ALIGN_EPI = false, bool SP2 = false>
__device__ __forceinline__ void gemm_phase(PG8_LAS unsigned char* lds, const Gemm g, const Sched& S, const Epi& E) {
    const int tid = threadIdx.x, wid = __builtin_amdgcn_readfirstlane(tid >> 6), lane = tid & 63, wr = wid >> 2, wc = wid & 3, fr = lane & 15, fq = lane >> 4;
    const int K = g.K, nt = K / BK;
    unsigned voffA[2], voffB[2];
#pragma unroll
    for (int i = 0; i < 2; ++i) { int R, C; stage_rc(tid * 16 + i * 8192, R, C); const int Rb = Epi::PERM ? ((R & ~31) + perm32(R & 31)) : R;
        voffA[i] = (unsigned)(R * g.lda + C) * 2u; voffB[i] = (unsigned)(Rb * g.ldb + C) * 2u; }
    const size_t kstep = (size_t)(BK * 2);
    const size_t hstepA = (size_t)HALF * g.lda * 2, hstepB = (size_t)HALF * g.ldb * 2;
    const size_t tstepA = 2 * hstepA, tstepB = 2 * hstepB;
    const unsigned ldsw = (unsigned)wid * 1024u;
    const int aoff = lds_byte(wr * 64 + fr, fq * 8), boff = lds_byte(wc * 32 + fr, fq * 8);
#define PG8_SA(b, h) (((b) * 2 + (h)) * HTB)
#define PG8_SB(b, h) ((4 + (b) * 2 + (h)) * HTB)
#define PG8_STAGE(bufoff, gbase, voff) do { _Pragma("unroll") for (int _i = 0; _i < 2; ++_i) \
        __builtin_amdgcn_global_load_lds((const unsigned*)((const char*)(gbase) + (voff)[_i]), (PG8_LAS unsigned*)(lds + (bufoff) + ldsw + _i * 8192), 16, 0, 0); } while (0)
#define PG8_LDA(dst, b, h) do { _Pragma("unroll") for (int m = 0; m < 4; ++m) _Pragma("unroll") for (int k = 0; k < 2; ++k) dst[m][k] = *(const PG8_LAS bf16x8*)(lds + PG8_SA(b, h) + aoff + m * 2048 + k * 1024); } while (0)
#define PG8_LDB(dst, b, h) do { _Pragma("unroll") for (int n = 0; n < 2; ++n) _Pragma("unroll") for (int k = 0; k < 2; ++k) dst[n][k] = *(const PG8_LAS bf16x8*)(lds + PG8_SB(b, h) + boff + n * 2048 + k * 1024); } while (0)
#define PG8_MMA(ai, bj, At, Bt) do { __builtin_amdgcn_s_setprio(1); _Pragma("unroll") for (int m = 0; m < 4; ++m) _Pragma("unroll") for (int n = 0; n < 2; ++n) _Pragma("unroll") for (int k = 0; k < 2; ++k) \
        acc[ai][bj][m][n] = pg8_mma(Bt[n][k], At[m][k], acc[ai][bj][m][n]); __builtin_amdgcn_s_setprio(0); } while (0)
#define PG8_WAIT_V(n) asm volatile("s_waitcnt vmcnt(" #n ")" ::: "memory")
#define PG8_WAIT_L(n) asm volatile("s_waitcnt lgkmcnt(" #n ")" ::: "memory")
#define PG8_BAR __builtin_amdgcn_s_barrier()
#define PG8_SCHED __builtin_amdgcn_sched_barrier(0)
#if defined(PROBE_EPI_TIME) || defined(PROBE_KLOOP_TIME)
    unsigned long long pg8_probe_acc = 0;
#endif
    Unit cur, nxt; int ui = 0;
    if (!S.next(0, cur)) return;
    typedef typename Epi::acc_t acc_t;
    acc_t acc[2][2][4][2];
#pragma unroll
    for (int a = 0; a < 2; ++a)
#pragma unroll
        for (int b = 0; b < 2; ++b)
#pragma unroll
            for (int m = 0; m < 4; ++m)
#pragma unroll
                for (int n = 0; n < 2; ++n) acc[a][b][m][n] = (acc_t){0, 0, 0, 0};
    bf16x8 At[4][2], B0[2][2], B1[2][2];
    const char* cA = (const char*)(g.A + (size_t)cur.z * g.sA) + (size_t)cur.pm * tstepA; const char* cB = (const char*)(g.Bt + (size_t)cur.z * g.sB) + (size_t)cur.pn * tstepB;
    S.a_ready(cur);
    if constexpr (SP2) {
        PG8_STAGE(PG8_SB(0, 0), cB, voffB); PG8_STAGE(PG8_SB(0, 1), cB + hstepB, voffB); PG8_STAGE(PG8_SA(0, 0), cA, voffA); PG8_STAGE(PG8_SA(0, 1), cA + hstepA, voffA);
        if (wr == 1) PG8_BAR;
        PG8_WAIT_V(2); PG8_BAR;
        PG8_STAGE(PG8_SB(1, 0), cB + kstep, voffB); PG8_STAGE(PG8_SA(1, 0), cA + kstep, voffA); PG8_STAGE(PG8_SB(1, 1), cB + hstepB + kstep, voffB);
        PG8_WAIT_V(6); PG8_BAR;
    } else {
        PG8_STAGE(PG8_SB(0, 0), cB, voffB); PG8_STAGE(PG8_SA(0, 0), cA, voffA); PG8_STAGE(PG8_SB(0, 1), cB + hstepB, voffB); PG8_STAGE(PG8_SA(0, 1), cA + hstepA, voffA);
        if (wr == 1) PG8_BAR;
        PG8_WAIT_V(4); PG8_BAR;
        PG8_STAGE(PG8_SB(1, 0), cB + kstep, voffB); PG8_STAGE(PG8_SA(1, 0), cA + kstep, voffA); PG8_STAGE(PG8_SB(1, 1), cB + hstepB + kstep, voffB);
        PG8_WAIT_V(6); PG8_BAR;
    }
    for (;;) {
        const bool has_next = S.next(ui + 1, nxt);
        const char* nA = has_next ? (const char*)(g.A + (size_t)nxt.z * g.sA) + (size_t)nxt.pm * tstepA : cA; const char* nB = has_next ? (const char*)(g.Bt + (size_t)nxt.z * g.sB) + (size_t)nxt.pn * tstepB : cB;
#ifdef PROBE_KLOOP_TIME
        const unsigned long long kt0_ = __builtin_amdgcn_s_memrealtime();
#endif
        for (int t = 0; t < nt; t += 2) {
            const bool last = (t == nt - 2);
            const char* a1 = cA + (size_t)(t + 1) * kstep;
            const char* a2 = last ? nA : cA + (size_t)(t + 2) * kstep; const char* b2 = last ? nB : cB + (size_t)(t + 2) * kstep;
            const char* a3 = a2 + kstep; const char* b3 = b2 + kstep;
            if (last && has_next) S.a_ready(nxt);
            if constexpr (SP2) {
            PG8_LDB(B0, 0, 0); PG8_LDB(B1, 0, 1); PG8_SCHED; PG8_LDA(At, 0, 0); PG8_STAGE(PG8_SA(1, 1), a1 + hstepA, voffA);
            PG8_WAIT_V(8); PG8_WAIT_L(0); PG8_BAR; PG8_MMA(0, 0, At, B0); PG8_MMA(0, 1, At, B1); PG8_BAR; PG8_SCHED;
            PG8_LDA(At, 0, 1); PG8_STAGE(PG8_SB(0, 0), b2, voffB); PG8_STAGE(PG8_SB(0, 1), b2 + hstepB, voffB); PG8_STAGE(PG8_SA(0, 0), a2, voffA);
            PG8_WAIT_V(8); PG8_WAIT_L(0); PG8_BAR; PG8_MMA(1, 0, At, B0); PG8_MMA(1, 1, At, B1); PG8_BAR; PG8_SCHED;
            PG8_LDB(B0, 1, 0); PG8_LDB(B1, 1, 1); PG8_SCHED; PG8_LDA(At, 1, 0); PG8_STAGE(PG8_SA(0, 1), a2 + hstepA, voffA);
            PG8_WAIT_V(8); PG8_WAIT_L(0); PG8_BAR; PG8_MMA(0, 0, At, B0); PG8_MMA(0, 1, At, B1); PG8_BAR; PG8_SCHED;
            PG8_LDA(At, 1, 1); PG8_STAGE(PG8_SB(1, 0), b3, voffB); PG8_STAGE(PG8_SB(1, 1), b3 + hstepB, voffB); PG8_STAGE(PG8_SA(1, 0), a3, voffA);
            PG8_WAIT_V(8); PG8_WAIT_L(0); PG8_BAR; PG8_MMA(1, 0, At, B0); PG8_MMA(1, 1, At, B1); PG8_BAR; PG8_SCHED;
            } else {
            PG8_LDB(B0, 0, 0); PG8_SCHED; PG8_LDA(At, 0, 0); PG8_STAGE(PG8_SA(1, 1), a1 + hstepA, voffA);
            PG8_WAIT_L(8); PG8_BAR; PG8_WAIT_L(0); PG8_MMA(0, 0, At, B0); PG8_BAR; PG8_SCHED;
            PG8_LDB(B1, 0, 1); PG8_STAGE(PG8_SB(0, 0), b2, voffB);
            PG8_BAR; PG8_WAIT_L(0); PG8_MMA(0, 1, At, B1); PG8_BAR;
            PG8_LDA(At, 0, 1); PG8_STAGE(PG8_SA(0, 0), a2, voffA);
            PG8_BAR; PG8_WAIT_L(0); PG8_MMA(1, 0, At, B0); PG8_BAR; PG8_SCHED;
            PG8_STAGE(PG8_SB(0, 1), b2 + hstepB, voffB);
            PG8_WAIT_V(6); PG8_BAR; PG8_MMA(1, 1, At, B1); PG8_BAR;
            PG8_LDB(B0, 1, 0); PG8_SCHED; PG8_LDA(At, 1, 0); PG8_STAGE(PG8_SA(0, 1), a2 + hstepA, voffA);
            PG8_WAIT_L(8); PG8_BAR; PG8_WAIT_L(0); PG8_MMA(0, 0, At, B0); PG8_BAR; PG8_SCHED;
            PG8_LDB(B1, 1, 1); PG8_STAGE(PG8_SB(1, 0), b3, voffB);
            PG8_BAR; PG8_WAIT_L(0); PG8_MMA(0, 1, At, B1); PG8_BAR;
            PG8_LDA(At, 1, 1); PG8_STAGE(PG8_SA(1, 0), a3, voffA);
            PG8_BAR; PG8_WAIT_L(0); PG8_MMA(1, 0, At, B0); PG8_BAR; PG8_SCHED;
            PG8_STAGE(PG8_SB(1, 1), b3 + hstepB, voffB);
            PG8_WAIT_V(6); PG8_BAR; PG8_MMA(1, 1, At, B1); PG8_BAR;
            }
        }
#ifdef PROBE_KLOOP_TIME
        pg8_probe_acc += __builtin_amdgcn_s_memrealtime() - kt0_;
#endif
        if constexpr (ALIGN_EPI) { if (wr == 0) PG8_BAR; }
#ifdef PROBE_EPI_TIME
        const unsigned long long pt0_ = __builtin_amdgcn_s_memrealtime();
#endif
        if constexpr (!Epi::AFTER_DRAIN) { E(acc, cur, wr, wc, fr, fq); S.done(cur); }
#ifdef PROBE_EPI_TIME
        asm volatile("s_waitcnt vmcnt(0)" ::: "memory");
        pg8_probe_acc += __builtin_amdgcn_s_memrealtime() - pt0_;
#endif
        if (!has_next) break;
        if (!Epi::CHAIN || nxt.z == 0) {
#pragma unroll
        for (int a = 0; a < 2; ++a)
#pragma unroll
            for (int b = 0; b < 2; ++b)
#pragma unroll
                for (int m = 0; m < 4; ++m)
#pragma unroll
                    for (int n = 0; n < 2; ++n) acc[a][b][m][n] = (acc_t){0, 0, 0, 0};
        }
        cur = nxt; cA = nA; cB = nB; ++ui;
        if constexpr (ALIGN_EPI) { if (wr == 1) PG8_BAR; }
    }
    PG8_WAIT_V(0);
    if constexpr (!ALIGN_EPI) { if (wr == 0) PG8_BAR; }
    PG8_BAR;
    if constexpr (Epi::AFTER_DRAIN) { E.fused(acc, cur, wr, wc, fr, fq, lds, wid, lane); S.done(cur); }
#ifdef PROBE_KLOOP_TIME
    if (blockIdx.x == 0 && Epi::PROBE_ME) { const unsigned long long t0_ = __builtin_amdgcn_s_memrealtime(); while (__builtin_amdgcn_s_memrealtime() - t0_ < PROBE_KLOOP_TIME * pg8_probe_acc) __builtin_amdgcn_s_sleep(8); }
#endif
#ifdef PROBE_EPI_TIME
    if (blockIdx.x == 0 && Epi::PROBE_ME) { const unsigned long long t0_ = __builtin_amdgcn_s_memrealtime(); while (__builtin_amdgcn_s_memrealtime() - t0_ < PROBE_EPI_TIME * pg8_probe_acc) __builtin_amdgcn_s_sleep(8); }
#endif
#undef PG8_SA
#undef PG8_SB
#undef PG8_STAGE
#undef PG8_LDA
#undef PG8_LDB
#undef PG8_MMA
#undef PG8_WAIT_V
#undef PG8_WAIT_L
#undef PG8_BAR
#undef PG8_SCHED
}
}

typedef f32x4 AccT[2][2][4][2];
DEVI v4u pack8(const f32x4& a, const f32x4& b) { v4u w; w.x = pk2(a[0], a[1]); w.y = pk2(a[2], a[3]); w.z = pk2(b[0], b[1]); w.w = pk2(b[2], b[3]); return w; }
DEVI void unpack8(const v4u& w, float (&f)[8]) { f[0] = bflo(w.x); f[1] = bfhi(w.x); f[2] = bflo(w.y); f[3] = bfhi(w.y); f[4] = bflo(w.z); f[5] = bfhi(w.z); f[6] = bflo(w.w); f[7] = bfhi(w.w); }

#ifndef PROBE_PROJ
#define PROBE_PROJ false
#endif
struct EpiProj {
    static constexpr bool PERM = true, AFTER_DRAIN = false, CHAIN = false, PROBE_ME = PROBE_PROJ;
#if PROJ_INT8
    typedef i32x4 acc_t;
#else
    typedef f32x4 acc_t;
#endif
    typedef acc_t AccP[2][2][4][2];
    unsigned char* ws; const float* lb_logits;
    template <int TYPE> DEVI void run(const AccP& acc, const pg8::Unit& u, int wr, int wc, int fr, int fq) const {
        const int row0 = u.pm * 256 + wr * 64 + fr;
#if PROJ_INT8
        float xsc[2][4];
#pragma unroll
        for (int ai = 0; ai < 2; ++ai)
#pragma unroll
            for (int m = 0; m < 4; ++m) xsc[ai][m] = ((const float*)(ws + WS_XSC))[row0 + ai * 128 + m * 16];
#endif
#pragma unroll
        for (int bj = 0; bj < 2; ++bj) {
            const int col = u.pn * 256 + bj * 128 + wc * 32 + 8 * fq;
#if PROJ_INT8
            float wsc[8];
            { const f32x4 w0 = *(const f32x4*)((const float*)(ws + WS_WSC) + col), w1 = *(const f32x4*)((const float*)(ws + WS_WSC) + col + 4);
#pragma unroll
              for (int j = 0; j < 4; ++j) { wsc[j] = w0[j]; wsc[4 + j] = w1[j]; } }
#endif
            float lb[8];
            if (TYPE == 2) {
#pragma unroll
                for (int j = 0; j < 8; ++j) { const int fc = col - 1024 + j; lb[j] = 1.0f / (1.0f + __expf(lb_logits[512 + fc] - lb_logits[fc])); }
            }
#pragma unroll
            for (int ai = 0; ai < 2; ++ai)
#pragma unroll
                for (int m = 0; m < 4; ++m) {
                    const int row = row0 + ai * 128 + m * 16;
#if PROJ_INT8
                    f32x4 v0, v1;
#pragma unroll
                    for (int j = 0; j < 4; ++j) { v0[j] = (float)acc[ai][bj][m][0][j] * xsc[ai][m] * wsc[j]; v1[j] = (float)acc[ai][bj][m][1][j] * xsc[ai][m] * wsc[4 + j]; }
#else
                    f32x4 v0 = acc[ai][bj][m][0], v1 = acc[ai][bj][m][1];
#endif
                    if (TYPE == 0) {
                        const int g = col >> 4, h0 = col & 15, b = row >> 12, t = row & 4095, c = t >> 6, j = t & 63;
                        bf16* p = (bf16*)(ws + WS_U5) + ((size_t)(g * 1024 + b * 64 + c) * UK + j * 16 + h0);
                        *(v4u*)p = pack8(v0, v1);
                    } else if (TYPE == 1 || TYPE == 4) {
#pragma unroll
                        for (int j = 0; j < 4; ++j) { v0[j] = silu(v0[j]); v1[j] = silu(v1[j]); }
                        if (TYPE == 1) *(v4u*)((bf16*)(ws + WS_Q) + (size_t)row * 512 + (col - 512)) = pack8(v0, v1);
                        else           *(v4u*)((bf16*)(ws + WS_GS) + (size_t)row * 512 + (col - 2048)) = pack8(v0, v1);
                    } else if (TYPE == 2) {
#pragma unroll
                        for (int j = 0; j < 4; ++j) { v0[j] = __logf(lb[j] + (1.0f - lb[j]) * sigm(v0[j])); v1[j] = __logf(lb[4 + j] + (1.0f - lb[4 + j]) * sigm(v1[j])); }
                        float* p = (float*)(ws + WS_LF) + (size_t)row * 512 + (col - 1024);
                        *(f32x4*)p = v0; *(f32x4*)(p + 4) = v1;
                    } else if (TYPE == 3) {
                        *(v4u*)((bf16*)(ws + WS_VV) + (size_t)row * 512 + (col - 1536)) = pack8(v0, v1);
                    } else {
#pragma unroll
                        for (int j = 0; j < 4; ++j) { v0[j] = sigm(v0[j]); v1[j] = sigm(v1[j]); }
                        if (TYPE == 5) *(v4u*)((bf16*)(ws + WS_GA) + (size_t)row * 1024 + (col - 2560)) = pack8(v0, v1);
                        else           *(v4u*)((bf16*)(ws + WS_GB) + (size_t)row * 1024 + (col - 3584)) = pack8(v0, v1);
                    }
                }
        }
    }
    DEVI void operator()(const AccP& acc, const pg8::Unit& u, int wr, int wc, int fr, int fq) const {
        const int pn = u.pn;
        if (pn < 2) run<0>(acc, u, wr, wc, fr, fq);
        else if (pn < 4) run<1>(acc, u, wr, wc, fr, fq);
        else if (pn < 6) run<2>(acc, u, wr, wc, fr, fq);
        else if (pn < 8) run<3>(acc, u, wr, wc, fr, fq);
        else if (pn < 10) run<4>(acc, u, wr, wc, fr, fq);
        else if (pn < 14) run<5>(acc, u, wr, wc, fr, fq);
        else run<6>(acc, u, wr, wc, fr, fq);
    }
};

struct EpiGlu {
    static constexpr bool PERM = true, AFTER_DRAIN = false, CHAIN = false, PROBE_ME = false; typedef f32x4 acc_t;
    unsigned char* ws; const float* bias;
    DEVI void operator()(const AccT& acc, const pg8::Unit& u, int wr, int wc, int fr, int fq) const {
        const int row0 = u.pm * 256 + wr * 64 + fr;
#pragma unroll
        for (int bj = 0; bj < 2; ++bj) {
            const int col = u.pn * 256 + bj * 128 + wc * 32 + 8 * fq;
            const f32x4 b0 = *(const f32x4*)(bias + col), b1 = *(const f32x4*)(bias + col + 4);
            v4u yw[2][4];
#pragma unroll
            for (int ai = 0; ai < 2; ++ai)
#pragma unroll
                for (int m = 0; m < 4; ++m) yw[ai][m] = *(const v4u*)((const bf16*)(ws + WS_Y2) + (size_t)(row0 + ai * 128 + m * 16) * 512 + col);
            __builtin_amdgcn_sched_barrier(0);
#pragma unroll
            for (int ai = 0; ai < 2; ++ai)
#pragma unroll
                for (int m = 0; m < 4; ++m) {
                    const int row = row0 + ai * 128 + m * 16;
                    float y[8]; unpack8(yw[ai][m], y);
                    f32x4 v0 = acc[ai][bj][m][0] + b0, v1 = acc[ai][bj][m][1] + b1;
#pragma unroll
                    for (int j = 0; j < 4; ++j) { v0[j] = y[j] * sigm(v0[j]); v1[j] = y[4 + j] * sigm(v1[j]); }
                    *(v4u*)((bf16*)(ws + WS_YAB) + (size_t)row * 1024 + col) = pack8(v0, v1);
                }
            __builtin_amdgcn_sched_barrier(0);
        }
    }
};

struct EpiMerge {
    static constexpr bool PERM = true, AFTER_DRAIN = false, CHAIN = true, PROBE_ME = false; typedef f32x4 acc_t;
    unsigned char* ws;
    DEVI void operator()(AccT& acc, const pg8::Unit& u, int wr, int wc, int fr, int fq) const {
        const int row0 = u.pm * 256 + wr * 64 + fr;
#pragma unroll
        for (int bj = 0; bj < 2; ++bj) {
            const int col = u.pn * 256 + bj * 128 + wc * 32 + 8 * fq;
#pragma unroll
            for (int ai = 0; ai < 2; ++ai) {
                v4u bw[4], aw[4];
#pragma unroll
                for (int m = 0; m < 4; ++m) { const size_t off = (size_t)(row0 + ai * 128 + m * 16) * 1024 + col;
                    bw[m] = *(const v4u*)((const bf16*)(ws + WS_GB) + off);
                    if (u.z == 0) aw[m] = *(const v4u*)((const bf16*)(ws + WS_GA) + off); }
                __builtin_amdgcn_sched_barrier(0);
#pragma unroll
                for (int m = 0; m < 4; ++m) {
                    const size_t off = (size_t)(row0 + ai * 128 + m * 16) * 1024 + col;
                    float gb[8]; unpack8(bw[m], gb);
                    if (u.z == 0) {
                        float ga[8]; unpack8(aw[m], ga);
#pragma unroll
                        for (int j = 0; j < 4; ++j) { acc[ai][bj][m][0][j] *= ga[j] * __builtin_amdgcn_rcpf(gb[j]); acc[ai][bj][m][1][j] *= ga[4 + j] * __builtin_amdgcn_rcpf(gb[4 + j]); }
                    } else {
                        f32x4 v0 = acc[ai][bj][m][0], v1 = acc[ai][bj][m][1];
#pragma unroll
                        for (int j = 0; j < 4; ++j) { v0[j] *= gb[j]; v1[j] *= gb[4 + j]; }
                        *(v4u*)((bf16*)(ws + WS_MG) + off) = pack8(v0, v1);
                    }
                }
                __builtin_amdgcn_sched_barrier(0);
            }
        }
    }
};

struct EpiOut {
    static constexpr bool PERM = true, AFTER_DRAIN = false, CHAIN = false, PROBE_ME = false; typedef f32x4 acc_t;
    unsigned char* ws; const float* x;
    DEVI void operator()(const AccT& acc, const pg8::Unit& u, int wr, int wc, int fr, int fq) const {
        const int row0 = u.pm * 256 + wr * 64 + fr;
#pragma unroll
        for (int bj = 0; bj < 2; ++bj) {
            const int col = u.pn * 256 + bj * 128 + wc * 32 + 8 * fq;
#pragma unroll
            for (int ai = 0; ai < 2; ++ai) {
                f32x4 xr[4][2];
#pragma unroll
                for (int m = 0; m < 4; ++m) { const size_t off = (size_t)(row0 + ai * 128 + m * 16) * 1024 + col; xr[m][0] = *(const f32x4*)(x + off); xr[m][1] = *(const f32x4*)(x + off + 4); }
                __builtin_amdgcn_sched_barrier(0);
#pragma unroll
                for (int m = 0; m < 4; ++m) {
                    float* p = (float*)(ws + WS_H1) + (size_t)(row0 + ai * 128 + m * 16) * 1024 + col;
                    *(f32x4*)p = acc[ai][bj][m][0] + ALPHA * xr[m][0]; *(f32x4*)(p + 4) = acc[ai][bj][m][1] + ALPHA * xr[m][1];
                }
                __builtin_amdgcn_sched_barrier(0);
            }
        }
    }
};

struct EpiScores {
    static constexpr bool PERM = true, AFTER_DRAIN = false, CHAIN = false, PROBE_ME = false;
#if SCORES_INT8
    typedef i32x4 acc_t;
#else
    typedef f32x4 acc_t;
#endif
    typedef acc_t AccS[2][2][4][2];
    unsigned char* ws;
    DEVI void operator()(const AccS& acc, const pg8::Unit& u, int wr, int wc, int fr, int fq) const {
        const int row0 = u.pm * 256 + wr * 64 + fr;
#if SCORES_INT8
        float xsc[2][4];
#pragma unroll
        for (int ai = 0; ai < 2; ++ai)
#pragma unroll
            for (int m = 0; m < 4; ++m) xsc[ai][m] = ((const float*)(ws + WS_XS))[row0 + ai * 128 + m * 16];
#endif
#pragma unroll
        for (int bj = 0; bj < 2; ++bj) {
            const int col = u.pn * 256 + bj * 128 + wc * 32 + 8 * fq;
#if SCORES_INT8
            float wsc[8];
            { const f32x4 w0 = *(const f32x4*)((const float*)(ws + WS_WFS) + col), w1 = *(const f32x4*)((const float*)(ws + WS_WFS) + col + 4);
#pragma unroll
              for (int j = 0; j < 4; ++j) { wsc[j] = w0[j]; wsc[4 + j] = w1[j]; } }
#endif
#pragma unroll
            for (int ai = 0; ai < 2; ++ai)
#pragma unroll
                for (int m = 0; m < 4; ++m) {
                    const int row = row0 + ai * 128 + m * 16;
#if SCORES_INT8
                    f32x4 v0, v1;
#pragma unroll
                    for (int j = 0; j < 4; ++j) { v0[j] = (float)acc[ai][bj][m][0][j] * xsc[ai][m] * wsc[j]; v1[j] = (float)acc[ai][bj][m][1][j] * xsc[ai][m] * wsc[4 + j]; }
#else
                    const f32x4 v0 = acc[ai][bj][m][0], v1 = acc[ai][bj][m][1];
#endif
                    v4u w; w.x = pkh2(v0[0], v0[1]); w.y = pkh2(v0[2], v0[3]); w.z = pkh2(v1[0], v1[1]); w.w = pkh2(v1[2], v1[3]);
                    *(v4u*)((unsigned short*)(ws + WS_SC) + (size_t)row * 2048 + col) = w;
                }
        }
    }
};

struct EpiS5Z {
    static constexpr bool PERM = true, AFTER_DRAIN = false, CHAIN = false, PROBE_ME = false; typedef f32x4 acc_t;
    unsigned char* ws;
    DEVI void operator()(const AccT& acc, const pg8::Unit& u, int wr, int wc, int fr, int fq) const {
        const int row0 = u.pm * 256 + wr * 64 + fr, col = wc * 32 + 8 * fq;
        float* Z = (float*)(ws + WS_Z) + (size_t)u.z * 1024 * 128;
#pragma unroll
        for (int ai = 0; ai < 2; ++ai)
#pragma unroll
            for (int m = 0; m < 4; ++m) {
                const int row = row0 + ai * 128 + m * 16;
                float* p = Z + (size_t)row * 128 + col;
                *(f32x4*)p = acc[ai][0][m][0]; *(f32x4*)(p + 4) = acc[ai][0][m][1];
            }
    }
};
struct EpiS5Y {
    static constexpr bool PERM = true, AFTER_DRAIN = false, CHAIN = false, PROBE_ME = false; typedef f32x4 acc_t;
    unsigned char* ws;
    DEVI void operator()(const AccT& acc, const pg8::Unit& u, int wr, int wc, int fr, int fq) const {
        const int row0 = u.pm * 256 + wr * 64 + fr;
        bf16* Y2 = (bf16*)(ws + WS_Y2);
#pragma unroll
        for (int bj = 0; bj < 2; ++bj) {
            const int n = u.pn * 256 + bj * 128 + wc * 32 + 8 * fq, i = n >> 4, h0 = n & 15;
#pragma unroll
            for (int ai = 0; ai < 2; ++ai)
#pragma unroll
                for (int m = 0; m < 4; ++m) {
                    const int r = row0 + ai * 128 + m * 16, b = r >> 6, c = r & 63;
                    f32x4 v0 = acc[ai][bj][m][0], v1 = acc[ai][bj][m][1];
#pragma unroll
                    for (int j = 0; j < 4; ++j) { v0[j] = gelu_t(v0[j]); v1[j] = gelu_t(v1[j]); }
                    *(v4u*)(Y2 + ((size_t)b * 4096 + c * 64 + i) * 512 + u.z * 16 + h0) = pack8(v0, v1);
                }
        }
    }
};

#define LDS_WAIT() asm volatile("s_waitcnt lgkmcnt(0)" ::: "memory")

DEVI void transpose_item(const float* W, int K, int N, bf16* WT, LAS float* scr, int item, int lane, int ldo = 0, int koff = 0) {
    if (ldo == 0) ldo = K;
    const int nblk = N / 32, kb = item / nblk, nb = item % nblk, k0 = 64 * kb, n0 = 32 * nb;
#pragma unroll 8
    for (int i = 0; i < 32; ++i) { const int kk = 2 * i + (lane >> 5); scr[kk * 33 + (lane & 31)] = W[(size_t)(k0 + kk) * N + n0 + (lane & 31)]; }
    LDS_WAIT();
    const int c = lane & 7;
#pragma unroll
    for (int j = 0; j < 4; ++j) { const int n = (lane >> 3) + 8 * j; const LAS float* s = scr + (8 * c) * 33 + n;
        v4u o; o.x = pk2(s[0 * 33], s[1 * 33]); o.y = pk2(s[2 * 33], s[3 * 33]); o.z = pk2(s[4 * 33], s[5 * 33]); o.w = pk2(s[6 * 33], s[7 * 33]);
        *(v4u*)(WT + (size_t)(n0 + n) * ldo + koff + k0 + 8 * c) = o; }
    LDS_WAIT();
}

DEVI void cvt_bf16_stream(const float* src, bf16* dst, size_t n8, size_t gtid, size_t gthreads) {
    for (size_t i = gtid; i < n8; i += gthreads) {
        const f32x4 a = *(const f32x4*)(src + i * 8), b = *(const f32x4*)(src + i * 8 + 4);
        *(v4u*)(dst + i * 8) = pack8(a, b);
    }
}

DEVI float clamp_fp8(float x) { return fminf(fmaxf(x, -448.0f), 448.0f); }
DEVI unsigned pk4_fp8(float a, float b, float c, float d) { a = clamp_fp8(a); b = clamp_fp8(b); c = clamp_fp8(c); d = clamp_fp8(d); int w = 0; w = __builtin_amdgcn_cvt_pk_fp8_f32(a, b, w, false); w = __builtin_amdgcn_cvt_pk_fp8_f32(c, d, w, true); return (unsigned)w; }
DEVI void cvt_fp8_stream(const float* src, unsigned char* dst, size_t n16, float scale, size_t gtid, size_t gthreads) {
    for (size_t i = gtid; i < n16; i += gthreads) {
        const f32x4 a = *(const f32x4*)(src + i * 16) * scale, b = *(const f32x4*)(src + i * 16 + 4) * scale, c = *(const f32x4*)(src + i * 16 + 8) * scale, d = *(const f32x4*)(src + i * 16 + 12) * scale;
        v4u o; o.x = pk4_fp8(a[0], a[1], a[2], a[3]); o.y = pk4_fp8(b[0], b[1], b[2], b[3]); o.z = pk4_fp8(c[0], c[1], c[2], c[3]); o.w = pk4_fp8(d[0], d[1], d[2], d[3]);
        *(v4u*)(dst + i * 16) = o;
    }
}

DEVI void cvt_fp8_sliced(const float* src, unsigned char* dst, float scale, size_t gtid, size_t gthreads) {
    for (size_t i = gtid; i < (size_t)PNE * D / 16; i += gthreads) {
        const size_t e = i >> 6; const int cg = (int)(i & 63), j = cg >> 3, within = (cg & 7) * 16;
        const f32x4 a = *(const f32x4*)(src + i * 16) * scale, b = *(const f32x4*)(src + i * 16 + 4) * scale, c = *(const f32x4*)(src + i * 16 + 8) * scale, d = *(const f32x4*)(src + i * 16 + 12) * scale;
        v4u o; o.x = pk4_fp8(a[0], a[1], a[2], a[3]); o.y = pk4_fp8(b[0], b[1], b[2], b[3]); o.z = pk4_fp8(c[0], c[1], c[2], c[3]); o.w = pk4_fp8(d[0], d[1], d[2], d[3]);
        *(v4u*)(dst + ((size_t)j * PNE + e) * 128 + within) = o;
    }
}

DEVI unsigned q4_i8(float a, float b, float c, float d) {
    const int ia = (int)rintf(a), ib = (int)rintf(b), ic = (int)rintf(c), id = (int)rintf(d);
    return (unsigned)(ia & 255) | ((unsigned)(ib & 255) << 8) | ((unsigned)(ic & 255) << 16) | ((unsigned)(id & 255) << 24);
}
DEVI void cvt_i8_rows(const float* src, unsigned char* dst, float* scales, int gw, int ngw, int lane) {
    for (int e0 = gw; e0 < PNE; e0 += 4 * ngw) {
        f32x4 v[4][4];
#pragma unroll
        for (int r = 0; r < 4; ++r) { const int er = (e0 + r * ngw < PNE) ? e0 + r * ngw : e0; const float* rp = src + (size_t)er * 1024 + lane * 16;
#pragma unroll
            for (int q = 0; q < 4; ++q) v[r][q] = *(const f32x4*)(rp + 4 * q); }
#pragma unroll
        for (int r = 0; r < 4; ++r) {
            const int e = e0 + r * ngw; if (e >= PNE) continue; float m = 0.f;
#pragma unroll
            for (int q = 0; q < 4; ++q) m = fmaxf(m, fmaxf(fmaxf(fabsf(v[r][q][0]), fabsf(v[r][q][1])), fmaxf(fabsf(v[r][q][2]), fabsf(v[r][q][3]))));
            m = wave_max(m); m = fmaxf(m, 1e-30f);
            const float inv = 127.0f / m;
            v4u o;
#pragma unroll
            for (int q = 0; q < 4; ++q) o[q] = q4_i8(v[r][q][0] * inv, v[r][q][1] * inv, v[r][q][2] * inv, v[r][q][3] * inv);
            *(v4u*)(dst + ((size_t)(lane >> 3) * PNE + e) * 128 + (lane & 7) * 16) = o;
            if (lane == 0) scales[e] = m * (1.0f / 127.0f);
        }
    }
}

DEVI void cvt_x_i8_rows(const float* src, unsigned char* dst, float* scales, int gw, int ngw, int lane) {
    for (int r0 = gw; r0 < T; r0 += 4 * ngw) {
        f32x4 v[4][4];
#pragma unroll
        for (int r = 0; r < 4; ++r) { const int rr = (r0 + r * ngw < T) ? r0 + r * ngw : r0; const float* rp = src + (size_t)rr * 1024 + lane * 16;
#pragma unroll
            for (int q = 0; q < 4; ++q) v[r][q] = *(const f32x4*)(rp + 4 * q); }
#pragma unroll
        for (int r = 0; r < 4; ++r) {
            const int row = r0 + r * ngw; if (row >= T) continue; float m = 0.f;
#pragma unroll
            for (int q = 0; q < 4; ++q) m = fmaxf(m, fmaxf(fmaxf(fabsf(v[r][q][0]), fabsf(v[r][q][1])), fmaxf(fabsf(v[r][q][2]), fabsf(v[r][q][3]))));
            m = fmaxf(wave_max(m), 1e-30f);
            const float inv = 127.0f / m;
            v4u o;
#pragma unroll
            for (int q = 0; q < 4; ++q) o[q] = q4_i8(v[r][q][0] * inv, v[r][q][1] * inv, v[r][q][2] * inv, v[r][q][3] * inv);
            *(v4u*)(dst + (size_t)row * 1024 + lane * 16) = o;
            if (lane == 0) scales[row] = m * (1.0f / 127.0f);
        }
    }
}
DEVI void win_i8_stripe(const float* W, unsigned char* WT8, float* wsc, LAS unsigned char* lds, int stripe, int wave, int lane) {
    LAS float* scr = (LAS float*)(lds + wave * 16384);
    LAS float* pm = (LAS float*)(lds + 131072);
    const int n0 = stripe * 32, c = lane & 31, hk = lane >> 5, kw = wave * 128;
    float m = 0.f;
#pragma unroll 8
    for (int k = hk; k < 128; k += 2) m = fmaxf(m, fabsf(W[(size_t)(kw + k) * INC + n0 + c]));
    m = fmaxf(m, __shfl_xor(m, 32));
    __syncthreads();
    if (lane < 32) pm[wave * 32 + c] = m;
    __syncthreads();
#pragma unroll
    for (int w = 0; w < 8; ++w) m = fmaxf(m, pm[w * 32 + c]);
    m = fmaxf(m, 1e-30f);
    const float inv = 127.0f / m;
    if (wave == 0 && lane < 32) wsc[n0 + c] = m * (1.0f / 127.0f);
    for (int kb = 0; kb < 2; ++kb) {
        const int k0 = kw + kb * 64;
#pragma unroll 8
        for (int i = 0; i < 32; ++i) { const int kk = 2 * i + hk; scr[kk * 33 + c] = W[(size_t)(k0 + kk) * INC + n0 + c] * inv; }
        LDS_WAIT();
        const int ch = lane & 3;
#pragma unroll
        for (int j = 0; j < 2; ++j) { const int n = (lane >> 2) + 16 * j; const LAS float* s = scr + (16 * ch) * 33 + n;
            v4u o;
#pragma unroll
            for (int q = 0; q < 4; ++q) o[q] = q4_i8(s[(4 * q) * 33], s[(4 * q + 1) * 33], s[(4 * q + 2) * 33], s[(4 * q + 3) * 33]);
            *(v4u*)(WT8 + (size_t)(n0 + n) * 1024 + k0 + 16 * ch) = o; }
        LDS_WAIT();
    }
}

DEVI void phase_prep(const Args& a, LAS unsigned char* lds) {
    const int tid = threadIdx.x, lane = tid & 63, wave = __builtin_amdgcn_readfirstlane(tid >> 6), G = gridDim.x;
    unsigned char* ws = a.ws;
    const size_t gtid = (size_t)blockIdx.x * 512 + tid, gthreads = (size_t)G * 512;
#if PROJ_INT8
    cvt_x_i8_rows(a.in[0], ws + WS_XB, (float*)(ws + WS_XSC), blockIdx.x * 8 + wave, G * 8, lane);
#else
    cvt_bf16_stream(a.in[0], (bf16*)(ws + WS_XB), (size_t)T * D / 8, gtid, gthreads);
#endif
#if PEER_FP8
#if PEER_U_INT8
    cvt_i8_rows(a.in[21], ws + WS_PU, (float*)(ws + WS_US), blockIdx.x * 8 + wave, G * 8, lane);
#else
    cvt_fp8_sliced(a.in[21], ws + WS_PU, PU_SCALE, gtid, gthreads);
#endif
    cvt_fp8_sliced(a.in[22], ws + WS_PV, PV_SCALE, gtid, gthreads);
#else
    cvt_bf16_stream(a.in[21], (bf16*)(ws + WS_PU), (size_t)PNE * D / 8, gtid, gthreads);
    cvt_bf16_stream(a.in[22], (bf16*)(ws + WS_PV), (size_t)PNE * D / 8, gtid, gthreads);
#endif
    {
        LAS float* scr = (LAS float*)(lds + wave * 16384);
        const int gw = blockIdx.x * 8 + wave, NGW = G * 8;
        constexpr int I_IN = (1024 / 64) * (INC / 32), I_GLU = (512 / 64) * (512 / 32), I_PA = (512 / 64) * (1024 / 32), I_O = (1024 / 64) * (1024 / 32);
        constexpr int NIT = I_IN + I_GLU + 2 * I_PA + I_O;
        for (int it = gw; it < NIT; it += NGW) {
            int r = it;
#if PROJ_INT8
            if (r < I_IN) continue; r -= I_IN;
#else
            if (r < I_IN) { transpose_item(a.in[1], 1024, INC, (bf16*)(ws + WS_WINT), scr, r, lane); continue; } r -= I_IN;
#endif
            if (r < I_GLU) { transpose_item(a.in[10], 512, 512, (bf16*)(ws + WS_WGLUT), scr, r, lane); continue; } r -= I_GLU;
            if (r < I_PA) { transpose_item(a.in[14], 512, 1024, (bf16*)(ws + WS_WPAT), scr, r, lane, 1024, 0); continue; } r -= I_PA;
            if (r < I_PA) { transpose_item(a.in[15], 512, 1024, (bf16*)(ws + WS_WPAT), scr, r, lane, 1024, 512); continue; } r -= I_PA;
            transpose_item(a.in[16], 1024, 1024, (bf16*)(ws + WS_WOT), scr, r, lane);
        }
    }
#if PROJ_INT8
    for (int st = blockIdx.x; st < INC / 32; st += G) win_i8_stripe(a.in[1], ws + WS_WINT, (float*)(ws + WS_WSC), lds, st, wave, lane);
#endif
    __syncthreads();
#if SCORES_INT8
    {
        LAS float* wq = (LAS float*)lds;
        LAS float* ky = wq + 32 * 132;
        LAS float* ob = ky + 16 * 132;
        const float* wpq = a.in[19]; const float* keys = a.in[20];
        const int n = tid & 15, kk = tid >> 4;
        for (int item = blockIdx.x; item < 16 * 8; item += G) {
            const int slot = item >> 3, nq = item & 7;
            __syncthreads();
            { const int nn = tid >> 5, d4 = (tid & 31) * 4; *(LAS f32x4*)(ky + nn * 132 + d4) = *(const f32x4*)(keys + ((size_t)(slot * 128 + nq * 16 + nn)) * 128 + d4); }
            for (int kt = 0; kt < 32; ++kt) {
                __syncthreads();
#pragma unroll
                for (int i = 0; i < 2; ++i) { const int idx = tid + 512 * i, k2 = idx >> 5, d4 = (idx & 31) * 4;
                    *(LAS f32x4*)(wq + k2 * 132 + d4) = *(const f32x4*)(wpq + (size_t)(kt * 32 + k2) * 2048 + slot * 128 + d4); }
                __syncthreads();
                float acc = 0.f;
#pragma unroll 8
                for (int d = 0; d < 128; d += 4) { const f32x4 kv = *(const LAS f32x4*)(ky + n * 132 + d), w = *(const LAS f32x4*)(wq + kk * 132 + d); acc += kv[0] * w[0] + kv[1] * w[1] + kv[2] * w[2] + kv[3] * w[3]; }
                ob[n * 1028 + kt * 32 + kk] = acc;
            }
            __syncthreads();
#pragma unroll
            for (int r = 0; r < 2; ++r) {
                const int nn = wave * 2 + r;
                f32x4 v[4]; float m = 0.f;
#pragma unroll
                for (int q = 0; q < 4; ++q) { v[q] = *(const LAS f32x4*)(ob + nn * 1028 + lane * 16 + 4 * q); m = fmaxf(m, fmaxf(fmaxf(fabsf(v[q][0]), fabsf(v[q][1])), fmaxf(fabsf(v[q][2]), fabsf(v[q][3])))); }
                m = fmaxf(wave_max(m), 1e-30f);
                const float inv = 127.0f / m;
                v4u o;
#pragma unroll
                for (int q = 0; q < 4; ++q) o[q] = q4_i8(v[q][0] * inv, v[q][1] * inv, v[q][2] * inv, v[q][3] * inv);
                const int nrow = slot * 128 + nq * 16 + nn;
                *(v4u*)(ws + WS_WFT + (size_t)nrow * 1024 + lane * 16) = o;
                if (lane == 0) ((float*)(ws + WS_WFS))[nrow] = m * (1.0f / 127.0f);
            }
        }
    }
#else
    {
        LAS float* wq = (LAS float*)lds;
        LAS float* ky = wq + 32 * 132;
        const float* wpq = a.in[19]; const float* keys = a.in[20];
        const int n = tid & 127, kh = __builtin_amdgcn_readfirstlane(tid >> 7);
        for (int item = blockIdx.x; item < 16 * 32; item += G) {
            const int slot = item >> 5, kt = item & 31;
            __syncthreads();
#pragma unroll
            for (int i = 0; i < 2; ++i) { const int idx = tid + 512 * i, kk = idx >> 5, d4 = (idx & 31) * 4;
                *(LAS f32x4*)(wq + kk * 132 + d4) = *(const f32x4*)(wpq + (size_t)(kt * 32 + kk) * 2048 + slot * 128 + d4); }
#pragma unroll
            for (int i = 0; i < 8; ++i) { const int idx = tid + 512 * i, nn = idx >> 5, d4 = (idx & 31) * 4;
                *(LAS f32x4*)(ky + nn * 132 + d4) = *(const f32x4*)(keys + ((size_t)(slot * 128 + nn)) * 128 + d4); }
            __syncthreads();
            float acc[8];
#pragma unroll
            for (int kk = 0; kk < 8; ++kk) acc[kk] = 0.f;
#pragma unroll 4
            for (int d = 0; d < 128; d += 4) {
                const f32x4 kv = *(const LAS f32x4*)(ky + n * 132 + d);
#pragma unroll
                for (int kk = 0; kk < 8; ++kk) { const f32x4 w = *(const LAS f32x4*)(wq + (kh * 8 + kk) * 132 + d); acc[kk] += kv[0] * w[0] + kv[1] * w[1] + kv[2] * w[2] + kv[3] * w[3]; }
            }
            v4u o; o.x = pk2(acc[0], acc[1]); o.y = pk2(acc[2], acc[3]); o.z = pk2(acc[4], acc[5]); o.w = pk2(acc[6], acc[7]);
            *(v4u*)((bf16*)(ws + WS_WFT) + (size_t)(slot * 128 + n) * 1024 + kt * 32 + kh * 8) = o;
        }
    }
#endif
}

DEVI void s5_tables_item(const Args& a, LAS unsigned char* lds, int item) {
    const int tid = threadIdx.x, g = item >> 3, part = item & 7;
    unsigned char* ws = a.ws;
    LAS float* pwr = (LAS float*)lds;
    LAS float* pwi = pwr + 65 * 64;
    LAS float* Bbr = pwi + 65 * 64;
    LAS float* Bbi = Bbr + 1024;
    LAS float* Cr = Bbi + 1024;
    LAS float* Ci = Cr + 1040;
    LAS float* Kt = Ci + 1040;
    __syncthreads();
    if (tid < 64) {
        const int p = tid;
        const float dt = __expf(a.in[9][g]);
        const float lr = a.in[2][g * 64 + p], li = a.in[3][g * 64 + p];
        const float er = __expf(lr * dt); float sn, cs; sincosf(li * dt, &sn, &cs);
        const float Lr = er * cs, Li = er * sn;
        const float ar = Lr - 1.0f, ai = Li, den = lr * lr + li * li;
        const float cr = (ar * lr + ai * li) / den, ci = (ai * lr - ar * li) / den;
#pragma unroll
        for (int h = 0; h < 16; ++h) { const float br = a.in[4][(g * 64 + p) * 16 + h], bi = a.in[5][(g * 64 + p) * 16 + h];
            Bbr[p * 16 + h] = cr * br - ci * bi; Bbi[p * 16 + h] = cr * bi + ci * br; }
        float xr = 1.0f, xi = 0.0f;
        for (int d = 0; d <= 64; ++d) { pwr[d * 64 + p] = xr; pwi[d * 64 + p] = xi; const float nr = xr * Lr - xi * Li, ni = xr * Li + xi * Lr; xr = nr; xi = ni; }
        if (part == 0) { float* l64 = (float*)(ws + WS_L64) + (g * 64 + p) * 2; l64[0] = pwr[64 * 64 + p]; l64[1] = pwi[64 * 64 + p]; }
    }
    for (int i = tid; i < 1024; i += 512) { Cr[(i >> 6) * 65 + (i & 63)] = a.in[6][g * 1024 + i]; Ci[(i >> 6) * 65 + (i & 63)] = a.in[7][g * 1024 + i]; }
    __syncthreads();
    for (int pr = tid; pr < 1024; pr += 512) {
        const int d = pr >> 4, hp = pr & 15;
        float acc[16];
#pragma unroll
        for (int h = 0; h < 16; ++h) acc[h] = 0.f;
        for (int p = 0; p < 64; ++p) {
            const float c_r = Cr[hp * 65 + p], c_i = Ci[hp * 65 + p], w_r = pwr[d * 64 + p], w_i = pwi[d * 64 + p];
            const float cpr = c_r * w_r - c_i * w_i, cpi = c_r * w_i + c_i * w_r;
#pragma unroll
            for (int h = 0; h < 16; ++h) acc[h] += cpr * Bbr[p * 16 + h] - cpi * Bbi[p * 16 + h];
        }
#pragma unroll
        for (int h = 0; h < 16; ++h) Kt[pr * 16 + h] = acc[h];
    }
    __syncthreads();
    bf16* TY = (bf16*)(ws + WS_TY) + (size_t)g * 1024 * UK;
    for (int e = tid; e < 128 * 128; e += 512) {
        const int n = part * 128 + (e >> 7), k0 = (e & 127) * 8, i = n >> 4, hp = n & 15, j = k0 >> 4, h0 = k0 & 15;
        float v[8];
#pragma unroll
        for (int q = 0; q < 8; ++q) v[q] = 0.f;
        if (j <= i) {
            const LAS float* kp = Kt + ((i - j) * 16 + hp) * 16 + h0;
#pragma unroll
            for (int q = 0; q < 8; ++q) v[q] = kp[q];
            if (j == i && hp >= h0 && hp < h0 + 8) v[hp - h0] += a.in[8][g * 16 + hp];
        }
        v4u o; o.x = pk2(v[0], v[1]); o.y = pk2(v[2], v[3]); o.z = pk2(v[4], v[5]); o.w = pk2(v[6], v[7]);
        *(v4u*)(TY + (size_t)n * UK + k0) = o;
    }
    for (int e = tid; e < 128 * 64; e += 512) {
        const int n = part * 128 + (e >> 6), p = e & 63, i = n >> 4, hp = n & 15;
        const float c_r = Cr[hp * 65 + p], c_i = Ci[hp * 65 + p], w_r = pwr[(i + 1) * 64 + p], w_i = pwi[(i + 1) * 64 + p];
        TY[(size_t)n * UK + 1024 + p] = (bf16)f2bf(c_r * w_r - c_i * w_i);
        TY[(size_t)n * UK + 1088 + p] = (bf16)f2bf(-(c_r * w_i + c_i * w_r));
    }
    bf16* WZ = (bf16*)(ws + WS_WZ) + (size_t)g * 256 * 1024;
    for (int e = tid; e < 32 * 128; e += 512) {
        const int n = part * 32 + (e >> 7), k0 = (e & 127) * 8, j = k0 >> 4, h0 = k0 & 15;
        float v[8];
#pragma unroll
        for (int q = 0; q < 8; ++q) v[q] = 0.f;
        if (n < 128) {
            const int p = n & 63; const float w_r = pwr[(63 - j) * 64 + p], w_i = pwi[(63 - j) * 64 + p];
#pragma unroll
            for (int q = 0; q < 8; ++q) { const float b_r = Bbr[p * 16 + h0 + q], b_i = Bbi[p * 16 + h0 + q]; v[q] = (n < 64) ? (w_r * b_r - w_i * b_i) : (w_r * b_i + w_i * b_r); }
        }
        v4u o; o.x = pk2(v[0], v[1]); o.y = pk2(v[2], v[3]); o.z = pk2(v[4], v[5]); o.w = pk2(v[6], v[7]);
        *(v4u*)(WZ + (size_t)n * 1024 + k0) = o;
    }
}

DEVI void s5_scan(const Args& a) {
    unsigned char* ws = a.ws;
    for (int id = blockIdx.x * 512 + threadIdx.x; id < S5G * BATCH * 64; id += gridDim.x * 512) {
        const int p = id & 63, b = (id >> 6) & 15, g = id >> 10;
        const float* l64 = (const float*)(ws + WS_L64) + (g * 64 + p) * 2; const float Lr = l64[0], Li = l64[1];
        const float* zp = (const float*)(ws + WS_Z) + (size_t)(g * 1024 + b * 64) * 128 + p;
        bf16* up = (bf16*)(ws + WS_U5) + (size_t)(g * 1024 + b * 64) * UK + 1024 + p;
        float xr = 0.f, xi = 0.f;
#pragma unroll 8
        for (int c = 0; c < 64; ++c) {
            const float zr = zp[(size_t)c * 128], zi = zp[(size_t)c * 128 + 64];
            up[(size_t)c * UK] = (bf16)f2bf(xr); up[(size_t)c * UK + 64] = (bf16)f2bf(xi);
            const float nr = Lr * xr - Li * xi + zr, ni = Lr * xi + Li * xr + zi; xr = nr; xi = ni;
        }
    }
}

constexpr int HG_QT = 0, HG_KT = 17408, HG_KHT = 34816, HG_VT = 53248, HG_SBT = 71680, HG_P = 106496, HG_EB = 115712, HG_TOT = 116224;
DEVI int crow(int j, int hh) { return (j & 3) + 8 * (j >> 2) + 4 * hh; }
DEVI bf16x8 ldfrag(const LAS unsigned char* base, int row, int pitch, int col) { return *(const LAS bf16x8*)(base + (row * pitch + col) * 2); }

template <bool FULL> DEVI void hgrn_segment(const Args& a, LAS unsigned char* lds, int item) {
    const int tid = threadIdx.x, lane = tid & 63, wave = __builtin_amdgcn_readfirstlane(tid >> 6);
    const int seg = item & 3, h = (item >> 2) & 3, b = item >> 4;
    unsigned char* ws = a.ws;
    const int kcol = tid & 127, qd = tid >> 7, r32 = lane & 31, hh = lane >> 5;
    const int ti = wave >> 2, vi = wave & 3, ski = wave & 3, sv0 = (wave >> 2) * 2;
    const float* LF = (const float*)(ws + WS_LF); const bf16* Q = (const bf16*)(ws + WS_Q); const bf16* VV = (const bf16*)(ws + WS_VV); const bf16* GS = (const bf16*)(ws + WS_GS);
    bf16* YB = (bf16*)(ws + WS_YAB) + 512;
    float* HGS = (float*)(ws + WS_HGS); float* HGD = (float*)(ws + WS_HGD);
    LAS unsigned char* QT = lds + HG_QT; LAS unsigned char* KT = lds + HG_KT; LAS unsigned char* KHT = lds + HG_KHT; LAS unsigned char* VT = lds + HG_VT;
    LAS unsigned char* SBT = lds + HG_SBT; LAS unsigned char* PB = lds + HG_P;
    LAS float* EB = (LAS float*)(lds + HG_EB); LAS float* TOT = (LAS float*)(lds + HG_TOT); LAS float* O = (LAS float*)(lds + HG_QT);
    f32x16 S0, S1;
#pragma unroll
    for (int j = 0; j < 16; ++j) { S0[j] = 0.f; S1[j] = 0.f; }
    float sumlog = 0.f;
    __syncthreads();
    if (FULL) {
        for (int s2 = 0; s2 < seg; ++s2) {
            const int it2 = (b * 4 + h) * 4 + s2;
            const float* dS = HGS + (size_t)it2 * 16384; const float* Dl = HGD + it2 * 128;
#pragma unroll
            for (int j = 0; j < 16; ++j) { const int k = ski * 32 + crow(j, hh); const float d = Dl[k];
                S0[j] = d * S0[j] + dS[k * 128 + sv0 * 32 + r32]; S1[j] = d * S1[j] + dS[k * 128 + (sv0 + 1) * 32 + r32]; }
        }
#pragma unroll
        for (int g4 = 0; g4 < 4; ++g4) { const int k0 = ski * 32 + 8 * g4 + 4 * hh;
            v2u w0, w1; w0.x = pk2(S0[4 * g4], S0[4 * g4 + 1]); w0.y = pk2(S0[4 * g4 + 2], S0[4 * g4 + 3]); w1.x = pk2(S1[4 * g4], S1[4 * g4 + 1]); w1.y = pk2(S1[4 * g4 + 2], S1[4 * g4 + 3]);
            *(LAS v2u*)(SBT + ((sv0 * 32 + r32) * 136 + k0) * 2) = w0; *(LAS v2u*)(SBT + (((sv0 + 1) * 32 + r32) * 136 + k0) * 2) = w1; }
    }
    for (int cc = 0; cc < 16; ++cc) {
        const size_t row0 = (size_t)b * 4096 + (seg * 16 + cc) * 64;
        __syncthreads();
        float l[16], qv[16];
        {
            const size_t g0 = (row0 + qd * 16) * 512 + h * 128 + kcol;
            bf16 vraw[16];
#pragma unroll
            for (int i = 0; i < 16; ++i) { l[i] = LF[g0 + (size_t)i * 512]; vraw[i] = VV[g0 + (size_t)i * 512]; if (FULL) qv[i] = bf2f(Q[g0 + (size_t)i * 512]); }
            v4u w0, w1;
            w0.x = vraw[0] | ((unsigned)vraw[1] << 16); w0.y = vraw[2] | ((unsigned)vraw[3] << 16); w0.z = vraw[4] | ((unsigned)vraw[5] << 16); w0.w = vraw[6] | ((unsigned)vraw[7] << 16);
            w1.x = vraw[8] | ((unsigned)vraw[9] << 16); w1.y = vraw[10] | ((unsigned)vraw[11] << 16); w1.z = vraw[12] | ((unsigned)vraw[13] << 16); w1.w = vraw[14] | ((unsigned)vraw[15] << 16);
            *(LAS v4u*)(VT + (kcol * 72 + qd * 16) * 2) = w0; *(LAS v4u*)(VT + (kcol * 72 + qd * 16 + 8) * 2) = w1;
        }
        float pre[16]; { float run = 0.f;
#pragma unroll
            for (int i = 0; i < 16; ++i) { run += l[i]; pre[i] = run; }
            TOT[qd * 128 + kcol] = run; }
        __syncthreads();
        float off = 0.f, blast = 0.f;
#pragma unroll
        for (int q2 = 0; q2 < 4; ++q2) { const float tv = TOT[q2 * 128 + kcol]; blast += tv; off += (q2 < qd) ? tv : 0.f; }
        if (qd == 0) { EB[kcol] = __expf(blast); sumlog += blast; }
        {
            float kh[16];
#pragma unroll
            for (int i = 0; i < 16; ++i) {
                const float bc = off + pre[i], omf = 1.0f - __expf(l[i]);
                kh[i] = omf * __expf(blast - bc);
                if (FULL) { const int s = qd * 16 + i;
                    *(LAS bf16*)(QT + (s * 136 + kcol) * 2) = (bf16)f2bf(qv[i] * __expf(bc));
                    *(LAS bf16*)(KT + (s * 136 + kcol) * 2) = (bf16)f2bf(omf * __expf(-bc)); }
            }
            v4u w0, w1; w0.x = pk2(kh[0], kh[1]); w0.y = pk2(kh[2], kh[3]); w0.z = pk2(kh[4], kh[5]); w0.w = pk2(kh[6], kh[7]);
            w1.x = pk2(kh[8], kh[9]); w1.y = pk2(kh[10], kh[11]); w1.z = pk2(kh[12], kh[13]); w1.w = pk2(kh[14], kh[15]);
            *(LAS v4u*)(KHT + (kcol * 72 + qd * 16) * 2) = w0; *(LAS v4u*)(KHT + (kcol * 72 + qd * 16 + 8) * 2) = w1;
        }
        __syncthreads();
        f32x16 o;
#pragma unroll
        for (int j = 0; j < 16; ++j) o[j] = 0.f;
        if (FULL) {
            if (wave < 3) {
                const int sti = wave ? 1 : 0, ssi = wave == 2 ? 1 : 0;
                f32x16 sc;
#pragma unroll
                for (int j = 0; j < 16; ++j) sc[j] = 0.f;
#pragma unroll
                for (int ks = 0; ks < 8; ++ks) sc = __builtin_amdgcn_mfma_f32_32x32x16_bf16(ldfrag(QT, sti * 32 + r32, 136, ks * 16 + 8 * hh), ldfrag(KT, ssi * 32 + r32, 136, ks * 16 + 8 * hh), sc, 0, 0, 0);
                const int s = ssi * 32 + r32;
#pragma unroll
                for (int j = 0; j < 16; ++j) { const int t = sti * 32 + crow(j, hh); *(LAS bf16*)(PB + (t * 72 + s) * 2) = (bf16)f2bf(s <= t ? sc[j] : 0.f); }
            }
#pragma unroll
            for (int ks = 0; ks < 8; ++ks) o = __builtin_amdgcn_mfma_f32_32x32x16_bf16(ldfrag(QT, ti * 32 + r32, 136, ks * 16 + 8 * hh), ldfrag(SBT, vi * 32 + r32, 136, ks * 16 + 8 * hh), o, 0, 0, 0);
        }
        {
#pragma unroll
            for (int g4 = 0; g4 < 4; ++g4) { const f32x4 e = *(const LAS f32x4*)(EB + ski * 32 + 8 * g4 + 4 * hh);
#pragma unroll
                for (int q = 0; q < 4; ++q) { S0[4 * g4 + q] *= e[q]; S1[4 * g4 + q] *= e[q]; } }
#pragma unroll
            for (int ks = 0; ks < 4; ++ks) { const bf16x8 af = ldfrag(KHT, ski * 32 + r32, 72, ks * 16 + 8 * hh);
                S0 = __builtin_amdgcn_mfma_f32_32x32x16_bf16(af, ldfrag(VT, sv0 * 32 + r32, 72, ks * 16 + 8 * hh), S0, 0, 0, 0);
                S1 = __builtin_amdgcn_mfma_f32_32x32x16_bf16(af, ldfrag(VT, (sv0 + 1) * 32 + r32, 72, ks * 16 + 8 * hh), S1, 0, 0, 0); }
        }
        if (FULL) {
            __syncthreads();
            if (ti) {
#pragma unroll
                for (int ks = 0; ks < 4; ++ks) o = __builtin_amdgcn_mfma_f32_32x32x16_bf16(ldfrag(PB, ti * 32 + r32, 72, ks * 16 + 8 * hh), ldfrag(VT, vi * 32 + r32, 72, ks * 16 + 8 * hh), o, 0, 0, 0);
            } else {
#pragma unroll
                for (int ks = 0; ks < 2; ++ks) o = __builtin_amdgcn_mfma_f32_32x32x16_bf16(ldfrag(PB, r32, 72, ks * 16 + 8 * hh), ldfrag(VT, vi * 32 + r32, 72, ks * 16 + 8 * hh), o, 0, 0, 0);
            }
#pragma unroll
            for (int g4 = 0; g4 < 4; ++g4) { const int k0 = ski * 32 + 8 * g4 + 4 * hh;
                v2u w0, w1; w0.x = pk2(S0[4 * g4], S0[4 * g4 + 1]); w0.y = pk2(S0[4 * g4 + 2], S0[4 * g4 + 3]); w1.x = pk2(S1[4 * g4], S1[4 * g4 + 1]); w1.y = pk2(S1[4 * g4 + 2], S1[4 * g4 + 3]);
                *(LAS v2u*)(SBT + ((sv0 * 32 + r32) * 136 + k0) * 2) = w0; *(LAS v2u*)(SBT + (((sv0 + 1) * 32 + r32) * 136 + k0) * 2) = w1; }
#pragma unroll
            for (int j = 0; j < 16; ++j) O[(ti * 32 + crow(j, hh)) * 132 + vi * 32 + r32] = o[j];
            __syncthreads();
            {
                const int t = tid >> 3, sg = (tid & 7) * 16;
                float ov[16], ss = 0.f;
#pragma unroll
                for (int i = 0; i < 16; i += 4) { const f32x4 x = *(const LAS f32x4*)(O + t * 132 + sg + i); ov[i] = x[0]; ov[i + 1] = x[1]; ov[i + 2] = x[2]; ov[i + 3] = x[3]; }
#pragma unroll
                for (int i = 0; i < 16; ++i) ss += ov[i] * ov[i];
                ss += __shfl_xor(ss, 1); ss += __shfl_xor(ss, 2); ss += __shfl_xor(ss, 4);
                const float r = rsqrtf(ss * (1.0f / 128.0f) + RMS_EPS);
                const size_t go = (row0 + t) * 512 + h * 128 + sg, yo = (row0 + t) * 1024 + h * 128 + sg;
                const v4u g0 = *(const v4u*)(GS + go), g1 = *(const v4u*)(GS + go + 8);
                float gs0[8], gs1[8]; unpack8(g0, gs0); unpack8(g1, gs1);
                const float* gw = a.in[13] + h * 128 + sg;
#pragma unroll
                for (int i = 0; i < 8; ++i) { ov[i] = ov[i] * r * gw[i] * gs0[i]; ov[8 + i] = ov[8 + i] * r * gw[8 + i] * gs1[i]; }
                v4u w0, w1; w0.x = pk2(ov[0], ov[1]); w0.y = pk2(ov[2], ov[3]); w0.z = pk2(ov[4], ov[5]); w0.w = pk2(ov[6], ov[7]);
                w1.x = pk2(ov[8], ov[9]); w1.y = pk2(ov[10], ov[11]); w1.z = pk2(ov[12], ov[13]); w1.w = pk2(ov[14], ov[15]);
                *(v4u*)(YB + yo) = w0; *(v4u*)(YB + yo + 8) = w1;
            }
        }
    }
    if (!FULL) {
        float* dS = HGS + (size_t)item * 16384;
#pragma unroll
        for (int j = 0; j < 16; ++j) { const int k = ski * 32 + crow(j, hh); dS[k * 128 + sv0 * 32 + r32] = S0[j]; dS[k * 128 + (sv0 + 1) * 32 + r32] = S1[j]; }
        if (qd == 0) HGD[item * 128 + kcol] = __expf(sumlog);
    }
}

template <int NT> DEVI void ln1_rows(const Args& a, int r0, int rstride, int lane) {
    f32x4 v[NT][4];
#pragma unroll
    for (int q = 0; q < NT; ++q) { const int rq = (r0 + q * rstride < T) ? r0 + q * rstride : r0; const float* hr = (const float*)(a.ws + WS_H1) + (size_t)rq * 1024 + lane * 4;
#pragma unroll
        for (int j = 0; j < 4; ++j) v[q][j] = *(const f32x4*)(hr + 256 * j); }
    f32x4 gg[4], bb[4];
#pragma unroll
    for (int j = 0; j < 4; ++j) { gg[j] = *(const f32x4*)(a.in[17] + lane * 4 + 256 * j); bb[j] = *(const f32x4*)(a.in[18] + lane * 4 + 256 * j); }
#pragma unroll
    for (int q = 0; q < NT; ++q) {
        const int row = r0 + q * rstride;
        if (row >= T) continue;
        float s = 0.f;
#pragma unroll
        for (int j = 0; j < 4; ++j) s += (v[q][j][0] + v[q][j][1]) + (v[q][j][2] + v[q][j][3]);
        const float mean = wave_sum(s) * (1.0f / 1024.0f); float qq = 0.f;
#pragma unroll
        for (int j = 0; j < 4; ++j) { v[q][j] = v[q][j] - mean; qq += (v[q][j][0] * v[q][j][0] + v[q][j][1] * v[q][j][1]) + (v[q][j][2] * v[q][j][2] + v[q][j][3] * v[q][j][3]); }
        const float rstd = rsqrtf(wave_sum(qq) * (1.0f / 1024.0f) + LN_EPS);
        bf16* o = (bf16*)(a.ws + WS_X1B) + (size_t)row * 1024 + lane * 4;
        float am = 0.f;
#pragma unroll
        for (int j = 0; j < 4; ++j) {
            const f32x4 y = v[q][j] * rstd * gg[j] + bb[j]; v[q][j] = y;
            am = fmaxf(am, fmaxf(fmaxf(fabsf(y[0]), fabsf(y[1])), fmaxf(fabsf(y[2]), fabsf(y[3]))));
            v2u w; w.x = pk2(y[0], y[1]); w.y = pk2(y[2], y[3]);
            *(v2u*)(o + 256 * j) = w;
        }
#if PEER_U_INT8
        am = fmaxf(wave_max(am), 1e-30f);
        const float inv = 127.0f / am;
        unsigned char* qo = a.ws + WS_X1Q + (size_t)row * 1024 + lane * 4;
#pragma unroll
        for (int j = 0; j < 4; ++j) *(unsigned*)(qo + 256 * j) = q4_i8(v[q][j][0] * inv, v[q][j][1] * inv, v[q][j][2] * inv, v[q][j][3] * inv);
        if (lane == 0) ((float*)(a.ws + WS_XS))[row] = am * (1.0f / 127.0f);
#endif
    }
}

DEVI unsigned umax_(unsigned a, unsigned b) { return a > b ? a : b; }
DEVI unsigned umin_(unsigned a, unsigned b) { return a < b ? a : b; }
DEVI unsigned skey(float x) { const unsigned b = __float_as_uint(x); return b ^ (((int)b >> 31) | 0x80000000u); }
DEVI unsigned hkey(unsigned h) { return h ^ ((h & 0x8000u) ? 0xFFFFu : 0x8000u); }
DEVI float hkey_dec(unsigned k) { const unsigned kk = k >> 16; return h2f((unsigned short)(kk ^ ((kk & 0x8000u) ? 0x8000u : 0xFFFFu))); }
DEVI void ce_desc(unsigned& a, unsigned& b) { const unsigned mx = umax_(a, b), mn = umin_(a, b); a = mx; b = mn; }
DEVI void sort16_desc(unsigned (&g)[16]) {
#pragma unroll
    for (int k = 2; k <= 16; k <<= 1)
#pragma unroll
        for (int j = k >> 1; j > 0; j >>= 1)
#pragma unroll
            for (int i = 0; i < 16; ++i) { const int l = i ^ j; if (l > i) { if ((i & k) == 0) ce_desc(g[i], g[l]); else ce_desc(g[l], g[i]); } }
}
DEVI void merge16_desc(unsigned (&L)[16], const unsigned (&g)[16]) {
#pragma unroll
    for (int i = 0; i < 16; ++i) L[i] = umax_(L[i], g[15 - i]);
#pragma unroll
    for (int j = 8; j > 0; j >>= 1)
#pragma unroll
        for (int i = 0; i < 16; ++i) { const int l = i ^ j; if (l > i) ce_desc(L[i], L[l]); }
}
DEVI void topk_block(const Args& a, LAS float* stg, int task, int lane) {
    const int tb = task >> 3, h = task & 7;
    const unsigned short* sc = (const unsigned short*)(a.ws + WS_SC) + (size_t)tb * 64 * 2048 + h * 256;
    unsigned L[2][16];
#pragma unroll
    for (int p = 0; p < 2; ++p) {
#pragma unroll
        for (int i = 0; i < 16; ++i) L[p][i] = 0u;
        for (int sub = 0; sub < 2; ++sub) {
            v4u ld[8];
#pragma unroll
            for (int q = 0; q < 8; ++q) ld[q] = *(const v4u*)(sc + (size_t)(q * 8 + (lane >> 3)) * 2048 + p * 128 + sub * 64 + (lane & 7) * 8);
            __builtin_amdgcn_wave_barrier();
#pragma unroll
            for (int q = 0; q < 8; ++q) *(LAS v4u*)(stg + (q * 8 + (lane >> 3)) * 36 + (lane & 7) * 4) = ld[q];
            LDS_WAIT(); __builtin_amdgcn_wave_barrier();
#pragma unroll
            for (int q2 = 0; q2 < 4; ++q2) {
                const v4u v0 = *(const LAS v4u*)(stg + lane * 36 + q2 * 8), v1 = *(const LAS v4u*)(stg + lane * 36 + q2 * 8 + 4);
                unsigned g[16];
#pragma unroll
                for (int e = 0; e < 8; ++e) {
                    const unsigned h0 = (e & 1) ? (v0[e >> 1] >> 16) : (v0[e >> 1] & 0xFFFFu), h1 = (e & 1) ? (v1[e >> 1] >> 16) : (v1[e >> 1] & 0xFFFFu);
                    g[e] = (hkey(h0) << 16) | (unsigned)(sub * 64 + q2 * 16 + e); g[8 + e] = (hkey(h1) << 16) | (unsigned)(sub * 64 + q2 * 16 + 8 + e);
                }
                sort16_desc(g);
                merge16_desc(L[p], g);
            }
            LDS_WAIT(); __builtin_amdgcn_wave_barrier();
        }
    }
    unsigned C[16];
#pragma unroll
    for (int i = 0; i < 16; ++i) C[i] = 0u;
#pragma unroll
    for (int ia = 0; ia < 16; ++ia) {
        const float va = hkey_dec(L[0][ia]); const unsigned ea = (L[0][ia] & 127u) << 7;
#pragma unroll
        for (int ib = 0; ib < 16; ++ib) {
            if ((ia + 1) * (ib + 1) <= 16) {
                unsigned x = (skey(va + hkey_dec(L[1][ib])) & 0xFFFFC000u) | ea | (L[1][ib] & 127u);
#pragma unroll
                for (int i = 0; i < 16; ++i) { const unsigned t = umax_(C[i], x); x = umin_(C[i], x); C[i] = t; }
            }
        }
    }
    const unsigned short* srow = sc + (size_t)lane * 2048;
    float cv[16]; float mx = -3.0e38f;
#pragma unroll
    for (int i = 0; i < 16; ++i) { const unsigned e = C[i] & 0x3FFFu; cv[i] = h2f(srow[e >> 7]) + h2f(srow[128 + (e & 127u)]); mx = fmaxf(mx, cv[i]); }
    float es = 0.f;
#pragma unroll
    for (int i = 0; i < 16; ++i) { cv[i] = __expf(cv[i] - mx); es += cv[i]; }
    const float inv = 1.0f / es;
    const size_t item = ((size_t)tb * 64 + lane) * 8 + h;
    int* ids = (int*)(a.ws + WS_IDS) + item * 16; float* gts = (float*)(a.ws + WS_GATES) + item * 16;
#pragma unroll
    for (int i = 0; i < 16; i += 4) { *(v4u*)(ids + i) = (v4u){C[i] & 0x3FFFu, C[i + 1] & 0x3FFFu, C[i + 2] & 0x3FFFu, C[i + 3] & 0x3FFFu};
        *(f32x4*)(gts + i) = (f32x4){cv[i] * inv, cv[i + 1] * inv, cv[i + 2] * inv, cv[i + 3] * inv}; }
}

DEVI void cvt16_fp8(const v4u& r, float (&f)[16]) {
#pragma unroll
    for (int w = 0; w < 4; ++w) { const f32x2 lo = __builtin_amdgcn_cvt_pk_f32_fp8((int)r[w], false), hi = __builtin_amdgcn_cvt_pk_f32_fp8((int)r[w], true);
        f[4 * w] = lo[0]; f[4 * w + 1] = lo[1]; f[4 * w + 2] = hi[0]; f[4 * w + 3] = hi[1]; }
}
#ifndef GCH
#define GCH 128
#endif
#ifndef GATHER_NT
#define GATHER_NT 0
#endif
#if GATHER_NT
#define NTLD(p) (*(p))
#define NTST(v, p) __builtin_nontemporal_store((v), (p))
#else
#define NTLD(p) (*(p))
#define NTST(v, p) (*(p) = (v))
#endif
DEVI int bperm_i(int srclane, int v) { return __builtin_amdgcn_ds_bpermute(srclane << 2, v); }
DEVI void gx_issue(v4u (&row)[16], const unsigned char* tab, int id0, int id1, int g) {
#pragma unroll
    for (int it = 0; it < 16; ++it) { const int e = bperm_i((it * 8 + g) & 63, it < 8 ? id0 : id1); row[it] = *(const v4u*)(tab + (size_t)e * 128); }
}
#if PEER_U_INT8
DEVI void gu_math(const v4u (&row)[16], const v4u& xq, const v4u&, float* pd, int g, int i) {
    int d[16];
#pragma unroll
    for (int it = 0; it < 16; ++it) { int s = 0;
#pragma unroll
        for (int w = 0; w < 4; ++w) s = __builtin_amdgcn_sdot4((int)row[it][w], (int)xq[w], s, false);
        d[it] = s; }
    const bool b2 = i & 4, b1 = i & 2, b0 = i & 1;
    int y[2];
#pragma unroll
    for (int hh = 0; hh < 2; ++hh) {
        int w4[4], w2[2];
#pragma unroll
        for (int q = 0; q < 4; ++q) { const int send = b2 ? d[8 * hh + q] : d[8 * hh + q + 4], keep = b2 ? d[8 * hh + q + 4] : d[8 * hh + q]; w4[q] = keep + __shfl_xor(send, 4); }
#pragma unroll
        for (int q = 0; q < 2; ++q) { const int send = b1 ? w4[q] : w4[q + 2], keep = b1 ? w4[q + 2] : w4[q]; w2[q] = keep + __shfl_xor(send, 2); }
        { const int send = b0 ? w2[0] : w2[1], keep = b0 ? w2[1] : w2[0]; y[hh] = keep + __shfl_xor(send, 1); }
    }
    NTST((float)y[0], pd + i * 8 + g); NTST((float)y[1], pd + (8 + i) * 8 + g);
}
#else
DEVI void gu_math(const v4u (&row)[16], const v4u& x0, const v4u& x1, float* pd, int g, int i) {
    float xs[16]; { float u0[8], u1[8]; unpack8(x0, u0); unpack8(x1, u1);
#pragma unroll
        for (int q = 0; q < 8; ++q) { xs[q] = u0[q]; xs[8 + q] = u1[q]; } }
    f32x2 xp2[8];
#pragma unroll
    for (int q = 0; q < 8; ++q) xp2[q] = (f32x2){xs[2 * q], xs[2 * q + 1]};
    float d[16];
#pragma unroll
    for (int it = 0; it < 16; ++it) { f32x2 sm = {0.f, 0.f};
#pragma unroll
        for (int w = 0; w < 4; ++w) { sm = __builtin_elementwise_fma(__builtin_amdgcn_cvt_pk_f32_fp8((int)row[it][w], false), xp2[2 * w], sm);
                                      sm = __builtin_elementwise_fma(__builtin_amdgcn_cvt_pk_f32_fp8((int)row[it][w], true), xp2[2 * w + 1], sm); }
        d[it] = sm[0] + sm[1];
        if ((it & 3) == 3) __builtin_amdgcn_sched_barrier(0); }
    const bool b2 = i & 4, b1 = i & 2, b0 = i & 1;
    float y[2];
#pragma unroll
    for (int hh = 0; hh < 2; ++hh) {
        float w4[4], w2[2];
#pragma unroll
        for (int q = 0; q < 4; ++q) { const float send = b2 ? d[8 * hh + q] : d[8 * hh + q + 4], keep = b2 ? d[8 * hh + q + 4] : d[8 * hh + q]; w4[q] = keep + __shfl_xor(send, 4); }
#pragma unroll
        for (int q = 0; q < 2; ++q) { const float send = b1 ? w4[q] : w4[q + 2], keep = b1 ? w4[q + 2] : w4[q]; w2[q] = keep + __shfl_xor(send, 2); }
        { const float send = b0 ? w2[0] : w2[1], keep = b0 ? w2[1] : w2[0]; y[hh] = keep + __shfl_xor(send, 1); }
    }
    pd[i * 8 + g] = y[0]; pd[(8 + i) * 8 + g] = y[1];
}
#endif
DEVI void gu_chunk(const Args& a, int j, int chunk, int wave, int lane) {
    unsigned char* ws = a.ws;
    const int g = lane >> 3, i = lane & 7;
    const unsigned char* tab = ws + WS_PU + (size_t)j * PNE * 128 + i * 16;
    float* PD = (float*)(ws + WS_PD) + (size_t)j * T * 128;
    const int* idbase = (const int*)(ws + WS_IDS);
#if PEER_U_INT8
    const unsigned char* xbase = ws + WS_X1Q + j * 128 + i * 16;
#define GU_X1(p) (*(const v4u*)(p))
#else
    const bf16* xbase = (const bf16*)(ws + WS_X1B) + j * 128 + i * 16;
#define GU_X1(p) (*(const v4u*)((p) + 8))
#endif
    const int t0 = chunk * GCH + wave * (GCH / 8);
    v4u rowA[16], rowB[16];
    int ia0 = NTLD(idbase + (size_t)t0 * 128 + lane), ia1 = NTLD(idbase + (size_t)t0 * 128 + 64 + lane);
    int ib0 = NTLD(idbase + (size_t)(t0 + 1) * 128 + lane), ib1 = NTLD(idbase + (size_t)(t0 + 1) * 128 + 64 + lane);
    v4u xa0 = *(const v4u*)(xbase + (size_t)t0 * 1024), xa1 = GU_X1(xbase + (size_t)t0 * 1024), xb0, xb1;
    gx_issue(rowA, tab, ia0, ia1, g);
    for (int tt = 0; tt < GCH / 8; tt += 2) {
        const int t = t0 + tt; const bool more = tt + 2 < GCH / 8;
        if (more) { ia0 = NTLD(idbase + (size_t)(t + 2) * 128 + lane); ia1 = NTLD(idbase + (size_t)(t + 2) * 128 + 64 + lane); }
        xb0 = *(const v4u*)(xbase + (size_t)(t + 1) * 1024); xb1 = GU_X1(xbase + (size_t)(t + 1) * 1024);
        __builtin_amdgcn_sched_barrier(0);
        gx_issue(rowB, tab, ib0, ib1, g);
        __builtin_amdgcn_sched_barrier(0);
        gu_math(rowA, xa0, xa1, PD + (size_t)t * 128, g, i);
        __builtin_amdgcn_sched_barrier(0);
        if (more) { ib0 = NTLD(idbase + (size_t)(t + 3) * 128 + lane); ib1 = NTLD(idbase + (size_t)(t + 3) * 128 + 64 + lane);
            xa0 = *(const v4u*)(xbase + (size_t)(t + 2) * 1024); xa1 = GU_X1(xbase + (size_t)(t + 2) * 1024); }
        __builtin_amdgcn_sched_barrier(0);
        if (more) gx_issue(rowA, tab, ia0, ia1, g);
        __builtin_amdgcn_sched_barrier(0);
        gu_math(rowB, xb0, xb1, PD + (size_t)(t + 1) * 128, g, i);
        __builtin_amdgcn_sched_barrier(0);
    }
}
DEVI void gv_math(const v4u (&row)[16], float c0, float c1, bf16* op, int g, int i, int lane) {
    const bool b5 = lane & 32, b4 = lane & 16, b3 = lane & 8;
    const int p = (b5 ? 4 : 0) + (b4 ? 2 : 0) + (b3 ? 1 : 0), colA = (p >> 1) * 4 + (p & 1);
    float cf[16];
#pragma unroll
    for (int it = 0; it < 16; ++it) cf[it] = __uint_as_float((unsigned)bperm_i((it * 8 + g) & 63, (int)__float_as_uint(it < 8 ? c0 : c1)));
#pragma unroll
    for (int pass = 0; pass < 2; ++pass) {
        f32x2 acc2[4];
#pragma unroll
        for (int c = 0; c < 4; ++c) acc2[c] = (f32x2){0.f, 0.f};
#pragma unroll
        for (int it = 0; it < 16; ++it) { const f32x2 c2 = {cf[it], cf[it]};
#pragma unroll
            for (int w = 0; w < 4; ++w) { const f32x2 v = pass ? __builtin_amdgcn_cvt_pk_f32_fp8((int)row[it][w], true) : __builtin_amdgcn_cvt_pk_f32_fp8((int)row[it][w], false); acc2[w] = __builtin_elementwise_fma(c2, v, acc2[w]); }
            if ((it & 3) == 3) __builtin_amdgcn_sched_barrier(0);
        }
        float acc[8];
#pragma unroll
        for (int c = 0; c < 4; ++c) { acc[2 * c] = acc2[c][0]; acc[2 * c + 1] = acc2[c][1]; }
        float w4[4], w2[2], y;
#pragma unroll
        for (int q = 0; q < 4; ++q) { const float send = b5 ? acc[q] : acc[q + 4], keep = b5 ? acc[q + 4] : acc[q]; w4[q] = keep + __shfl_xor(send, 32); }
#pragma unroll
        for (int q = 0; q < 2; ++q) { const float send = b4 ? w4[q] : w4[q + 2], keep = b4 ? w4[q + 2] : w4[q]; w2[q] = keep + __shfl_xor(send, 16); }
        { const float send = b3 ? w2[0] : w2[1], keep = b3 ? w2[1] : w2[0]; y = keep + __shfl_xor(send, 8); }
        NTST((bf16)f2bf(y), op + i * 16 + colA + 2 * pass);
    }
}
#ifndef PROBE_GVMATH
#define PROBE_GVMATH 0
#endif
__device__ unsigned long long gvm_dummy;
DEVI void gv_chunk(const Args& a, int j, int chunk, int wave, int lane, unsigned long long& gvm_acc) {
    unsigned char* ws = a.ws;
    const int g = lane >> 3, i = lane & 7;
    const unsigned char* tab = ws + WS_PV + (size_t)j * PNE * 128 + i * 16;
    const int* idbase = (const int*)(ws + WS_IDS); const float* cfbase = (const float*)(ws + WS_CF);
    bf16* obase = (bf16*)(ws + WS_OP) + j * 128;
    const int t0 = chunk * GCH + wave * (GCH / 8);
    v4u rowA[16], rowB[16];
    int ia0 = NTLD(idbase + (size_t)t0 * 128 + lane), ia1 = NTLD(idbase + (size_t)t0 * 128 + 64 + lane);
    int ib0 = NTLD(idbase + (size_t)(t0 + 1) * 128 + lane), ib1 = NTLD(idbase + (size_t)(t0 + 1) * 128 + 64 + lane);
    float ca0 = NTLD(cfbase + (size_t)t0 * 128 + lane), ca1 = NTLD(cfbase + (size_t)t0 * 128 + 64 + lane), cb0, cb1;
    gx_issue(rowA, tab, ia0, ia1, g);
    for (int tt = 0; tt < GCH / 8; tt += 2) {
        const int t = t0 + tt; const bool more = tt + 2 < GCH / 8;
        if (more) { ia0 = NTLD(idbase + (size_t)(t + 2) * 128 + lane); ia1 = NTLD(idbase + (size_t)(t + 2) * 128 + 64 + lane); }
        cb0 = NTLD(cfbase + (size_t)(t + 1) * 128 + lane); cb1 = NTLD(cfbase + (size_t)(t + 1) * 128 + 64 + lane);
        __builtin_amdgcn_sched_barrier(0);
        gx_issue(rowB, tab, ib0, ib1, g);
        __builtin_amdgcn_sched_barrier(0);
        { const unsigned long long m0_ = PROBE_GVMATH ? __builtin_amdgcn_s_memrealtime() : 0ull;
        gv_math(rowA, ca0, ca1, obase + (size_t)t * 1024, g, i, lane);
        if (PROBE_GVMATH) gvm_acc += __builtin_amdgcn_s_memrealtime() - m0_; }
        __builtin_amdgcn_sched_barrier(0);
        if (more) { ib0 = NTLD(idbase + (size_t)(t + 3) * 128 + lane); ib1 = NTLD(idbase + (size_t)(t + 3) * 128 + 64 + lane);
            ca0 = NTLD(cfbase + (size_t)(t + 2) * 128 + lane); ca1 = NTLD(cfbase + (size_t)(t + 2) * 128 + 64 + lane); }
        __builtin_amdgcn_sched_barrier(0);
        if (more) gx_issue(rowA, tab, ia0, ia1, g);
        __builtin_amdgcn_sched_barrier(0);
        { const unsigned long long m0_ = PROBE_GVMATH ? __builtin_amdgcn_s_memrealtime() : 0ull;
        gv_math(rowB, cb0, cb1, obase + (size_t)(t + 1) * 1024, g, i, lane);
        if (PROBE_GVMATH) gvm_acc += __builtin_amdgcn_s_memrealtime() - m0_; }
        __builtin_amdgcn_sched_barrier(0);
    }
}
DEVI void gvg_issue(v4u (&row)[8], const unsigned char* tab, const v4u (&ev)[2]) {
#pragma unroll
    for (int q = 0; q < 8; ++q) row[q] = *(const v4u*)(tab + (size_t)ev[q >> 2][q & 3] * 128);
}
DEVI void gvg_math(const v4u (&row)[8], const f32x4 (&cv)[2], f32x2 (&acc2)[8]) {
#pragma unroll
    for (int q = 0; q < 8; ++q) { const float c = cv[q >> 2][q & 3]; const f32x2 c2 = {c, c};
#pragma unroll
        for (int w = 0; w < 4; ++w) { acc2[2 * w] = __builtin_elementwise_fma(c2, __builtin_amdgcn_cvt_pk_f32_fp8((int)row[q][w], false), acc2[2 * w]);
                                      acc2[2 * w + 1] = __builtin_elementwise_fma(c2, __builtin_amdgcn_cvt_pk_f32_fp8((int)row[q][w], true), acc2[2 * w + 1]); }
        if ((q & 3) == 3) __builtin_amdgcn_sched_barrier(0); }
}
DEVI void gv_chunk_grp(const Args& a, int j, int chunk, int wave, int lane) {
    unsigned char* ws = a.ws;
    const int g = lane >> 3, i = lane & 7;
    const unsigned char* tab = ws + WS_PV + (size_t)j * PNE * 128 + i * 16;
    for (int r = 0; r < GCH / 64; ++r) {
        const int t = chunk * GCH + r * 64 + wave * 8 + g;
        const int* idp = (const int*)(ws + WS_IDS) + (size_t)t * 128; const float* cfp = (const float*)(ws + WS_CF) + (size_t)t * 128;
        f32x2 acc2[8];
#pragma unroll
        for (int c = 0; c < 8; ++c) acc2[c] = (f32x2){0.f, 0.f};
        v4u rowA[8], rowB[8], evA[2], evB[2]; f32x4 cvA[2], cvB[2];
#pragma unroll
        for (int q = 0; q < 2; ++q) { evA[q] = *(const v4u*)(idp + 4 * q); cvA[q] = *(const f32x4*)(cfp + 4 * q); }
        gvg_issue(rowA, tab, evA);
#pragma unroll
        for (int q = 0; q < 2; ++q) evB[q] = *(const v4u*)(idp + 8 + 4 * q);
        for (int s = 0; s < 16; s += 2) {
            if (s + 2 < 16) {
#pragma unroll
                for (int q = 0; q < 2; ++q) evA[q] = *(const v4u*)(idp + (s + 2) * 8 + 4 * q);
            }
#pragma unroll
            for (int q = 0; q < 2; ++q) cvB[q] = *(const f32x4*)(cfp + (s + 1) * 8 + 4 * q);
            __builtin_amdgcn_sched_barrier(0);
            gvg_issue(rowB, tab, evB);
            __builtin_amdgcn_sched_barrier(0);
            gvg_math(rowA, cvA, acc2);
            __builtin_amdgcn_sched_barrier(0);
            if (s + 3 < 16) {
#pragma unroll
                for (int q = 0; q < 2; ++q) evB[q] = *(const v4u*)(idp + (s + 3) * 8 + 4 * q);
            }
            if (s + 2 < 16) {
#pragma unroll
                for (int q = 0; q < 2; ++q) cvA[q] = *(const f32x4*)(cfp + (s + 2) * 8 + 4 * q);
            }
            __builtin_amdgcn_sched_barrier(0);
            if (s + 2 < 16) gvg_issue(rowA, tab, evA);
            __builtin_amdgcn_sched_barrier(0);
            gvg_math(rowB, cvB, acc2);
            __builtin_amdgcn_sched_barrier(0);
        }
        bf16* op = (bf16*)(ws + WS_OP) + (size_t)t * 1024 + j * 128 + i * 16;
        v4u w0, w1; w0.x = pk2(acc2[0][0], acc2[0][1]); w0.y = pk2(acc2[1][0], acc2[1][1]); w0.z = pk2(acc2[2][0], acc2[2][1]); w0.w = pk2(acc2[3][0], acc2[3][1]);
        w1.x = pk2(acc2[4][0], acc2[4][1]); w1.y = pk2(acc2[5][0], acc2[5][1]); w1.z = pk2(acc2[6][0], acc2[6][1]); w1.w = pk2(acc2[7][0], acc2[7][1]);
        *(v4u*)op = w0; *(v4u*)(op + 8) = w1;
    }
}
#if PEER_U_INT8
DEVI void gug_math(const v4u (&row)[8], const v4u& xq, float* pd, int i) {
    int d[8];
#pragma unroll
    for (int q = 0; q < 8; ++q) { int s = 0;
#pragma unroll
        for (int w = 0; w < 4; ++w) s = __builtin_amdgcn_sdot4((int)row[q][w], (int)xq[w], s, false);
        d[q] = s; }
    const bool b2 = i & 4, b1 = i & 2, b0 = i & 1;
    int w4[4], w2[2], y;
#pragma unroll
    for (int q = 0; q < 4; ++q) { const int send = b2 ? d[q] : d[q + 4], keep = b2 ? d[q + 4] : d[q]; w4[q] = keep + __shfl_xor(send, 4); }
#pragma unroll
    for (int q = 0; q < 2; ++q) { const int send = b1 ? w4[q] : w4[q + 2], keep = b1 ? w4[q + 2] : w4[q]; w2[q] = keep + __shfl_xor(send, 2); }
    { const int send = b0 ? w2[0] : w2[1], keep = b0 ? w2[1] : w2[0]; y = keep + __shfl_xor(send, 1); }
    pd[i] = (float)y;
}
DEVI void gug_issue16(v4u (&row)[16], const unsigned char* tab, const v4u (&ev)[4]) {
#pragma unroll
    for (int q = 0; q < 16; ++q) row[q] = *(const v4u*)(tab + (size_t)ev[q >> 2][q & 3] * 128);
}
DEVI void gug_math16(const v4u (&row)[16], const v4u& xq, float* pd, int i) {
    int d[16];
#pragma unroll
    for (int q = 0; q < 16; ++q) { int s = 0;
#pragma unroll
        for (int w = 0; w < 4; ++w) s = __builtin_amdgcn_sdot4((int)row[q][w], (int)xq[w], s, false);
        d[q] = s; }
    const bool b2 = i & 4, b1 = i & 2, b0 = i & 1;
#pragma unroll
    for (int hh = 0; hh < 2; ++hh) {
        int w4[4], w2[2], y;
#pragma unroll
        for (int q = 0; q < 4; ++q) { const int send = b2 ? d[8 * hh + q] : d[8 * hh + q + 4], keep = b2 ? d[8 * hh + q + 4] : d[8 * hh + q]; w4[q] = keep + __shfl_xor(send, 4); }
#pragma unroll
        for (int q = 0; q < 2; ++q) { const int send = b1 ? w4[q] : w4[q + 2], keep = b1 ? w4[q + 2] : w4[q]; w2[q] = keep + __shfl_xor(send, 2); }
        { const int send = b0 ? w2[0] : w2[1], keep = b0 ? w2[1] : w2[0]; y = keep + __shfl_xor(send, 1); }
        pd[8 * hh + i] = (float)y;
    }
}
DEVI void gu_chunk_grp(const Args& a, int j, int chunk, int wave, int lane) {
    unsigned char* ws = a.ws;
    const int g = lane >> 3, i = lane & 7;
    const unsigned char* tab = ws + WS_PU + (size_t)j * PNE * 128 + i * 16;
    for (int r = 0; r < GCH / 64; ++r) {
        const int t = chunk * GCH + r * 64 + wave * 8 + g;
        const int* idp = (const int*)(ws + WS_IDS) + (size_t)t * 128;
        float* pd = (float*)(ws + WS_PD) + (size_t)j * T * 128 + (size_t)t * 128;
        const v4u xq = *(const v4u*)(ws + WS_X1Q + (size_t)t * 1024 + j * 128 + i * 16);
        v4u rowA[16], rowB[16], evA[4], evB[4];
#pragma unroll
        for (int q = 0; q < 4; ++q) evA[q] = *(const v4u*)(idp + 4 * q);
        gug_issue16(rowA, tab, evA);
#pragma unroll
        for (int q = 0; q < 4; ++q) evB[q] = *(const v4u*)(idp + 16 + 4 * q);
        for (int s = 0; s < 8; s += 2) {
            if (s + 2 < 8) {
#pragma unroll
                for (int q = 0; q < 4; ++q) evA[q] = *(const v4u*)(idp + (s + 2) * 16 + 4 * q);
            }
            __builtin_amdgcn_sched_barrier(0);
            gug_issue16(rowB, tab, evB);
            __builtin_amdgcn_sched_barrier(0);
            gug_math16(rowA, xq, pd + s * 16, i);
            __builtin_amdgcn_sched_barrier(0);
            if (s + 3 < 8) {
#pragma unroll
                for (int q = 0; q < 4; ++q) evB[q] = *(const v4u*)(idp + (s + 3) * 16 + 4 * q);
            }
            __builtin_amdgcn_sched_barrier(0);
            if (s + 2 < 8) gug_issue16(rowA, tab, evA);
            __builtin_amdgcn_sched_barrier(0);
            gug_math16(rowB, xq, pd + (s + 1) * 16, i);
            __builtin_amdgcn_sched_barrier(0);
        }
    }
}
#endif
#ifndef GV_GROUPED
#define GV_GROUPED 1
#endif
#ifndef GU_GROUPED
#define GU_GROUPED 1
#endif
template <int WHICH> DEVI void sliced_phase(const Args& a, LAS unsigned char* lds, int wave, int lane, int ctr_off = 0) {
    unsigned* ctr = (unsigned*)(a.ws + WS_CTL) + (WHICH ? CW_GV : CW_GU) + ctr_off;
    volatile LAS unsigned* slot = (volatile LAS unsigned*)(lds + LDS_BYTES - 32);
#ifdef SLICE_BY_BLOCK
    const int xcc = (int)(blockIdx.x & 7u);
#else
    const int xcc = (int)(xb_xcc_id() & 7u);
#endif
    unsigned long long gvm_acc = 0;
    for (int pass = 0; pass < 8; ++pass) {
        const int j = (xcc + pass) & 7;
        for (;;) {
            __syncthreads();
            if (threadIdx.x == 0) *slot = __hip_atomic_fetch_add(ctr + 64 * j, 1u, __ATOMIC_RELAXED, __HIP_MEMORY_SCOPE_AGENT);
            __syncthreads();
            const unsigned c = *slot;
            if (c >= (unsigned)(T / GCH)) break;
            if (WHICH) { if (GV_GROUPED) gv_chunk_grp(a, j, (int)c, wave, lane); else gv_chunk(a, j, (int)c, wave, lane, gvm_acc); } else { if (GU_GROUPED && PEER_U_INT8) gu_chunk_grp(a, j, (int)c, wave, lane); else gu_chunk(a, j, (int)c, wave, lane); }
        }
    }
    if (PROBE_GVMATH && WHICH) { const unsigned long long s_ = __builtin_amdgcn_s_memrealtime(); while (__builtin_amdgcn_s_memrealtime() - s_ < PROBE_GVMATH * gvm_acc) __builtin_amdgcn_s_sleep(8); }
}
DEVI void coef_phase(const Args& a) {
    unsigned char* ws = a.ws;
    const float* PD = (const float*)(ws + WS_PD); const float* gts = (const float*)(ws + WS_GATES); float* CF = (float*)(ws + WS_CF);
    for (size_t i = (size_t)blockIdx.x * 512 + threadIdx.x; i < (size_t)T * 128 / 4; i += (size_t)gridDim.x * 512) {
        f32x4 s = *(const f32x4*)(PD + i * 4);
#pragma unroll
        for (int j = 1; j < 8; ++j) s += *(const f32x4*)(PD + (size_t)j * T * 128 + i * 4);
        const f32x4 gt = *(const f32x4*)(gts + i * 4);
        f32x4 o;
#if PEER_U_INT8
        const v4u ev = *(const v4u*)((const int*)(ws + WS_IDS) + i * 4);
        const float xsc = ((const float*)(ws + WS_XS))[i >> 5];
        const float* us = (const float*)(ws + WS_US);
#pragma unroll
        for (int q = 0; q < 4; ++q) o[q] = gt[q] * gelu_t(s[q] * xsc * us[ev[q]]) * (1.0f / PV_SCALE);
#else
#pragma unroll
        for (int q = 0; q < 4; ++q) o[q] = gt[q] * gelu_t(s[q] * (1.0f / PU_SCALE)) * (1.0f / PV_SCALE);
#endif
        *(f32x4*)(CF + i * 4) = o;
    }
}
template <int NT> DEVI void ln2_tokens(const Args& a, int t0, int tstride, int lane) {
    unsigned char* ws = a.ws;
    v4u xr[NT][2], orr[NT][2];
#pragma unroll
    for (int q = 0; q < NT; ++q) { const int tq = (t0 + q * tstride < T) ? t0 + q * tstride : t0; const size_t o = (size_t)tq * 1024 + lane * 16;
        const bf16* xp = (const bf16*)(ws + WS_X1B) + o; const bf16* ip = (const bf16*)(ws + WS_OP) + o;
        xr[q][0] = *(const v4u*)xp; xr[q][1] = *(const v4u*)(xp + 8); orr[q][0] = *(const v4u*)ip; orr[q][1] = *(const v4u*)(ip + 8); }
    const float* g2 = a.in[23] + lane * 16; const float* b2 = a.in[24] + lane * 16;
    f32x4 gg[4], bb[4];
#pragma unroll
    for (int i = 0; i < 4; ++i) { gg[i] = *(const f32x4*)(g2 + 4 * i); bb[i] = *(const f32x4*)(b2 + 4 * i); }
#pragma unroll
    for (int q = 0; q < NT; ++q) {
        float xf[16], acc[16];
        { float t0a[8], t1a[8]; unpack8(xr[q][0], t0a); unpack8(xr[q][1], t1a);
#pragma unroll
          for (int i = 0; i < 8; ++i) { xf[i] = t0a[i]; xf[8 + i] = t1a[i]; } }
        { float t0a[8], t1a[8]; unpack8(orr[q][0], t0a); unpack8(orr[q][1], t1a);
#pragma unroll
          for (int i = 0; i < 8; ++i) { acc[i] = t0a[i]; acc[8 + i] = t1a[i]; } }
        float s = 0.f;
#pragma unroll
        for (int i = 0; i < 16; ++i) { acc[i] += ALPHA * xf[i]; s += acc[i]; }
        const float mean = wave_sum(s) * (1.0f / 1024.0f); float qq = 0.f;
#pragma unroll
        for (int i = 0; i < 16; ++i) { acc[i] -= mean; qq += acc[i] * acc[i]; }
        const float rstd = rsqrtf(wave_sum(qq) * (1.0f / 1024.0f) + LN_EPS);
        if (t0 + q * tstride >= T) continue;
        float* op = a.out + (size_t)(t0 + q * tstride) * 1024 + lane * 16;
#pragma unroll
        for (int i = 0; i < 4; ++i) {
            f32x4 y; y[0] = acc[4 * i] * rstd * gg[i][0] + bb[i][0]; y[1] = acc[4 * i + 1] * rstd * gg[i][1] + bb[i][1]; y[2] = acc[4 * i + 2] * rstd * gg[i][2] + bb[i][2]; y[3] = acc[4 * i + 3] * rstd * gg[i][3] + bb[i][3];
            *(f32x4*)(op + 4 * i) = y;
        }
    }
}

enum Phase { PH_PREP = 0, PH_PROJ, PH_S5Z, PH_S5SCAN, PH_S5Y, PH_HGRN, PH_GLU, PH_MERGE, PH_OUT, PH_LN1, PH_SCORES, PH_TOPK, PH_GU, PH_COEF, PH_GV, PH_LN2, PH_COUNT };

#ifndef STAGGER_SLEEPS
#define STAGGER_SLEEPS 2
#endif
DEVI void stagger() { if (blockIdx.x & 1) { for (int i = 0; i < STAGGER_SLEEPS; ++i) __builtin_amdgcn_s_sleep(127); } }
#ifndef PG8_ALIGN
#define PG8_ALIGN true
#endif
#ifndef PG8_SP2
#define PG8_SP2 true
#endif
template <class Epi> DEVI void run_gemm(LAS unsigned char* lds, const bf16* A, const bf16* Bt, int M, int N, int K, int lda, int ldb, const Epi& E) {
    pg8::Gemm g; g.A = A; g.Bt = Bt; g.M = M; g.N = N; g.K = K; g.lda = lda; g.ldb = ldb; g.sA = 0; g.sB = 0; g.nz = 1;
    pg8::StaticOrder S; S.init(M, N, gridDim.x, blockIdx.x, 1);
    pg8::gemm_phase<Epi, pg8::StaticOrder, PG8_ALIGN, PG8_SP2>(lds, g, S, E);
}
template <class Epi> DEVI void run_gemm_batched(LAS unsigned char* lds, const bf16* A, const bf16* Bt, int M, int N, int K, int lda, int ldb, size_t sA, size_t sB, int nz, const Epi& E, int cidx = -1) {
    pg8::Gemm g; g.A = A; g.Bt = Bt; g.M = M; g.N = N; g.K = K; g.lda = lda; g.ldb = ldb; g.sA = sA; g.sB = sB; g.nz = nz;
    pg8::StaticOrder S; S.init(M, N, gridDim.x, cidx < 0 ? (int)blockIdx.x : cidx, nz);
    pg8::gemm_phase<Epi, pg8::StaticOrder, PG8_ALIGN, PG8_SP2>(lds, g, S, E);
}

#ifndef MK_COOP
#define MK_COOP 1
#endif
__global__ void __launch_bounds__(512, 2) mk_fwd(Args a) {
    extern __shared__ __attribute__((aligned(16))) unsigned char smem[];
    LAS unsigned char* lds = (LAS unsigned char*)smem;
    cg::grid_group grid = cg::this_grid();
    const int tid = threadIdx.x, lane = tid & 63, wave = __builtin_amdgcn_readfirstlane(tid >> 6), G = gridDim.x;
    unsigned char* ws = a.ws;
    volatile LAS unsigned* bst = (volatile LAS unsigned*)(lds + LDS_BYTES - 16);
    if (tid < 2) bst[tid] = 0u;
    __syncthreads();
    const XcdBarrier xb = xcd_barrier_post((unsigned*)(ws + WS_CTL), bst);
#ifndef REP_PH
#define REP_PH -1
#endif
#ifndef REP_N
#define REP_N 1
#endif
#ifndef PROBE_PH
#define PROBE_PH -1
#endif
#ifndef PROBE_BAR
#define PROBE_BAR 0
#endif
    unsigned long long bar_acc_ = 0;
#define PH_BEGIN(P) if (a.ph_lo <= (P) && (P) < a.ph_hi) { if (a.ph_lo < (P)) { const unsigned long long bt0_ = PROBE_BAR ? __builtin_amdgcn_s_memrealtime() : 0ull; if (MK_COOP && (P) == PH_PROJ) grid.sync(); else xcd_barrier(xb); if (PROBE_BAR) bar_acc_ += __builtin_amdgcn_s_memrealtime() - bt0_; } \
    const int ph_cur_ = (P); const unsigned long long ph_t0_ = (PROBE_PH >= 0) ? __builtin_amdgcn_s_memrealtime() : 0ull; for (int rep_ = 0; rep_ < ((P) == REP_PH ? REP_N : 1); ++rep_) {
#define PH_END } if (PROBE_PH >= 0 && ph_cur_ == PROBE_PH) { const unsigned long long d_ = __builtin_amdgcn_s_memrealtime() - ph_t0_, s_ = __builtin_amdgcn_s_memrealtime(); while (__builtin_amdgcn_s_memrealtime() - s_ < 2 * d_) __builtin_amdgcn_s_sleep(8); } }
    PH_BEGIN(PH_PREP) phase_prep(a, lds); for (int it = blockIdx.x; it < S5G * 8; it += G) s5_tables_item(a, lds, it); PH_END
    PH_BEGIN(PH_PROJ) EpiProj E; E.ws = ws; E.lb_logits = a.in[12];
#ifdef PROBE_PHASE_BLOCK
        const unsigned long long pp0_ = __builtin_amdgcn_s_memrealtime();
#endif
#if PROJ_INT8
        run_gemm(lds, (const bf16*)(ws + WS_XB), (const bf16*)(ws + WS_WINT), T, INC, 512, 512, 512, E);
#else
        run_gemm(lds, (const bf16*)(ws + WS_XB), (const bf16*)(ws + WS_WINT), T, INC, 1024, 1024, 1024, E);
#endif
#ifdef PROBE_PHASE_BLOCK
        if (PROBE_PHASE_COND) { const unsigned long long d_ = __builtin_amdgcn_s_memrealtime() - pp0_, t0_ = __builtin_amdgcn_s_memrealtime(); while (__builtin_amdgcn_s_memrealtime() - t0_ < 2 * d_) __builtin_amdgcn_s_sleep(8); }
#endif
    PH_END
    PH_BEGIN(PH_S5Z)
        for (int it = blockIdx.x; it < 256; it += G) if ((it & 3) != 3) hgrn_segment<false>(a, lds, it);
        __syncthreads();
        EpiS5Z E; E.ws = ws;
        run_gemm_batched(lds, (const bf16*)(ws + WS_U5), (const bf16*)(ws + WS_WZ), 1024, 256, 1024, UK, 1024, (size_t)1024 * UK, (size_t)256 * 1024, S5G, E, G - 1 - (int)blockIdx.x); PH_END
    PH_BEGIN(PH_S5SCAN) s5_scan(a); PH_END
    PH_BEGIN(PH_S5Y) EpiS5Y E; E.ws = ws;
        run_gemm_batched(lds, (const bf16*)(ws + WS_U5), (const bf16*)(ws + WS_TY), 1024, 1024, UK, UK, UK, (size_t)1024 * UK, (size_t)1024 * UK, S5G, E); PH_END
    PH_BEGIN(PH_HGRN) for (int it = blockIdx.x; it < 256; it += G) hgrn_segment<true>(a, lds, it); PH_END
    PH_BEGIN(PH_GLU) EpiGlu E; E.ws = ws; E.bias = a.in[11];
        run_gemm(lds, (const bf16*)(ws + WS_Y2), (const bf16*)(ws + WS_WGLUT), T, 512, 512, 512, 512, E); PH_END
    PH_BEGIN(PH_MERGE) EpiMerge E; E.ws = ws;
        pg8::Gemm g; g.A = (const bf16*)(ws + WS_YAB); g.Bt = (const bf16*)(ws + WS_WPAT); g.M = T; g.N = 1024; g.K = 512; g.lda = 1024; g.ldb = 1024; g.sA = 512; g.sB = 512; g.nz = 2;
        pg8::ChainOrder S; S.init(T, 1024, G, blockIdx.x, 1);
        pg8::gemm_phase<EpiMerge, pg8::ChainOrder, PG8_ALIGN, PG8_SP2>(lds, g, S, E); PH_END
    PH_BEGIN(PH_OUT) EpiOut E; E.ws = ws; E.x = a.in[0];
        run_gemm(lds, (const bf16*)(ws + WS_MG), (const bf16*)(ws + WS_WOT), T, 1024, 1024, 1024, 1024, E); PH_END
    PH_BEGIN(PH_LN1) for (int r = blockIdx.x * 8 + wave; r < T; r += 8 * G * 4) ln1_rows<4>(a, r, 8 * G, lane); PH_END
    PH_BEGIN(PH_SCORES) EpiScores E; E.ws = ws;
#if SCORES_INT8
        run_gemm(lds, (const bf16*)(ws + WS_X1Q), (const bf16*)(ws + WS_WFT), T, 2048, 512, 512, 512, E);
#else
        run_gemm(lds, (const bf16*)(ws + WS_X1B), (const bf16*)(ws + WS_WFT), T, 2048, 1024, 1024, 1024, E);
#endif
    PH_END
    PH_BEGIN(PH_TOPK) LAS float* stg = (LAS float*)(lds + wave * 9216);
        for (int it = blockIdx.x * 8 + wave; it < (T / 64) * PH; it += 8 * G) topk_block(a, stg, it, lane); PH_END
    PH_BEGIN(PH_GU) sliced_phase<0>(a, lds, wave, lane);
#ifdef PROBE_GU2
        sliced_phase<0>(a, lds, wave, lane, 64 * 16);
#endif
    PH_END
    PH_BEGIN(PH_COEF) coef_phase(a); PH_END
    PH_BEGIN(PH_GV) sliced_phase<1>(a, lds, wave, lane);
#ifdef PROBE_GV2
        sliced_phase<1>(a, lds, wave, lane, 64 * 16);
#endif
    PH_END
    PH_BEGIN(PH_LN2) for (int t = blockIdx.x * 8 + wave; t < T; t += 8 * G * 4) ln2_tokens<4>(a, t, 8 * G, lane); PH_END
    if (PROBE_BAR) {
        unsigned* mx = (unsigned*)(ws + WS_CTL) + 7000;
        if (tid == 0) __hip_atomic_fetch_max(mx, 0x7fffffffu - (unsigned)bar_acc_, __ATOMIC_RELAXED, __HIP_MEMORY_SCOPE_AGENT);
        xcd_barrier(xb);
        const unsigned long long mn = 0x7fffffffu - __hip_atomic_load(mx, __ATOMIC_RELAXED, __HIP_MEMORY_SCOPE_AGENT);
        const unsigned long long s_ = __builtin_amdgcn_s_memrealtime(); while (__builtin_amdgcn_s_memrealtime() - s_ < PROBE_BAR * mn) __builtin_amdgcn_s_sleep(8); }
}

#ifndef MK_ONE_LAUNCH
#define MK_ONE_LAUNCH 1
#endif

extern "C" void kernel_launch(void* const* d_in, const int* in_sizes, int n_in, void* d_out, int out_size, void* d_ws, size_t ws_size, hipStream_t stream) {
    static int grid = 0;
    if (grid == 0) {
        if (n_in != 25 || out_size != T * D || ws_size < WS_END) { fprintf(stderr, "kernel_launch: unexpected problem (n_in %d, out %d, ws %zu)\n", n_in, out_size, ws_size); grid = -1; return; }
        int dev = 0, cus = 0, per_cu = 0;
        if (hipGetDevice(&dev) != hipSuccess || hipDeviceGetAttribute(&cus, hipDeviceAttributeMultiprocessorCount, dev) != hipSuccess) { grid = -1; return; }
        if (hipFuncSetAttribute((const void*)mk_fwd, hipFuncAttributeMaxDynamicSharedMemorySize, LDS_BYTES) != hipSuccess) { fprintf(stderr, "kernel_launch: hipFuncSetAttribute failed\n"); grid = -1; return; }
        if (hipOccupancyMaxActiveBlocksPerMultiprocessor(&per_cu, (const void*)mk_fwd, 512, LDS_BYTES) != hipSuccess || per_cu < 1) { fprintf(stderr, "kernel_launch: occupancy query says %d\n", per_cu); per_cu = 1; }
        (void)hipGetLastError();
        grid = cus;
    }
    if (grid < 0) return;
    Args a{};
    for (int i = 0; i < 25; ++i) a.in[i] = (const float*)d_in[i];
    a.out = (float*)d_out; a.ws = (unsigned char*)d_ws;
#if MK_ONE_LAUNCH
    if (hipMemsetAsync((char*)d_ws + WS_CTL, 0, CTL_WORDS * 4, stream) != hipSuccess) { fprintf(stderr, "kernel_launch: memset of the barrier words failed\n"); return; }
    a.ph_lo = 0; a.ph_hi = PH_COUNT;
#if MK_COOP
    void* kargs[] = {&a};
    hipError_t e = hipLaunchCooperativeKernel((const void*)mk_fwd, dim3(grid), dim3(512), kargs, LDS_BYTES, stream);
    if (e != hipSuccess) fprintf(stderr, "kernel_launch: cooperative launch failed: %s (grid %d)\n", hipGetErrorString(e), grid);
#else
    hipLaunchKernelGGL(mk_fwd, dim3(grid), dim3(512), LDS_BYTES, stream, a);
#endif
#else
    for (int ph = 0; ph < PH_COUNT; ++ph) {
        a.ph_lo = ph; a.ph_hi = ph + 1;
        hipLaunchKernelGGL(mk_fwd, dim3(grid), dim3(512), LDS_BYTES, stream, a);
    }
#endif
}
```

```cpp
#include <hip/hip_runtime.h>
#include <hip/hip_cooperative_groups.h>
#include <cstdio>
#include <cstdint>
namespace cg = cooperative_groups;

#define DEVI __device__ __forceinline__
#define LAS __attribute__((address_space(3)))
typedef unsigned short bf16;
typedef unsigned v4u __attribute__((ext_vector_type(4)));
typedef unsigned v2u __attribute__((ext_vector_type(2)));
typedef float f32x4 __attribute__((ext_vector_type(4)));
typedef float f32x2 __attribute__((ext_vector_type(2)));
typedef short bf16x8 __attribute__((ext_vector_type(8)));
typedef float f32x16 __attribute__((ext_vector_type(16)));
typedef int i32x4 __attribute__((ext_vector_type(4)));

constexpr int D = 1024, BATCH = 16, SEQ = 4096, T = BATCH * SEQ;
constexpr int S5W = 512, S5H = 16, S5G = 32, S5P = 64;
constexpr int HW = 512, HD = 128, HH = 4;
constexpr int PH = 8, PK = 16, PNK = 128, PNE = 16384;
constexpr int INC = 4608;
constexpr float ALPHA = 1.189207115002721f;
constexpr float LN_EPS = 1e-5f, RMS_EPS = 1e-6f;
constexpr int NCH = 64;
constexpr int UK = 1152;

constexpr size_t MiB = 1u << 20;
constexpr size_t WS_XB = 0;
constexpr size_t WS_Y2 = 0;
constexpr size_t WS_YAB = 64 * MiB;
constexpr size_t WS_X1B = 0;
constexpr size_t WS_U5 = 128 * MiB;
constexpr size_t WS_IDS = 128 * MiB;
constexpr size_t WS_GATES = 160 * MiB;
constexpr size_t WS_Q = 200 * MiB;
constexpr size_t WS_LF = 264 * MiB;
constexpr size_t WS_MG = 264 * MiB;
constexpr size_t WS_VV = 392 * MiB;
constexpr size_t WS_GS = 456 * MiB;
constexpr size_t WS_GA = 520 * MiB;
constexpr size_t WS_GB = 648 * MiB;
constexpr size_t WS_H1 = 392 * MiB;
constexpr size_t WS_SC = 264 * MiB;
constexpr size_t WS_PD = 264 * MiB;
constexpr size_t WS_OP = 264 * MiB;
constexpr size_t WS_CF = 520 * MiB;
constexpr size_t WS_WINT = 776 * MiB;
constexpr size_t WS_WGLUT = 785 * MiB;
constexpr size_t WS_WPAT = 786 * MiB;
constexpr size_t WS_WOT = 788 * MiB;
constexpr size_t WS_WFT = 790 * MiB;
constexpr size_t WS_WZ = 794 * MiB;
constexpr size_t WS_TY = 810 * MiB;
constexpr size_t WS_PU = 882 * MiB;
constexpr size_t WS_PV = 914 * MiB;
constexpr size_t WS_Z = 946 * MiB;
constexpr size_t WS_L64 = 962 * MiB;
constexpr size_t WS_HGS = 963 * MiB;
constexpr size_t WS_HGD = 979 * MiB;
constexpr size_t WS_US = 979 * MiB + 256 * 1024;
constexpr size_t WS_XS = 979 * MiB + 512 * 1024;
constexpr size_t WS_XSC = 979 * MiB + 768 * 1024;
constexpr size_t WS_WSC = 962 * MiB + 32 * 1024;
constexpr size_t WS_WFS = 962 * MiB + 64 * 1024;
constexpr size_t WS_X1Q = 192 * MiB;
constexpr size_t WS_CTL = 980 * MiB;
constexpr size_t WS_END = 981 * MiB;

#ifndef PEER_FP8
#define PEER_FP8 1
#endif
constexpr float PU_SCALE = 256.0f, PV_SCALE = 16.0f;
#ifndef SCORES_INT8
#define SCORES_INT8 0
#endif
#ifndef PROJ_INT8
#define PROJ_INT8 1
#endif
#ifndef PEER_U_INT8
#define PEER_U_INT8 1
#endif
constexpr int CTL_WORDS = 8192;
constexpr int CW_GU = 4096, CW_GV = 4096 + 64 * 8;
constexpr int LDS_BYTES = 147456;

DEVI unsigned f2bf(float f) { return (unsigned)__builtin_bit_cast(unsigned short, (__bf16)f); }
typedef __bf16 bf16x2_t __attribute__((ext_vector_type(2)));
DEVI unsigned pk2(float lo, float hi) { const f32x2 v = {lo, hi}; return __builtin_bit_cast(unsigned, __builtin_convertvector(v, bf16x2_t)); }
typedef _Float16 h16x2 __attribute__((ext_vector_type(2)));
DEVI unsigned pkh2(float a, float b) { const f32x2 v = {a, b}; return __builtin_bit_cast(unsigned, __builtin_convertvector(v, h16x2)); }
DEVI float h2f(unsigned short b) { return (float)__builtin_bit_cast(_Float16, b); }
DEVI float bflo(unsigned w) { return __uint_as_float(w << 16); }
DEVI float bfhi(unsigned w) { return __uint_as_float(w & 0xffff0000u); }
DEVI float bf2f(bf16 b) { return __uint_as_float(((unsigned)b) << 16); }
DEVI float sigm(float x) { return __builtin_amdgcn_rcpf(1.0f + __builtin_amdgcn_exp2f(-1.4426950408889634f * x)); }
DEVI float silu(float x) { return x * sigm(x); }
DEVI float gelu_t(float x) { return x * sigm(1.5957691216057308f * (x + 0.044715f * x * x * x)); }
DEVI float wave_sum(float v) {
#pragma unroll
    for (int o = 1; o < 64; o <<= 1) v += __shfl_xor(v, o);
    return v;
}
DEVI float wave_max(float v) {
#pragma unroll
    for (int o = 1; o < 64; o <<= 1) v = fmaxf(v, __shfl_xor(v, o));
    return v;
}

struct Args { const float* in[25]; float* out; unsigned char* ws; int ph_lo, ph_hi; };

#define XB_TMO      128
#define XB_XCNT(j)  (256  + 64 * (j))
#define XB_XSUB(j)  (1280 + 64 * (j))
#define XB_XGEN(j)  (2304 + 64 * (j))
#define XB_TOP      3328
#define XB_TOPGEN   3392
#define XCD_BAR_WORDS 3456
#define XB_SPIN_CAP (1u << 20)

__device__ __forceinline__ unsigned xb_ld(unsigned* p)              { return __hip_atomic_load(p, __ATOMIC_RELAXED, __HIP_MEMORY_SCOPE_AGENT); }
__device__ __forceinline__ unsigned xb_add(unsigned* p, unsigned v) { return __hip_atomic_fetch_add(p, v, __ATOMIC_RELAXED, __HIP_MEMORY_SCOPE_AGENT); }
__device__ __forceinline__ unsigned xb_xcc_id() { return (unsigned)__builtin_amdgcn_s_getreg((3 << 11) | 20) & 0xFu; }
#define XB_SPIN(cond, bar) do { unsigned _sp = 0; while (cond) { __builtin_amdgcn_s_sleep(1); \
    if ((++_sp & 255u) == 0u) { if (xb_ld(&(bar)[XB_TMO])) break; if (_sp > XB_SPIN_CAP) { atomicAdd(&(bar)[XB_TMO], 1u); break; } } } } while (0)

struct XcdBarrier {
    unsigned* bar; unsigned x;
    volatile LAS unsigned* st;
};

__device__ __forceinline__ XcdBarrier xcd_barrier_post(unsigned* bar, volatile LAS unsigned* st) {
    XcdBarrier b; b.bar = bar; b.x = xb_xcc_id(); b.st = st;
    if (threadIdx.x == 0) (void)xb_add(&bar[XB_XCNT(b.x)], 1u);
    return b;
}
__device__ __forceinline__ void xcd_barrier_complete(unsigned* bar, unsigned x, unsigned& nloc, unsigned& nx) {
    const unsigned G = gridDim.x * gridDim.y * gridDim.z;
    unsigned sum, cnt, mine, sp = 0u;
    for (;;) {
        sum = 0u; cnt = 0u; mine = 0u;
#pragma unroll
        for (unsigned j = 0; j < 16; ++j) { const unsigned c = xb_ld(&bar[XB_XCNT(j)]); sum += c; cnt += (c > 0u) ? 1u : 0u; mine = (j == x) ? c : mine; }
        if (sum == G) break;
        __builtin_amdgcn_s_sleep(1);
        if ((++sp & 255u) == 0u) { if (xb_ld(&bar[XB_TMO])) break; if (sp > XB_SPIN_CAP) { atomicAdd(&bar[XB_TMO], 1u); break; } }
    }
    nloc = mine > 0u ? mine : 1u; nx = cnt > 0u ? cnt : 1u;
}

__device__ __forceinline__ void xcd_barrier(const XcdBarrier& b) {
    asm volatile("s_waitcnt vmcnt(0)" ::: "memory");
    __syncthreads();
    if (threadIdx.x == 0) {
        unsigned* bar = b.bar;
        __builtin_amdgcn_s_waitcnt(0);
        unsigned nloc = b.st[0], nx = b.st[1];
        if (nloc == 0u) { xcd_barrier_complete(bar, b.x, nloc, nx); b.st[0] = nloc; b.st[1] = nx; }
        const unsigned old = xb_add(&bar[XB_XSUB(b.x)], 1u);
        const unsigned gen = old / nloc;
        if (old + 1u == (gen + 1u) * nloc) {
            __builtin_amdgcn_fence(__ATOMIC_RELEASE, "agent");
            asm volatile("s_waitcnt vmcnt(0)" ::: "memory");
            const unsigned og = xb_add(&bar[XB_TOP], 1u);
            const unsigned tg = og / nx;
            if (og + 1u == (tg + 1u) * nx) xb_add(&bar[XB_TOPGEN], 1u);
            else XB_SPIN(xb_ld(&bar[XB_TOPGEN]) == tg, bar);
            __builtin_amdgcn_fence(__ATOMIC_ACQUIRE, "agent");
            xb_add(&bar[XB_XGEN(b.x)], 1u);
            asm volatile("s_waitcnt vmcnt(0)" ::: "memory");
        } else {
            XB_SPIN(xb_ld(&bar[XB_XGEN(b.x)]) == gen, bar);
            __builtin_amdgcn_fence(__ATOMIC_ACQUIRE, "agent");
            asm volatile("s_waitcnt vmcnt(0)" ::: "memory");
        }
    }
    __syncthreads();
}


namespace pg8 {
#ifdef PROBE_EPI_TIME
__device__ unsigned long long pg8_probe_dummy;
#endif
#define PG8_LAS __attribute__((address_space(3)))
typedef unsigned short bf16_t;
constexpr int BM = 256, BK = 64, HALF = 128, HTB = HALF * BK * 2  , STAGE_BYTES = 8 * HTB, NXCD = 8, WGM = 8;

__host__ __device__ __forceinline__ int lds_byte(int r, int c) { const int st = (r >> 4) * 2 + (c >> 5), rr = r & 15, cc = c & 31, ob = rr * 64 + cc * 2; return st * 1024 + (ob ^ (((ob >> 9) & 1) << 5)); }
__host__ __device__ __forceinline__ void stage_rc(int b, int& R, int& C) { const int st = b / 1024, sb = b % 1024, swz = sb ^ (((sb >> 9) & 1) << 5); R = (st >> 1) * 16 + swz / 64; C = (st & 1) * 32 + (swz % 64) / 2; }
__host__ __device__ __forceinline__ int perm32(int rho) { const int n = rho >> 4, i = rho & 15; return 8 * (i >> 2) + 4 * n + (i & 3); }

struct Unit { int pm, pn, z; };
struct Gemm { const bf16_t* A; const bf16_t* Bt; int M, N, K, lda, ldb; size_t sA, sB; int nz; };

struct StaticOrder {
    int nM, nN, nwg, G, c, nz;
    __host__ __device__ void init(int M, int N, int G_, int c_, int nz_ = 1) { nM = M / BM; nN = N / BM; nwg = nM * nN; G = G_; c = c_; nz = nz_; }
    __host__ __device__ bool next(int i, Unit& u) const {
        const long L0 = (long)i * G + c; if (L0 >= (long)nwg * nz) return false;
        u.z = (int)(L0 / nwg); int wgid = (int)(L0 % nwg); { const int q = nwg / NXCD, r = nwg % NXCD, xcd = wgid % NXCD, off = wgid / NXCD; wgid = (xcd < r ? xcd * (q + 1) : r * (q + 1) + (xcd - r) * q) + off; }
        const int nig = WGM * nN, gid = wgid / nig, fm = gid * WGM, gsz = (nM - fm) < WGM ? (nM - fm) : WGM;
        u.pm = fm + ((wgid % nig) % gsz); u.pn = (wgid % nig) / gsz; return true;
    }
    __device__ __forceinline__ void a_ready(const Unit&) const {}
    __device__ __forceinline__ void done(const Unit&) const {}
};

struct ChainOrder : StaticOrder {
    __host__ __device__ bool next(int i, Unit& u) const { if (!StaticOrder::next(i >> 1, u)) return false; u.z = i & 1; return true; }
};
__device__ __forceinline__ unsigned cvt_pk_bf16(float lo, float hi) { unsigned r; asm volatile("v_cvt_pk_bf16_f32 %0, %1, %2" : "=v"(r) : "v"(lo), "v"(hi)); return r; }

__device__ __forceinline__ f32x4 pg8_mma(const bf16x8& b, const bf16x8& a, const f32x4& c) { return __builtin_amdgcn_mfma_f32_16x16x32_bf16(b, a, c, 0, 0, 0); }
__device__ __forceinline__ i32x4 pg8_mma(const bf16x8& b, const bf16x8& a, const i32x4& c) { return __builtin_amdgcn_mfma_i32_16x16x64_i8(__builtin_bit_cast(i32x4, b), __builtin_bit_cast(i32x4, a), c, 0, 0, 0); }
template <class Epi, class Sched, bool ALIGN_EPI = false, bool SP2 = false>
__device__ __forceinline__ void gemm_phase(PG8_LAS unsigned char* lds, const Gemm g, const Sched& S, const Epi& E) {
    const int tid = threadIdx.x, wid = __builtin_amdgcn_readfirstlane(tid >> 6), lane = tid & 63, wr = wid >> 2, wc = wid & 3, fr = lane & 15, fq = lane >> 4;
    const int K = g.K, nt = K / BK;
    unsigned voffA[2], voffB[2];
#pragma unroll
    for (int i = 0; i < 2; ++i) { int R, C; stage_rc(tid * 16 + i * 8192, R, C); const int Rb = Epi::PERM ? ((R & ~31) + perm32(R & 31)) : R;
        voffA[i] = (unsigned)(R * g.lda + C) * 2u; voffB[i] = (unsigned)(Rb * g.ldb + C) * 2u; }
    const size_t kstep = (size_t)(BK * 2);
    const size_t hstepA = (size_t)HALF * g.lda * 2, hstepB = (size_t)HALF * g.ldb * 2;
    const size_t tstepA = 2 * hstepA, tstepB = 2 * hstepB;
    const unsigned ldsw = (unsigned)wid * 1024u;
    const int aoff = lds_byte(wr * 64 + fr, fq * 8), boff = lds_byte(wc * 32 + fr, fq * 8);
#define PG8_SA(b, h) (((b) * 2 + (h)) * HTB)
#define PG8_SB(b, h) ((4 + (b) * 2 + (h)) * HTB)
#define PG8_STAGE(bufoff, gbase, voff) do { _Pragma("unroll") for (int _i = 0; _i < 2; ++_i) \
        __builtin_amdgcn_global_load_lds((const unsigned*)((const char*)(gbase) + (voff)[_i]), (PG8_LAS unsigned*)(lds + (bufoff) + ldsw + _i * 8192), 16, 0, 0); } while (0)
#define PG8_LDA(dst, b, h) do { _Pragma("unroll") for (int m = 0; m < 4; ++m) _Pragma("unroll") for (int k = 0; k < 2; ++k) dst[m][k] = *(const PG8_LAS bf16x8*)(lds + PG8_SA(b, h) + aoff + m * 2048 + k * 1024); } while (0)
#define PG8_LDB(dst, b, h) do { _Pragma("unroll") for (int n = 0; n < 2; ++n) _Pragma("unroll") for (int k = 0; k < 2; ++k) dst[n][k] = *(const PG8_LAS bf16x8*)(lds + PG8_SB(b, h) + boff + n * 2048 + k * 1024); } while (0)
#define PG8_MMA(ai, bj, At, Bt) do { __builtin_amdgcn_s_setprio(1); _Pragma("unroll") for (int m = 0; m < 4; ++m) _Pragma("unroll") for (int n = 0; n < 2; ++n) _Pragma("unroll") for (int k = 0; k < 2; ++k) \
        acc[ai][bj][m][n] = pg8_mma(Bt[n][k], At[m][k], acc[ai][bj][m][n]); __builtin_amdgcn_s_setprio(0); } while (0)
#define PG8_WAIT_V(n) asm volatile("s_waitcnt vmcnt(" #n ")" ::: "memory")
#define PG8_WAIT_L(n) asm volatile("s_waitcnt lgkmcnt(" #n ")" ::: "memory")
#define PG8_BAR __builtin_amdgcn_s_barrier()
#define PG8_SCHED __builtin_amdgcn_sched_barrier(0)
#if defined(PROBE_EPI_TIME) || defined(PROBE_KLOOP_TIME)
    unsigned long long pg8_probe_acc = 0;
#endif
    Unit cur, nxt; int ui = 0;
    if (!S.next(0, cur)) return;
    typedef typename Epi::acc_t acc_t;
    acc_t acc[2][2][4][2];
#pragma unroll
    for (int a = 0; a < 2; ++a)
#pragma unroll
        for (int b = 0; b < 2; ++b)
#pragma unroll
            for (int m = 0; m < 4; ++m)
#pragma unroll
                for (int n = 0; n < 2; ++n) acc[a][b][m][n] = (acc_t){0, 0, 0, 0};
    bf16x8 At[4][2], B0[2][2], B1[2][2];
    const char* cA = (const char*)(g.A + (size_t)cur.z * g.sA) + (size_t)cur.pm * tstepA; const char* cB = (const char*)(g.Bt + (size_t)cur.z * g.sB) + (size_t)cur.pn * tstepB;
    S.a_ready(cur);
    if constexpr (SP2) {
        PG8_STAGE(PG8_SB(0, 0), cB, voffB); PG8_STAGE(PG8_SB(0, 1), cB + hstepB, voffB); PG8_STAGE(PG8_SA(0, 0), cA, voffA); PG8_STAGE(PG8_SA(0, 1), cA + hstepA, voffA);
        if (wr == 1) PG8_BAR;
        PG8_WAIT_V(2); PG8_BAR;
        PG8_STAGE(PG8_SB(1, 0), cB + kstep, voffB); PG8_STAGE(PG8_SA(1, 0), cA + kstep, voffA); PG8_STAGE(PG8_SB(1, 1), cB + hstepB + kstep, voffB);
        PG8_WAIT_V(6); PG8_BAR;
    } else {
        PG8_STAGE(PG8_SB(0, 0), cB, voffB); PG8_STAGE(PG8_SA(0, 0), cA, voffA); PG8_STAGE(PG8_SB(0, 1), cB + hstepB, voffB); PG8_STAGE(PG8_SA(0, 1), cA + hstepA, voffA);
        if (wr == 1) PG8_BAR;
        PG8_WAIT_V(4); PG8_BAR;
        PG8_STAGE(PG8_SB(1, 0), cB + kstep, voffB); PG8_STAGE(PG8_SA(1, 0), cA + kstep, voffA); PG8_STAGE(PG8_SB(1, 1), cB + hstepB + kstep, voffB);
        PG8_WAIT_V(6); PG8_BAR;
    }
    for (;;) {
        const bool has_next = S.next(ui + 1, nxt);
        const char* nA = has_next ? (const char*)(g.A + (size_t)nxt.z * g.sA) + (size_t)nxt.pm * tstepA : cA; const char* nB = has_next ? (const char*)(g.Bt + (size_t)nxt.z * g.sB) + (size_t)nxt.pn * tstepB : cB;
#ifdef PROBE_KLOOP_TIME
        const unsigned long long kt0_ = __builtin_amdgcn_s_memrealtime();
#endif
        for (int t = 0; t < nt; t += 2) {
            const bool last = (t == nt - 2);
            const char* a1 = cA + (size_t)(t + 1) * kstep;
            const char* a2 = last ? nA : cA + (size_t)(t + 2) * kstep; const char* b2 = last ? nB : cB + (size_t)(t + 2) * kstep;
            const char* a3 = a2 + kstep; const char* b3 = b2 + kstep;
            if (last && has_next) S.a_ready(nxt);
            if constexpr (SP2) {
            PG8_LDB(B0, 0, 0); PG8_LDB(B1, 0, 1); PG8_SCHED; PG8_LDA(At, 0, 0); PG8_STAGE(PG8_SA(1, 1), a1 + hstepA, voffA);
            PG8_WAIT_V(8); PG8_WAIT_L(0); PG8_BAR; PG8_MMA(0, 0, At, B0); PG8_MMA(0, 1, At, B1); PG8_BAR; PG8_SCHED;
            PG8_LDA(At, 0, 1); PG8_STAGE(PG8_SB(0, 0), b2, voffB); PG8_STAGE(PG8_SB(0, 1), b2 + hstepB, voffB); PG8_STAGE(PG8_SA(0, 0), a2, voffA);
            PG8_WAIT_V(8); PG8_WAIT_L(0); PG8_BAR; PG8_MMA(1, 0, At, B0); PG8_MMA(1, 1, At, B1); PG8_BAR; PG8_SCHED;
            PG8_LDB(B0, 1, 0); PG8_LDB(B1, 1, 1); PG8_SCHED; PG8_LDA(At, 1, 0); PG8_STAGE(PG8_SA(0, 1), a2 + hstepA, voffA);
            PG8_WAIT_V(8); PG8_WAIT_L(0); PG8_BAR; PG8_MMA(0, 0, At, B0); PG8_MMA(0, 1, At, B1); PG8_BAR; PG8_SCHED;
            PG8_LDA(At, 1, 1); PG8_STAGE(PG8_SB(1, 0), b3, voffB); PG8_STAGE(PG8_SB(1, 1), b3 + hstepB, voffB); PG8_STAGE(PG8_SA(1, 0), a3, voffA);
            PG8_WAIT_V(8); PG8_WAIT_L(0); PG8_BAR; PG8_MMA(1, 0, At, B0); PG8_MMA(1, 1, At, B1); PG8_BAR; PG8_SCHED;
            } else {
            PG8_LDB(B0, 0, 0); PG8_SCHED; PG8_LDA(At, 0, 0); PG8_STAGE(PG8_SA(1, 1), a1 + hstepA, voffA);
            PG8_WAIT_L(8); PG8_BAR; PG8_WAIT_L(0); PG8_MMA(0, 0, At, B0); PG8_BAR; PG8_SCHED;
            PG8_LDB(B1, 0, 1); PG8_STAGE(PG8_SB(0, 0), b2, voffB);
            PG8_BAR; PG8_WAIT_L(0); PG8_MMA(0, 1, At, B1); PG8_BAR;
            PG8_LDA(At, 0, 1); PG8_STAGE(PG8_SA(0, 0), a2, voffA);
            PG8_BAR; PG8_WAIT_L(0); PG8_MMA(1, 0, At, B0); PG8_BAR; PG8_SCHED;
            PG8_STAGE(PG8_SB(0, 1), b2 + hstepB, voffB);
            PG8_WAIT_V(6); PG8_BAR; PG8_MMA(1, 1, At, B1); PG8_BAR;
            PG8_LDB(B0, 1, 0); PG8_SCHED; PG8_LDA(At, 1, 0); PG8_STAGE(PG8_SA(0, 1), a2 + hstepA, voffA);
            PG8_WAIT_L(8); PG8_BAR; PG8_WAIT_L(0); PG8_MMA(0, 0, At, B0); PG8_BAR; PG8_SCHED;
            PG8_LDB(B1, 1, 1); PG8_STAGE(PG8_SB(1, 0), b3, voffB);
            PG8_BAR; PG8_WAIT_L(0); PG8_MMA(0, 1, At, B1); PG8_BAR;
            PG8_LDA(At, 1, 1); PG8_STAGE(PG8_SA(1, 0), a3, voffA);
            PG8_BAR; PG8_WAIT_L(0); PG8_MMA(1, 0, At, B0); PG8_BAR; PG8_SCHED;
            PG8_STAGE(PG8_SB(1, 1), b3 + hstepB, voffB);
            PG8_WAIT_V(6); PG8_BAR; PG8_MMA(1, 1, At, B1); PG8_BAR;
            }
        }
#ifdef PROBE_KLOOP_TIME
        pg8_probe_acc += __builtin_amdgcn_s_memrealtime() - kt0_;
#endif
        if constexpr (ALIGN_EPI) { if (wr == 0) PG8_BAR; }
#ifdef PROBE_EPI_TIME
        const unsigned long long pt0_ = __builtin_amdgcn_s_memrealtime();
#endif
        if constexpr (!Epi::AFTER_DRAIN) { E(acc, cur, wr, wc, fr, fq); S.done(cur); }
#ifdef PROBE_EPI_TIME
        asm volatile("s_waitcnt vmcnt(0)" ::: "memory");
        pg8_probe_acc += __builtin_amdgcn_s_memrealtime() - pt0_;
#endif
        if (!has_next) break;
        if (!Epi::CHAIN || nxt.z == 0) {
#pragma unroll
        for (int a = 0; a < 2; ++a)
#pragma unroll
            for (int b = 0; b < 2; ++b)
#pragma unroll
                for (int m = 0; m < 4; ++m)
#pragma unroll
                    for (int n = 0; n < 2; ++n) acc[a][b][m][n] = (acc_t){0, 0, 0, 0};
        }
        cur = nxt; cA = nA; cB = nB; ++ui;
        if constexpr (ALIGN_EPI) { if (wr == 1) PG8_BAR; }
    }
    PG8_WAIT_V(0);
    if constexpr (!ALIGN_EPI) { if (wr == 0) PG8_BAR; }
    PG8_BAR;
    if constexpr (Epi::AFTER_DRAIN) { E.fused(acc, cur, wr, wc, fr, fq, lds, wid, lane); S.done(cur); }
#ifdef PROBE_KLOOP_TIME
    if (blockIdx.x == 0 && Epi::PROBE_ME) { const unsigned long long t0_ = __builtin_amdgcn_s_memrealtime(); while (__builtin_amdgcn_s_memrealtime() - t0_ < PROBE_KLOOP_TIME * pg8_probe_acc) __builtin_amdgcn_s_sleep(8); }
#endif
#ifdef PROBE_EPI_TIME
    if (blockIdx.x == 0 && Epi::PROBE_ME) { const unsigned long long t0_ = __builtin_amdgcn_s_memrealtime(); while (__builtin_amdgcn_s_memrealtime() - t0_ < PROBE_EPI_TIME * pg8_probe_acc) __builtin_amdgcn_s_sleep(8); }
#endif
#undef PG8_SA
#undef PG8_SB
#undef PG8_STAGE
#undef PG8_LDA
#undef PG8_LDB
#undef PG8_MMA
#undef PG8_WAIT_V
#undef PG8_WAIT_L
#undef PG8_BAR
#undef PG8_SCHED
}
}

typedef f32x4 AccT[2][2][4][2];
DEVI v4u pack8(const f32x4& a, const f32x4& b) { v4u w; w.x = pk2(a[0], a[1]); w.y = pk2(a[2], a[3]); w.z = pk2(b[0], b[1]); w.w = pk2(b[2], b[3]); return w; }
DEVI void unpack8(const v4u& w, float (&f)[8]) { f[0] = bflo(w.x); f[1] = bfhi(w.x); f[2] = bflo(w.y); f[3] = bfhi(w.y); f[4] = bflo(w.z); f[5] = bfhi(w.z); f[6] = bflo(w.w); f[7] = bfhi(w.w); }

#ifndef PROBE_PROJ
#define PROBE_PROJ false
#endif
struct EpiProj {
    static constexpr bool PERM = true, AFTER_DRAIN = false, CHAIN = false, PROBE_ME = PROBE_PROJ;
#if PROJ_INT8
    typedef i32x4 acc_t;
#else
    typedef f32x4 acc_t;
#endif
    typedef acc_t AccP[2][2][4][2];
    unsigned char* ws; const float* lb_logits;
    template <int TYPE> DEVI void run(const AccP& acc, const pg8::Unit& u, int wr, int wc, int fr, int fq) const {
        const int row0 = u.pm * 256 + wr * 64 + fr;
#if PROJ_INT8
        float xsc[2][4];
#pragma unroll
        for (int ai = 0; ai < 2; ++ai)
#pragma unroll
            for (int m = 0; m < 4; ++m) xsc[ai][m] = ((const float*)(ws + WS_XSC))[row0 + ai * 128 + m * 16];
#endif
#pragma unroll
        for (int bj = 0; bj < 2; ++bj) {
            const int col = u.pn * 256 + bj * 128 + wc * 32 + 8 * fq;
#if PROJ_INT8
            float wsc[8];
            { const f32x4 w0 = *(const f32x4*)((const float*)(ws + WS_WSC) + col), w1 = *(const f32x4*)((const float*)(ws + WS_WSC) + col + 4);
#pragma unroll
              for (int j = 0; j < 4; ++j) { wsc[j] = w0[j]; wsc[4 + j] = w1[j]; } }
#endif
            float lb[8];
            if (TYPE == 2) {
#pragma unroll
                for (int j = 0; j < 8; ++j) { const int fc = col - 1024 + j; lb[j] = 1.0f / (1.0f + __expf(lb_logits[512 + fc] - lb_logits[fc])); }
            }
#pragma unroll
            for (int ai = 0; ai < 2; ++ai)
#pragma unroll
                for (int m = 0; m < 4; ++m) {
                    const int row = row0 + ai * 128 + m * 16;
#if PROJ_INT8
                    f32x4 v0, v1;
#pragma unroll
                    for (int j = 0; j < 4; ++j) { v0[j] = (float)acc[ai][bj][m][0][j] * xsc[ai][m] * wsc[j]; v1[j] = (float)acc[ai][bj][m][1][j] * xsc[ai][m] * wsc[4 + j]; }
#else
                    f32x4 v0 = acc[ai][bj][m][0], v1 = acc[ai][bj][m][1];
#endif
                    if (TYPE == 0) {
                        const int g = col >> 4, h0 = col & 15, b = row >> 12, t = row & 4095, c = t >> 6, j = t & 63;
                        bf16* p = (bf16*)(ws + WS_U5) + ((size_t)(g * 1024 + b * 64 + c) * UK + j * 16 + h0);
                        *(v4u*)p = pack8(v0, v1);
                    } else if (TYPE == 1 || TYPE == 4) {
#pragma unroll
                        for (int j = 0; j < 4; ++j) { v0[j] = silu(v0[j]); v1[j] = silu(v1[j]); }
                        if (TYPE == 1) *(v4u*)((bf16*)(ws + WS_Q) + (size_t)row * 512 + (col - 512)) = pack8(v0, v1);
                        else           *(v4u*)((bf16*)(ws + WS_GS) + (size_t)row * 512 + (col - 2048)) = pack8(v0, v1);
                    } else if (TYPE == 2) {
#pragma unroll
                        for (int j = 0; j < 4; ++j) { v0[j] = __logf(lb[j] + (1.0f - lb[j]) * sigm(v0[j])); v1[j] = __logf(lb[4 + j] + (1.0f - lb[4 + j]) * sigm(v1[j])); }
                        float* p = (float*)(ws + WS_LF) + (size_t)row * 512 + (col - 1024);
                        *(f32x4*)p = v0; *(f32x4*)(p + 4) = v1;
                    } else if (TYPE == 3) {
                        *(v4u*)((bf16*)(ws + WS_VV) + (size_t)row * 512 + (col - 1536)) = pack8(v0, v1);
                    } else {
#pragma unroll
                        for (int j = 0; j < 4; ++j) { v0[j] = sigm(v0[j]); v1[j] = sigm(v1[j]); }
                        if (TYPE == 5) *(v4u*)((bf16*)(ws + WS_GA) + (size_t)row * 1024 + (col - 2560)) = pack8(v0, v1);
                        else           *(v4u*)((bf16*)(ws + WS_GB) + (size_t)row * 1024 + (col - 3584)) = pack8(v0, v1);
                    }
                }
        }
    }
    DEVI void operator()(const AccP& acc, const pg8::Unit& u, int wr, int wc, int fr, int fq) const {
        const int pn = u.pn;
        if (pn < 2) run<0>(acc, u, wr, wc, fr, fq);
        else if (pn < 4) run<1>(acc, u, wr, wc, fr, fq);
        else if (pn < 6) run<2>(acc, u, wr, wc, fr, fq);
        else if (pn < 8) run<3>(acc, u, wr, wc, fr, fq);
        else if (pn < 10) run<4>(acc, u, wr, wc, fr, fq);
        else if (pn < 14) run<5>(acc, u, wr, wc, fr, fq);
        else run<6>(acc, u, wr, wc, fr, fq);
    }
};

struct EpiGlu {
    static constexpr bool PERM = true, AFTER_DRAIN = false, CHAIN = false, PROBE_ME = false; typedef f32x4 acc_t;
    unsigned char* ws; const float* bias;
    DEVI void operator()(const AccT& acc, const pg8::Unit& u, int wr, int wc, int fr, int fq) const {
        const int row0 = u.pm * 256 + wr * 64 + fr;
#pragma unroll
        for (int bj = 0; bj < 2; ++bj) {
            const int col = u.pn * 256 + bj * 128 + wc * 32 + 8 * fq;
            const f32x4 b0 = *(const f32x4*)(bias + col), b1 = *(const f32x4*)(bias + col + 4);
            v4u yw[2][4];
#pragma unroll
            for (int ai = 0; ai < 2; ++ai)
#pragma unroll
                for (int m = 0; m < 4; ++m) yw[ai][m] = *(const v4u*)((const bf16*)(ws + WS_Y2) + (size_t)(row0 + ai * 128 + m * 16) * 512 + col);
            __builtin_amdgcn_sched_barrier(0);
#pragma unroll
            for (int ai = 0; ai < 2; ++ai)
#pragma unroll
                for (int m = 0; m < 4; ++m) {
                    const int row = row0 + ai * 128 + m * 16;
                    float y[8]; unpack8(yw[ai][m], y);
                    f32x4 v0 = acc[ai][bj][m][0] + b0, v1 = acc[ai][bj][m][1] + b1;
#pragma unroll
                    for (int j = 0; j < 4; ++j) { v0[j] = y[j] * sigm(v0[j]); v1[j] = y[4 + j] * sigm(v1[j]); }
                    *(v4u*)((bf16*)(ws + WS_YAB) + (size_t)row * 1024 + col) = pack8(v0, v1);
                }
            __builtin_amdgcn_sched_barrier(0);
        }
    }
};

struct EpiMerge {
    static constexpr bool PERM = true, AFTER_DRAIN = false, CHAIN = true, PROBE_ME = false; typedef f32x4 acc_t;
    unsigned char* ws;
    DEVI void operator()(AccT& acc, const pg8::Unit& u, int wr, int wc, int fr, int fq) const {
        const int row0 = u.pm * 256 + wr * 64 + fr;
#pragma unroll
        for (int bj = 0; bj < 2; ++bj) {
            const int col = u.pn * 256 + bj * 128 + wc * 32 + 8 * fq;
#pragma unroll
            for (int ai = 0; ai < 2; ++ai) {
                v4u bw[4], aw[4];
#pragma unroll
                for (int m = 0; m < 4; ++m) { const size_t off = (size_t)(row0 + ai * 128 + m * 16) * 1024 + col;
                    bw[m] = *(const v4u*)((const bf16*)(ws + WS_GB) + off);
                    if (u.z == 0) aw[m] = *(const v4u*)((const bf16*)(ws + WS_GA) + off); }
                __builtin_amdgcn_sched_barrier(0);
#pragma unroll
                for (int m = 0; m < 4; ++m) {
                    const size_t off = (size_t)(row0 + ai * 128 + m * 16) * 1024 + col;
                    float gb[8]; unpack8(bw[m], gb);
                    if (u.z == 0) {
                        float ga[8]; unpack8(aw[m], ga);
#pragma unroll
                        for (int j = 0; j < 4; ++j) { acc[ai][bj][m][0][j] *= ga[j] * __builtin_amdgcn_rcpf(gb[j]); acc[ai][bj][m][1][j] *= ga[4 + j] * __builtin_amdgcn_rcpf(gb[4 + j]); }
                    } else {
                        f32x4 v0 = acc[ai][bj][m][0], v1 = acc[ai][bj][m][1];
#pragma unroll
                        for (int j = 0; j < 4; ++j) { v0[j] *= gb[j]; v1[j] *= gb[4 + j]; }
                        *(v4u*)((bf16*)(ws + WS_MG) + off) = pack8(v0, v1);
                    }
                }
                __builtin_amdgcn_sched_barrier(0);
            }
        }
    }
};

struct EpiOut {
    static constexpr bool PERM = true, AFTER_DRAIN = false, CHAIN = false, PROBE_ME = false; typedef f32x4 acc_t;
    unsigned char* ws; const float* x;
    DEVI void operator()(const AccT& acc, const pg8::Unit& u, int wr, int wc, int fr, int fq) const {
        const int row0 = u.pm * 256 + wr * 64 + fr;
#pragma unroll
        for (int bj = 0; bj < 2; ++bj) {
            const int col = u.pn * 256 + bj * 128 + wc * 32 + 8 * fq;
#pragma unroll
            for (int ai = 0; ai < 2; ++ai) {
                f32x4 xr[4][2];
#pragma unroll
                for (int m = 0; m < 4; ++m) { const size_t off = (size_t)(row0 + ai * 128 + m * 16) * 1024 + col; xr[m][0] = *(const f32x4*)(x + off); xr[m][1] = *(const f32x4*)(x + off + 4); }
                __builtin_amdgcn_sched_barrier(0);
#pragma unroll
                for (int m = 0; m < 4; ++m) {
                    float* p = (float*)(ws + WS_H1) + (size_t)(row0 + ai * 128 + m * 16) * 1024 + col;
                    *(f32x4*)p = acc[ai][bj][m][0] + ALPHA * xr[m][0]; *(f32x4*)(p + 4) = acc[ai][bj][m][1] + ALPHA * xr[m][1];
                }
                __builtin_amdgcn_sched_barrier(0);
            }
        }
    }
};

struct EpiScores {
    static constexpr bool PERM = true, AFTER_DRAIN = false, CHAIN = false, PROBE_ME = false;
#if SCORES_INT8
    typedef i32x4 acc_t;
#else
    typedef f32x4 acc_t;
#endif
    typedef acc_t AccS[2][2][4][2];
    unsigned char* ws;
    DEVI void operator()(const AccS& acc, const pg8::Unit& u, int wr, int wc, int fr, int fq) const {
        const int row0 = u.pm * 256 + wr * 64 + fr;
#if SCORES_INT8
        float xsc[2][4];
#pragma unroll
        for (int ai = 0; ai < 2; ++ai)
#pragma unroll
            for (int m = 0; m < 4; ++m) xsc[ai][m] = ((const float*)(ws + WS_XS))[row0 + ai * 128 + m * 16];
#endif
#pragma unroll
        for (int bj = 0; bj < 2; ++bj) {
            const int col = u.pn * 256 + bj * 128 + wc * 32 + 8 * fq;
#if SCORES_INT8
            float wsc[8];
            { const f32x4 w0 = *(const f32x4*)((const float*)(ws + WS_WFS) + col), w1 = *(const f32x4*)((const float*)(ws + WS_WFS) + col + 4);
#pragma unroll
              for (int j = 0; j < 4; ++j) { wsc[j] = w0[j]; wsc[4 + j] = w1[j]; } }
#endif
#pragma unroll
            for (int ai = 0; ai < 2; ++ai)
#pragma unroll
                for (int m = 0; m < 4; ++m) {
                    const int row = row0 + ai * 128 + m * 16;
#if SCORES_INT8
                    f32x4 v0, v1;
#pragma unroll
                    for (int j = 0; j < 4; ++j) { v0[j] = (float)acc[ai][bj][m][0][j] * xsc[ai][m] * wsc[j]; v1[j] = (float)acc[ai][bj][m][1][j] * xsc[ai][m] * wsc[4 + j]; }
#else
                    const f32x4 v0 = acc[ai][bj][m][0], v1 = acc[ai][bj][m][1];
#endif
                    v4u w; w.x = pkh2(v0[0], v0[1]); w.y = pkh2(v0[2], v0[3]); w.z = pkh2(v1[0], v1[1]); w.w = pkh2(v1[2], v1[3]);
                    *(v4u*)((unsigned short*)(ws + WS_SC) + (size_t)row * 2048 + col) = w;
                }
        }
    }
};

struct EpiS5Z {
    static constexpr bool PERM = true, AFTER_DRAIN = false, CHAIN = false, PROBE_ME = false; typedef f32x4 acc_t;
    unsigned char* ws;
    DEVI void operator()(const AccT& acc, const pg8::Unit& u, int wr, int wc, int fr, int fq) const {
        const int row0 = u.pm * 256 + wr * 64 + fr, col = wc * 32 + 8 * fq;
        float* Z = (float*)(ws + WS_Z) + (size_t)u.z * 1024 * 128;
#pragma unroll
        for (int ai = 0; ai < 2; ++ai)
#pragma unroll
            for (int m = 0; m < 4; ++m) {
                const int row = row0 + ai * 128 + m * 16;
                float* p = Z + (size_t)row * 128 + col;
                *(f32x4*)p = acc[ai][0][m][0]; *(f32x4*)(p + 4) = acc[ai][0][m][1];
            }
    }
};
struct EpiS5Y {
    static constexpr bool PERM = true, AFTER_DRAIN = false, CHAIN = false, PROBE_ME = false; typedef f32x4 acc_t;
    unsigned char* ws;
    DEVI void operator()(const AccT& acc, const pg8::Unit& u, int wr, int wc, int fr, int fq) const {
        const int row0 = u.pm * 256 + wr * 64 + fr;
        bf16* Y2 = (bf16*)(ws + WS_Y2);
#pragma unroll
        for (int bj = 0; bj < 2; ++bj) {
            const int n = u.pn * 256 + bj * 128 + wc * 32 + 8 * fq, i = n >> 4, h0 = n & 15;
#pragma unroll
            for (int ai = 0; ai < 2; ++ai)
#pragma unroll
                for (int m = 0; m < 4; ++m) {
                    const int r = row0 + ai * 128 + m * 16, b = r >> 6, c = r & 63;
                    f32x4 v0 = acc[ai][bj][m][0], v1 = acc[ai][bj][m][1];
#pragma unroll
                    for (int j = 0; j < 4; ++j) { v0[j] = gelu_t(v0[j]); v1[j] = gelu_t(v1[j]); }
                    *(v4u*)(Y2 + ((size_t)b * 4096 + c * 64 + i) * 512 + u.z * 16 + h0) = pack8(v0, v1);
                }
        }
    }
};

#define LDS_WAIT() asm volatile("s_waitcnt lgkmcnt(0)" ::: "memory")

DEVI void transpose_item(const float* W, int K, int N, bf16* WT, LAS float* scr, int item, int lane, int ldo = 0, int koff = 0) {
    if (ldo == 0) ldo = K;
    const int nblk = N / 32, kb = item / nblk, nb = item % nblk, k0 = 64 * kb, n0 = 32 * nb;
#pragma unroll 8
    for (int i = 0; i < 32; ++i) { const int kk = 2 * i + (lane >> 5); scr[kk * 33 + (lane & 31)] = W[(size_t)(k0 + kk) * N + n0 + (lane & 31)]; }
    LDS_WAIT();
    const int c = lane & 7;
#pragma unroll
    for (int j = 0; j < 4; ++j) { const int n = (lane >> 3) + 8 * j; const LAS float* s = scr + (8 * c) * 33 + n;
        v4u o; o.x = pk2(s[0 * 33], s[1 * 33]); o.y = pk2(s[2 * 33], s[3 * 33]); o.z = pk2(s[4 * 33], s[5 * 33]); o.w = pk2(s[6 * 33], s[7 * 33]);
        *(v4u*)(WT + (size_t)(n0 + n) * ldo + koff + k0 + 8 * c) = o; }
    LDS_WAIT();
}

DEVI void cvt_bf16_stream(const float* src, bf16* dst, size_t n8, size_t gtid, size_t gthreads) {
    for (size_t i = gtid; i < n8; i += gthreads) {
        const f32x4 a = *(const f32x4*)(src + i * 8), b = *(const f32x4*)(src + i * 8 + 4);
        *(v4u*)(dst + i * 8) = pack8(a, b);
    }
}

DEVI float clamp_fp8(float x) { return fminf(fmaxf(x, -448.0f), 448.0f); }
DEVI unsigned pk4_fp8(float a, float b, float c, float d) { a = clamp_fp8(a); b = clamp_fp8(b); c = clamp_fp8(c); d = clamp_fp8(d); int w = 0; w = __builtin_amdgcn_cvt_pk_fp8_f32(a, b, w, false); w = __builtin_amdgcn_cvt_pk_fp8_f32(c, d, w, true); return (unsigned)w; }
DEVI void cvt_fp8_stream(const float* src, unsigned char* dst, size_t n16, float scale, size_t gtid, size_t gthreads) {
    for (size_t i = gtid; i < n16; i += gthreads) {
        const f32x4 a = *(const f32x4*)(src + i * 16) * scale, b = *(const f32x4*)(src + i * 16 + 4) * scale, c = *(const f32x4*)(src + i * 16 + 8) * scale, d = *(const f32x4*)(src + i * 16 + 12) * scale;
        v4u o; o.x = pk4_fp8(a[0], a[1], a[2], a[3]); o.y = pk4_fp8(b[0], b[1], b[2], b[3]); o.z = pk4_fp8(c[0], c[1], c[2], c[3]); o.w = pk4_fp8(d[0], d[1], d[2], d[3]);
        *(v4u*)(dst + i * 16) = o;
    }
}

DEVI void cvt_fp8_sliced(const float* src, unsigned char* dst, float scale, size_t gtid, size_t gthreads) {
    for (size_t i = gtid; i < (size_t)PNE * D / 16; i += gthreads) {
        const size_t e = i >> 6; const int cg = (int)(i & 63), j = cg >> 3, within = (cg & 7) * 16;
        const f32x4 a = *(const f32x4*)(src + i * 16) * scale, b = *(const f32x4*)(src + i * 16 + 4) * scale, c = *(const f32x4*)(src + i * 16 + 8) * scale, d = *(const f32x4*)(src + i * 16 + 12) * scale;
        v4u o; o.x = pk4_fp8(a[0], a[1], a[2], a[3]); o.y = pk4_fp8(b[0], b[1], b[2], b[3]); o.z = pk4_fp8(c[0], c[1], c[2], c[3]); o.w = pk4_fp8(d[0], d[1], d[2], d[3]);
        *(v4u*)(dst + ((size_t)j * PNE + e) * 128 + within) = o;
    }
}

DEVI unsigned q4_i8(float a, float b, float c, float d) {
    const int ia = (int)rintf(a), ib = (int)rintf(b), ic = (int)rintf(c), id = (int)rintf(d);
    return (unsigned)(ia & 255) | ((unsigned)(ib & 255) << 8) | ((unsigned)(ic & 255) << 16) | ((unsigned)(id & 255) << 24);
}
DEVI void cvt_i8_rows(const float* src, unsigned char* dst, float* scales, int gw, int ngw, int lane) {
    for (int e0 = gw; e0 < PNE; e0 += 4 * ngw) {
        f32x4 v[4][4];
#pragma unroll
        for (int r = 0; r < 4; ++r) { const int er = (e0 + r * ngw < PNE) ? e0 + r * ngw : e0; const float* rp = src + (size_t)er * 1024 + lane * 16;
#pragma unroll
            for (int q = 0; q < 4; ++q) v[r][q] = *(const f32x4*)(rp + 4 * q); }
#pragma unroll
        for (int r = 0; r < 4; ++r) {
            const int e = e0 + r * ngw; if (e >= PNE) continue; float m = 0.f;
#pragma unroll
            for (int q = 0; q < 4; ++q) m = fmaxf(m, fmaxf(fmaxf(fabsf(v[r][q][0]), fabsf(v[r][q][1])), fmaxf(fabsf(v[r][q][2]), fabsf(v[r][q][3]))));
            m = wave_max(m); m = fmaxf(m, 1e-30f);
            const float inv = 127.0f / m;
            v4u o;
#pragma unroll
            for (int q = 0; q < 4; ++q) o[q] = q4_i8(v[r][q][0] * inv, v[r][q][1] * inv, v[r][q][2] * inv, v[r][q][3] * inv);
            *(v4u*)(dst + ((size_t)(lane >> 3) * PNE + e) * 128 + (lane & 7) * 16) = o;
            if (lane == 0) scales[e] = m * (1.0f / 127.0f);
        }
    }
}

DEVI void cvt_x_i8_rows(const float* src, unsigned char* dst, float* scales, int gw, int ngw, int lane) {
    for (int r0 = gw; r0 < T; r0 += 4 * ngw) {
        f32x4 v[4][4];
#pragma unroll
        for (int r = 0; r < 4; ++r) { const int rr = (r0 + r * ngw < T) ? r0 + r * ngw : r0; const float* rp = src + (size_t)rr * 1024 + lane * 16;
#pragma unroll
            for (int q = 0; q < 4; ++q) v[r][q] = *(const f32x4*)(rp + 4 * q); }
#pragma unroll
        for (int r = 0; r < 4; ++r) {
            const int row = r0 + r * ngw; if (row >= T) continue; float m = 0.f;
#pragma unroll
            for (int q = 0; q < 4; ++q) m = fmaxf(m, fmaxf(fmaxf(fabsf(v[r][q][0]), fabsf(v[r][q][1])), fmaxf(fabsf(v[r][q][2]), fabsf(v[r][q][3]))));
            m = fmaxf(wave_max(m), 1e-30f);
            const float inv = 127.0f / m;
            v4u o;
#pragma unroll
            for (int q = 0; q < 4; ++q) o[q] = q4_i8(v[r][q][0] * inv, v[r][q][1] * inv, v[r][q][2] * inv, v[r][q][3] * inv);
            *(v4u*)(dst + (size_t)row * 1024 + lane * 16) = o;
            if (lane == 0) scales[row] = m * (1.0f / 127.0f);
        }
    }
}
DEVI void win_i8_stripe(const float* W, unsigned char* WT8, float* wsc, LAS unsigned char* lds, int stripe, int wave, int lane) {
    LAS float* scr = (LAS float*)(lds + wave * 16384);
    LAS float* pm = (LAS float*)(lds + 131072);
    const int n0 = stripe * 32, c = lane & 31, hk = lane >> 5, kw = wave * 128;
    float m = 0.f;
#pragma unroll 8
    for (int k = hk; k < 128; k += 2) m = fmaxf(m, fabsf(W[(size_t)(kw + k) * INC + n0 + c]));
    m = fmaxf(m, __shfl_xor(m, 32));
    __syncthreads();
    if (lane < 32) pm[wave * 32 + c] = m;
    __syncthreads();
#pragma unroll
    for (int w = 0; w < 8; ++w) m = fmaxf(m, pm[w * 32 + c]);
    m = fmaxf(m, 1e-30f);
    const float inv = 127.0f / m;
    if (wave == 0 && lane < 32) wsc[n0 + c] = m * (1.0f / 127.0f);
    for (int kb = 0; kb < 2; ++kb) {
        const int k0 = kw + kb * 64;
#pragma unroll 8
        for (int i = 0; i < 32; ++i) { const int kk = 2 * i + hk; scr[kk * 33 + c] = W[(size_t)(k0 + kk) * INC + n0 + c] * inv; }
        LDS_WAIT();
        const int ch = lane & 3;
#pragma unroll
        for (int j = 0; j < 2; ++j) { const int n = (lane >> 2) + 16 * j; const LAS float* s = scr + (16 * ch) * 33 + n;
            v4u o;
#pragma unroll
            for (int q = 0; q < 4; ++q) o[q] = q4_i8(s[(4 * q) * 33], s[(4 * q + 1) * 33], s[(4 * q + 2) * 33], s[(4 * q + 3) * 33]);
            *(v4u*)(WT8 + (size_t)(n0 + n) * 1024 + k0 + 16 * ch) = o; }
        LDS_WAIT();
    }
}

DEVI void phase_prep(const Args& a, LAS unsigned char* lds) {
    const int tid = threadIdx.x, lane = tid & 63, wave = __builtin_amdgcn_readfirstlane(tid >> 6), G = gridDim.x;
    unsigned char* ws = a.ws;
    const size_t gtid = (size_t)blockIdx.x * 512 + tid, gthreads = (size_t)G * 512;
#if PROJ_INT8
    cvt_x_i8_rows(a.in[0], ws + WS_XB, (float*)(ws + WS_XSC), blockIdx.x * 8 + wave, G * 8, lane);
#else
    cvt_bf16_stream(a.in[0], (bf16*)(ws + WS_XB), (size_t)T * D / 8, gtid, gthreads);
#endif
#if PEER_FP8
#if PEER_U_INT8
    cvt_i8_rows(a.in[21], ws + WS_PU, (float*)(ws + WS_US), blockIdx.x * 8 + wave, G * 8, lane);
#else
    cvt_fp8_sliced(a.in[21], ws + WS_PU, PU_SCALE, gtid, gthreads);
#endif
    cvt_fp8_sliced(a.in[22], ws + WS_PV, PV_SCALE, gtid, gthreads);
#else
    cvt_bf16_stream(a.in[21], (bf16*)(ws + WS_PU), (size_t)PNE * D / 8, gtid, gthreads);
    cvt_bf16_stream(a.in[22], (bf16*)(ws + WS_PV), (size_t)PNE * D / 8, gtid, gthreads);
#endif
    {
        LAS float* scr = (LAS float*)(lds + wave * 16384);
        const int gw = blockIdx.x * 8 + wave, NGW = G * 8;
        constexpr int I_IN = (1024 / 64) * (INC / 32), I_GLU = (512 / 64) * (512 / 32), I_PA = (512 / 64) * (1024 / 32), I_O = (1024 / 64) * (1024 / 32);
        constexpr int NIT = I_IN + I_GLU + 2 * I_PA + I_O;
        for (int it = gw; it < NIT; it += NGW) {
            int r = it;
#if PROJ_INT8
            if (r < I_IN) continue; r -= I_IN;
#else
            if (r < I_IN) { transpose_item(a.in[1], 1024, INC, (bf16*)(ws + WS_WINT), scr, r, lane); continue; } r -= I_IN;
#endif
            if (r < I_GLU) { transpose_item(a.in[10], 512, 512, (bf16*)(ws + WS_WGLUT), scr, r, lane); continue; } r -= I_GLU;
            if (r < I_PA) { transpose_item(a.in[14], 512, 1024, (bf16*)(ws + WS_WPAT), scr, r, lane, 1024, 0); continue; } r -= I_PA;
            if (r < I_PA) { transpose_item(a.in[15], 512, 1024, (bf16*)(ws + WS_WPAT), scr, r, lane, 1024, 512); continue; } r -= I_PA;
            transpose_item(a.in[16], 1024, 1024, (bf16*)(ws + WS_WOT), scr, r, lane);
        }
    }
#if PROJ_INT8
    for (int st = blockIdx.x; st < INC / 32; st += G) win_i8_stripe(a.in[1], ws + WS_WINT, (float*)(ws + WS_WSC), lds, st, wave, lane);
#endif
    __syncthreads();
#if SCORES_INT8
    {
        LAS float* wq = (LAS float*)lds;
        LAS float* ky = wq + 32 * 132;
        LAS float* ob = ky + 16 * 132;
        const float* wpq = a.in[19]; const float* keys = a.in[20];
        const int n = tid & 15, kk = tid >> 4;
        for (int item = blockIdx.x; item < 16 * 8; item += G) {
            const int slot = item >> 3, nq = item & 7;
            __syncthreads();
            { const int nn = tid >> 5, d4 = (tid & 31) * 4; *(LAS f32x4*)(ky + nn * 132 + d4) = *(const f32x4*)(keys + ((size_t)(slot * 128 + nq * 16 + nn)) * 128 + d4); }
            for (int kt = 0; kt < 32; ++kt) {
                __syncthreads();
#pragma unroll
                for (int i = 0; i < 2; ++i) { const int idx = tid + 512 * i, k2 = idx >> 5, d4 = (idx & 31) * 4;
                    *(LAS f32x4*)(wq + k2 * 132 + d4) = *(const f32x4*)(wpq + (size_t)(kt * 32 + k2) * 2048 + slot * 128 + d4); }
                __syncthreads();
                float acc = 0.f;
#pragma unroll 8
                for (int d = 0; d < 128; d += 4) { const f32x4 kv = *(const LAS f32x4*)(ky + n * 132 + d), w = *(const LAS f32x4*)(wq + kk * 132 + d); acc += kv[0] * w[0] + kv[1] * w[1] + kv[2] * w[2] + kv[3] * w[3]; }
                ob[n * 1028 + kt * 32 + kk] = acc;
            }
            __syncthreads();
#pragma unroll
            for (int r = 0; r < 2; ++r) {
                const int nn = wave * 2 + r;
                f32x4 v[4]; float m = 0.f;
#pragma unroll
                for (int q = 0; q < 4; ++q) { v[q] = *(const LAS f32x4*)(ob + nn * 1028 + lane * 16 + 4 * q); m = fmaxf(m, fmaxf(fmaxf(fabsf(v[q][0]), fabsf(v[q][1])), fmaxf(fabsf(v[q][2]), fabsf(v[q][3])))); }
                m = fmaxf(wave_max(m), 1e-30f);
                const float inv = 127.0f / m;
                v4u o;
#pragma unroll
                for (int q = 0; q < 4; ++q) o[q] = q4_i8(v[q][0] * inv, v[q][1] * inv, v[q][2] * inv, v[q][3] * inv);
                const int nrow = slot * 128 + nq * 16 + nn;
                *(v4u*)(ws + WS_WFT + (size_t)nrow * 1024 + lane * 16) = o;
                if (lane == 0) ((float*)(ws + WS_WFS))[nrow] = m * (1.0f / 127.0f);
            }
        }
    }
#else
    {
        LAS float* wq = (LAS float*)lds;
        LAS float* ky = wq + 32 * 132;
        const float* wpq = a.in[19]; const float* keys = a.in[20];
        const int n = tid & 127, kh = __builtin_amdgcn_readfirstlane(tid >> 7);
        for (int item = blockIdx.x; item < 16 * 32; item += G) {
            const int slot = item >> 5, kt = item & 31;
            __syncthreads();
#pragma unroll
            for (int i = 0; i < 2; ++i) { const int idx = tid + 512 * i, kk = idx >> 5, d4 = (idx & 31) * 4;
                *(LAS f32x4*)(wq + kk * 132 + d4) = *(const f32x4*)(wpq + (size_t)(kt * 32 + kk) * 2048 + slot * 128 + d4); }
#pragma unroll
            for (int i = 0; i < 8; ++i) { const int idx = tid + 512 * i, nn = idx >> 5, d4 = (idx & 31) * 4;
                *(LAS f32x4*)(ky + nn * 132 + d4) = *(const f32x4*)(keys + ((size_t)(slot * 128 + nn)) * 128 + d4); }
            __syncthreads();
            float acc[8];
#pragma unroll
            for (int kk = 0; kk < 8; ++kk) acc[kk] = 0.f;
#pragma unroll 4
            for (int d = 0; d < 128; d += 4) {
                const f32x4 kv = *(const LAS f32x4*)(ky + n * 132 + d);
#pragma unroll
                for (int kk = 0; kk < 8; ++kk) { const f32x4 w = *(const LAS f32x4*)(wq + (kh * 8 + kk) * 132 + d); acc[kk] += kv[0] * w[0] + kv[1] * w[1] + kv[2] * w[2] + kv[3] * w[3]; }
            }
            v4u o; o.x = pk2(acc[0], acc[1]); o.y = pk2(acc[2], acc[3]); o.z = pk2(acc[4], acc[5]); o.w = pk2(acc[6], acc[7]);
            *(v4u*)((bf16*)(ws + WS_WFT) + (size_t)(slot * 128 + n) * 1024 + kt * 32 + kh * 8) = o;
        }
    }
#endif
}

DEVI void s5_tables_item(const Args& a, LAS unsigned char* lds, int item) {
    const int tid = threadIdx.x, g = item >> 3, part = item & 7;
    unsigned char* ws = a.ws;
    LAS float* pwr = (LAS float*)lds;
    LAS float* pwi = pwr + 65 * 64;
    LAS float* Bbr = pwi + 65 * 64;
    LAS float* Bbi = Bbr + 1024;
    LAS float* Cr = Bbi + 1024;
    LAS float* Ci = Cr + 1040;
    LAS float* Kt = Ci + 1040;
    __syncthreads();
    if (tid < 64) {
        const int p = tid;
        const float dt = __expf(a.in[9][g]);
        const float lr = a.in[2][g * 64 + p], li = a.in[3][g * 64 + p];
        const float er = __expf(lr * dt); float sn, cs; sincosf(li * dt, &sn, &cs);
        const float Lr = er * cs, Li = er * sn;
        const float ar = Lr - 1.0f, ai = Li, den = lr * lr + li * li;
        const float cr = (ar * lr + ai * li) / den, ci = (ai * lr - ar * li) / den;
#pragma unroll
        for (int h = 0; h < 16; ++h) { const float br = a.in[4][(g * 64 + p) * 16 + h], bi = a.in[5][(g * 64 + p) * 16 + h];
            Bbr[p * 16 + h] = cr * br - ci * bi; Bbi[p * 16 + h] = cr * bi + ci * br; }
        float xr = 1.0f, xi = 0.0f;
        for (int d = 0; d <= 64; ++d) { pwr[d * 64 + p] = xr; pwi[d * 64 + p] = xi; const float nr = xr * Lr - xi * Li, ni = xr * Li + xi * Lr; xr = nr; xi = ni; }
        if (part == 0) { float* l64 = (float*)(ws + WS_L64) + (g * 64 + p) * 2; l64[0] = pwr[64 * 64 + p]; l64[1] = pwi[64 * 64 + p]; }
    }
    for (int i = tid; i < 1024; i += 512) { Cr[(i >> 6) * 65 + (i & 63)] = a.in[6][g * 1024 + i]; Ci[(i >> 6) * 65 + (i & 63)] = a.in[7][g * 1024 + i]; }
    __syncthreads();
    for (int pr = tid; pr < 1024; pr += 512) {
        const int d = pr >> 4, hp = pr & 15;
        float acc[16];
#pragma unroll
        for (int h = 0; h < 16; ++h) acc[h] = 0.f;
        for (int p = 0; p < 64; ++p) {
            const float c_r = Cr[hp * 65 + p], c_i = Ci[hp * 65 + p], w_r = pwr[d * 64 + p], w_i = pwi[d * 64 + p];
            const float cpr = c_r * w_r - c_i * w_i, cpi = c_r * w_i + c_i * w_r;
#pragma unroll
            for (int h = 0; h < 16; ++h) acc[h] += cpr * Bbr[p * 16 + h] - cpi * Bbi[p * 16 + h];
        }
#pragma unroll
        for (int h = 0; h < 16; ++h) Kt[pr * 16 + h] = acc[h];
    }
    __syncthreads();
    bf16* TY = (bf16*)(ws + WS_TY) + (size_t)g * 1024 * UK;
    for (int e = tid; e < 128 * 128; e += 512) {
        const int n = part * 128 + (e >> 7), k0 = (e & 127) * 8, i = n >> 4, hp = n & 15, j = k0 >> 4, h0 = k0 & 15;
        float v[8];
#pragma unroll
        for (int q = 0; q < 8; ++q) v[q] = 0.f;
        if (j <= i) {
            const LAS float* kp = Kt + ((i - j) * 16 + hp) * 16 + h0;
#pragma unroll
            for (int q = 0; q < 8; ++q) v[q] = kp[q];
            if (j == i && hp >= h0 && hp < h0 + 8) v[hp - h0] += a.in[8][g * 16 + hp];
        }
        v4u o; o.x = pk2(v[0], v[1]); o.y = pk2(v[2], v[3]); o.z = pk2(v[4], v[5]); o.w = pk2(v[6], v[7]);
        *(v4u*)(TY + (size_t)n * UK + k0) = o;
    }
    for (int e = tid; e < 128 * 64; e += 512) {
        const int n = part * 128 + (e >> 6), p = e & 63, i = n >> 4, hp = n & 15;
        const float c_r = Cr[hp * 65 + p], c_i = Ci[hp * 65 + p], w_r = pwr[(i + 1) * 64 + p], w_i = pwi[(i + 1) * 64 + p];
        TY[(size_t)n * UK + 1024 + p] = (bf16)f2bf(c_r * w_r - c_i * w_i);
        TY[(size_t)n * UK + 1088 + p] = (bf16)f2bf(-(c_r * w_i + c_i * w_r));
    }
    bf16* WZ = (bf16*)(ws + WS_WZ) + (size_t)g * 256 * 1024;
    for (int e = tid; e < 32 * 128; e += 512) {
        const int n = part * 32 + (e >> 7), k0 = (e & 127) * 8, j = k0 >> 4, h0 = k0 & 15;
        float v[8];
#pragma unroll
        for (int q = 0; q < 8; ++q) v[q] = 0.f;
        if (n < 128) {
            const int p = n & 63; const float w_r = pwr[(63 - j) * 64 + p], w_i = pwi[(63 - j) * 64 + p];
#pragma unroll
            for (int q = 0; q < 8; ++q) { const float b_r = Bbr[p * 16 + h0 + q], b_i = Bbi[p * 16 + h0 + q]; v[q] = (n < 64) ? (w_r * b_r - w_i * b_i) : (w_r * b_i + w_i * b_r); }
        }
        v4u o; o.x = pk2(v[0], v[1]); o.y = pk2(v[2], v[3]); o.z = pk2(v[4], v[5]); o.w = pk2(v[6], v[7]);
        *(v4u*)(WZ + (size_t)n * 1024 + k0) = o;
    }
}

DEVI void s5_scan(const Args& a) {
    unsigned char* ws = a.ws;
    for (int id = blockIdx.x * 512 + threadIdx.x; id < S5G * BATCH * 64; id += gridDim.x * 512) {
        const int p = id & 63, b = (id >> 6) & 15, g = id >> 10;
        const float* l64 = (const float*)(ws + WS_L64) + (g * 64 + p) * 2; const float Lr = l64[0], Li = l64[1];
        const float* zp = (const float*)(ws + WS_Z) + (size_t)(g * 1024 + b * 64) * 128 + p;
        bf16* up = (bf16*)(ws + WS_U5) + (size_t)(g * 1024 + b * 64) * UK + 1024 + p;
        float xr = 0.f, xi = 0.f;
#pragma unroll 8
        for (int c = 0; c < 64; ++c) {
            const float zr = zp[(size_t)c * 128], zi = zp[(size_t)c * 128 + 64];
            up[(size_t)c * UK] = (bf16)f2bf(xr); up[(size_t)c * UK + 64] = (bf16)f2bf(xi);
            const float nr = Lr * xr - Li * xi + zr, ni = Lr * xi + Li * xr + zi; xr = nr; xi = ni;
        }
    }
}

constexpr int HG_QT = 0, HG_KT = 17408, HG_KHT = 34816, HG_VT = 53248, HG_SBT = 71680, HG_P = 106496, HG_EB = 115712, HG_TOT = 116224;
DEVI int crow(int j, int hh) { return (j & 3) + 8 * (j >> 2) + 4 * hh; }
DEVI bf16x8 ldfrag(const LAS unsigned char* base, int row, int pitch, int col) { return *(const LAS bf16x8*)(base + (row * pitch + col) * 2); }

template <bool FULL> DEVI void hgrn_segment(const Args& a, LAS unsigned char* lds, int item) {
    const int tid = threadIdx.x, lane = tid & 63, wave = __builtin_amdgcn_readfirstlane(tid >> 6);
    const int seg = item & 3, h = (item >> 2) & 3, b = item >> 4;
    unsigned char* ws = a.ws;
    const int kcol = tid & 127, qd = tid >> 7, r32 = lane & 31, hh = lane >> 5;
    const int ti = wave >> 2, vi = wave & 3, ski = wave & 3, sv0 = (wave >> 2) * 2;
    const float* LF = (const float*)(ws + WS_LF); const bf16* Q = (const bf16*)(ws + WS_Q); const bf16* VV = (const bf16*)(ws + WS_VV); const bf16* GS = (const bf16*)(ws + WS_GS);
    bf16* YB = (bf16*)(ws + WS_YAB) + 512;
    float* HGS = (float*)(ws + WS_HGS); float* HGD = (float*)(ws + WS_HGD);
    LAS unsigned char* QT = lds + HG_QT; LAS unsigned char* KT = lds + HG_KT; LAS unsigned char* KHT = lds + HG_KHT; LAS unsigned char* VT = lds + HG_VT;
    LAS unsigned char* SBT = lds + HG_SBT; LAS unsigned char* PB = lds + HG_P;
    LAS float* EB = (LAS float*)(lds + HG_EB); LAS float* TOT = (LAS float*)(lds + HG_TOT); LAS float* O = (LAS float*)(lds + HG_QT);
    f32x16 S0, S1;
#pragma unroll
    for (int j = 0; j < 16; ++j) { S0[j] = 0.f; S1[j] = 0.f; }
    float sumlog = 0.f;
    __syncthreads();
    if (FULL) {
        for (int s2 = 0; s2 < seg; ++s2) {
            const int it2 = (b * 4 + h) * 4 + s2;
            const float* dS = HGS + (size_t)it2 * 16384; const float* Dl = HGD + it2 * 128;
#pragma unroll
            for (int j = 0; j < 16; ++j) { const int k = ski * 32 + crow(j, hh); const float d = Dl[k];
                S0[j] = d * S0[j] + dS[k * 128 + sv0 * 32 + r32]; S1[j] = d * S1[j] + dS[k * 128 + (sv0 + 1) * 32 + r32]; }
        }
#pragma unroll
        for (int g4 = 0; g4 < 4; ++g4) { const int k0 = ski * 32 + 8 * g4 + 4 * hh;
            v2u w0, w1; w0.x = pk2(S0[4 * g4], S0[4 * g4 + 1]); w0.y = pk2(S0[4 * g4 + 2], S0[4 * g4 + 3]); w1.x = pk2(S1[4 * g4], S1[4 * g4 + 1]); w1.y = pk2(S1[4 * g4 + 2], S1[4 * g4 + 3]);
            *(LAS v2u*)(SBT + ((sv0 * 32 + r32) * 136 + k0) * 2) = w0; *(LAS v2u*)(SBT + (((sv0 + 1) * 32 + r32) * 136 + k0) * 2) = w1; }
    }
    for (int cc = 0; cc < 16; ++cc) {
        const size_t row0 = (size_t)b * 4096 + (seg * 16 + cc) * 64;
        __syncthreads();
        float l[16], qv[16];
        {
            const size_t g0 = (row0 + qd * 16) * 512 + h * 128 + kcol;
            bf16 vraw[16];
#pragma unroll
            for (int i = 0; i < 16; ++i) { l[i] = LF[g0 + (size_t)i * 512]; vraw[i] = VV[g0 + (size_t)i * 512]; if (FULL) qv[i] = bf2f(Q[g0 + (size_t)i * 512]); }
            v4u w0, w1;
            w0.x = vraw[0] | ((unsigned)vraw[1] << 16); w0.y = vraw[2] | ((unsigned)vraw[3] << 16); w0.z = vraw[4] | ((unsigned)vraw[5] << 16); w0.w = vraw[6] | ((unsigned)vraw[7] << 16);
            w1.x = vraw[8] | ((unsigned)vraw[9] << 16); w1.y = vraw[10] | ((unsigned)vraw[11] << 16); w1.z = vraw[12] | ((unsigned)vraw[13] << 16); w1.w = vraw[14] | ((unsigned)vraw[15] << 16);
            *(LAS v4u*)(VT + (kcol * 72 + qd * 16) * 2) = w0; *(LAS v4u*)(VT + (kcol * 72 + qd * 16 + 8) * 2) = w1;
        }
        float pre[16]; { float run = 0.f;
#pragma unroll
            for (int i = 0; i < 16; ++i) { run += l[i]; pre[i] = run; }
            TOT[qd * 128 + kcol] = run; }
        __syncthreads();
        float off = 0.f, blast = 0.f;
#pragma unroll
        for (int q2 = 0; q2 < 4; ++q2) { const float tv = TOT[q2 * 128 + kcol]; blast += tv; off += (q2 < qd) ? tv : 0.f; }
        if (qd == 0) { EB[kcol] = __expf(blast); sumlog += blast; }
        {
            float kh[16];
#pragma unroll
            for (int i = 0; i < 16; ++i) {
                const float bc = off + pre[i], omf = 1.0f - __expf(l[i]);
                kh[i] = omf * __expf(blast - bc);
                if (FULL) { const int s = qd * 16 + i;
                    *(LAS bf16*)(QT + (s * 136 + kcol) * 2) = (bf16)f2bf(qv[i] * __expf(bc));
                    *(LAS bf16*)(KT + (s * 136 + kcol) * 2) = (bf16)f2bf(omf * __expf(-bc)); }
            }
            v4u w0, w1; w0.x = pk2(kh[0], kh[1]); w0.y = pk2(kh[2], kh[3]); w0.z = pk2(kh[4], kh[5]); w0.w = pk2(kh[6], kh[7]);
            w1.x = pk2(kh[8], kh[9]); w1.y = pk2(kh[10], kh[11]); w1.z = pk2(kh[12], kh[13]); w1.w = pk2(kh[14], kh[15]);
            *(LAS v4u*)(KHT + (kcol * 72 + qd * 16) * 2) = w0; *(LAS v4u*)(KHT + (kcol * 72 + qd * 16 + 8) * 2) = w1;
        }
        __syncthreads();
        f32x16 o;
#pragma unroll
        for (int j = 0; j < 16; ++j) o[j] = 0.f;
        if (FULL) {
            if (wave < 3) {
                const int sti = wave ? 1 : 0, ssi = wave == 2 ? 1 : 0;
                f32x16 sc;
#pragma unroll
                for (int j = 0; j < 16; ++j) sc[j] = 0.f;
#pragma unroll
                for (int ks = 0; ks < 8; ++ks) sc = __builtin_amdgcn_mfma_f32_32x32x16_bf16(ldfrag(QT, sti * 32 + r32, 136, ks * 16 + 8 * hh), ldfrag(KT, ssi * 32 + r32, 136, ks * 16 + 8 * hh), sc, 0, 0, 0);
                const int s = ssi * 32 + r32;
#pragma unroll
                for (int j = 0; j < 16; ++j) { const int t = sti * 32 + crow(j, hh); *(LAS bf16*)(PB + (t * 72 + s) * 2) = (bf16)f2bf(s <= t ? sc[j] : 0.f); }
            }
#pragma unroll
            for (int ks = 0; ks < 8; ++ks) o = __builtin_amdgcn_mfma_f32_32x32x16_bf16(ldfrag(QT, ti * 32 + r32, 136, ks * 16 + 8 * hh), ldfrag(SBT, vi * 32 + r32, 136, ks * 16 + 8 * hh), o, 0, 0, 0);
        }
        {
#pragma unroll
            for (int g4 = 0; g4 < 4; ++g4) { const f32x4 e = *(const LAS f32x4*)(EB + ski * 32 + 8 * g4 + 4 * hh);
#pragma unroll
                for (int q = 0; q < 4; ++q) { S0[4 * g4 + q] *= e[q]; S1[4 * g4 + q] *= e[q]; } }
#pragma unroll
            for (int ks = 0; ks < 4; ++ks) { const bf16x8 af = ldfrag(KHT, ski * 32 + r32, 72, ks * 16 + 8 * hh);
                S0 = __builtin_amdgcn_mfma_f32_32x32x16_bf16(af, ldfrag(VT, sv0 * 32 + r32, 72, ks * 16 + 8 * hh), S0, 0, 0, 0);
                S1 = __builtin_amdgcn_mfma_f32_32x32x16_bf16(af, ldfrag(VT, (sv0 + 1) * 32 + r32, 72, ks * 16 + 8 * hh), S1, 0, 0, 0); }
        }
        if (FULL) {
            __syncthreads();
            if (ti) {
#pragma unroll
                for (int ks = 0; ks < 4; ++ks) o = __builtin_amdgcn_mfma_f32_32x32x16_bf16(ldfrag(PB, ti * 32 + r32, 72, ks * 16 + 8 * hh), ldfrag(VT, vi * 32 + r32, 72, ks * 16 + 8 * hh), o, 0, 0, 0);
            } else {
#pragma unroll
                for (int ks = 0; ks < 2; ++ks) o = __builtin_amdgcn_mfma_f32_32x32x16_bf16(ldfrag(PB, r32, 72, ks * 16 + 8 * hh), ldfrag(VT, vi * 32 + r32, 72, ks * 16 + 8 * hh), o, 0, 0, 0);
            }
#pragma unroll
            for (int g4 = 0; g4 < 4; ++g4) { const int k0 = ski * 32 + 8 * g4 + 4 * hh;
                v2u w0, w1; w0.x = pk2(S0[4 * g4], S0[4 * g4 + 1]); w0.y = pk2(S0[4 * g4 + 2], S0[4 * g4 + 3]); w1.x = pk2(S1[4 * g4], S1[4 * g4 + 1]); w1.y = pk2(S1[4 * g4 + 2], S1[4 * g4 + 3]);
                *(LAS v2u*)(SBT + ((sv0 * 32 + r32) * 136 + k0) * 2) = w0; *(LAS v2u*)(SBT + (((sv0 + 1) * 32 + r32) * 136 + k0) * 2) = w1; }
#pragma unroll
            for (int j = 0; j < 16; ++j) O[(ti * 32 + crow(j, hh)) * 132 + vi * 32 + r32] = o[j];
            __syncthreads();
            {
                const int t = tid >> 3, sg = (tid & 7) * 16;
                float ov[16], ss = 0.f;
#pragma unroll
                for (int i = 0; i < 16; i += 4) { const f32x4 x = *(const LAS f32x4*)(O + t * 132 + sg + i); ov[i] = x[0]; ov[i + 1] = x[1]; ov[i + 2] = x[2]; ov[i + 3] = x[3]; }
#pragma unroll
                for (int i = 0; i < 16; ++i) ss += ov[i] * ov[i];
                ss += __shfl_xor(ss, 1); ss += __shfl_xor(ss, 2); ss += __shfl_xor(ss, 4);
                const float r = rsqrtf(ss * (1.0f / 128.0f) + RMS_EPS);
                const size_t go = (row0 + t) * 512 + h * 128 + sg, yo = (row0 + t) * 1024 + h * 128 + sg;
                const v4u g0 = *(const v4u*)(GS + go), g1 = *(const v4u*)(GS + go + 8);
                float gs0[8], gs1[8]; unpack8(g0, gs0); unpack8(g1, gs1);
                const float* gw = a.in[13] + h * 128 + sg;
#pragma unroll
                for (int i = 0; i < 8; ++i) { ov[i] = ov[i] * r * gw[i] * gs0[i]; ov[8 + i] = ov[8 + i] * r * gw[8 + i] * gs1[i]; }
                v4u w0, w1; w0.x = pk2(ov[0], ov[1]); w0.y = pk2(ov[2], ov[3]); w0.z = pk2(ov[4], ov[5]); w0.w = pk2(ov[6], ov[7]);
                w1.x = pk2(ov[8], ov[9]); w1.y = pk2(ov[10], ov[11]); w1.z = pk2(ov[12], ov[13]); w1.w = pk2(ov[14], ov[15]);
                *(v4u*)(YB + yo) = w0; *(v4u*)(YB + yo + 8) = w1;
            }
        }
    }
    if (!FULL) {
        float* dS = HGS + (size_t)item * 16384;
#pragma unroll
        for (int j = 0; j < 16; ++j) { const int k = ski * 32 + crow(j, hh); dS[k * 128 + sv0 * 32 + r32] = S0[j]; dS[k * 128 + (sv0 + 1) * 32 + r32] = S1[j]; }
        if (qd == 0) HGD[item * 128 + kcol] = __expf(sumlog);
    }
}

template <int NT> DEVI void ln1_rows(const Args& a, int r0, int rstride, int lane) {
    f32x4 v[NT][4];
#pragma unroll
    for (int q = 0; q < NT; ++q) { const int rq = (r0 + q * rstride < T) ? r0 + q * rstride : r0; const float* hr = (const float*)(a.ws + WS_H1) + (size_t)rq * 1024 + lane * 4;
#pragma unroll
        for (int j = 0; j < 4; ++j) v[q][j] = *(const f32x4*)(hr + 256 * j); }
    f32x4 gg[4], bb[4];
#pragma unroll
    for (int j = 0; j < 4; ++j) { gg[j] = *(const f32x4*)(a.in[17] + lane * 4 + 256 * j); bb[j] = *(const f32x4*)(a.in[18] + lane * 4 + 256 * j); }
#pragma unroll
    for (int q = 0; q < NT; ++q) {
        const int row = r0 + q * rstride;
        if (row >= T) continue;
        float s = 0.f;
#pragma unroll
        for (int j = 0; j < 4; ++j) s += (v[q][j][0] + v[q][j][1]) + (v[q][j][2] + v[q][j][3]);
        const float mean = wave_sum(s) * (1.0f / 1024.0f); float qq = 0.f;
#pragma unroll
        for (int j = 0; j < 4; ++j) { v[q][j] = v[q][j] - mean; qq += (v[q][j][0] * v[q][j][0] + v[q][j][1] * v[q][j][1]) + (v[q][j][2] * v[q][j][2] + v[q][j][3] * v[q][j][3]); }
        const float rstd = rsqrtf(wave_sum(qq) * (1.0f / 1024.0f) + LN_EPS);
        bf16* o = (bf16*)(a.ws + WS_X1B) + (size_t)row * 1024 + lane * 4;
        float am = 0.f;
#pragma unroll
        for (int j = 0; j < 4; ++j) {
            const f32x4 y = v[q][j] * rstd * gg[j] + bb[j]; v[q][j] = y;
            am = fmaxf(am, fmaxf(fmaxf(fabsf(y[0]), fabsf(y[1])), fmaxf(fabsf(y[2]), fabsf(y[3]))));
            v2u w; w.x = pk2(y[0], y[1]); w.y = pk2(y[2], y[3]);
            *(v2u*)(o + 256 * j) = w;
        }
#if PEER_U_INT8
        am = fmaxf(wave_max(am), 1e-30f);
        const float inv = 127.0f / am;
        unsigned char* qo = a.ws + WS_X1Q + (size_t)row * 1024 + lane * 4;
#pragma unroll
        for (int j = 0; j < 4; ++j) *(unsigned*)(qo + 256 * j) = q4_i8(v[q][j][0] * inv, v[q][j][1] * inv, v[q][j][2] * inv, v[q][j][3] * inv);
        if (lane == 0) ((float*)(a.ws + WS_XS))[row] = am * (1.0f / 127.0f);
#endif
    }
}

DEVI unsigned umax_(unsigned a, unsigned b) { return a > b ? a : b; }
DEVI unsigned umin_(unsigned a, unsigned b) { return a < b ? a : b; }
DEVI unsigned skey(float x) { const unsigned b = __float_as_uint(x); return b ^ (((int)b >> 31) | 0x80000000u); }
DEVI unsigned hkey(unsigned h) { return h ^ ((h & 0x8000u) ? 0xFFFFu : 0x8000u); }
DEVI float hkey_dec(unsigned k) { const unsigned kk = k >> 16; return h2f((unsigned short)(kk ^ ((kk & 0x8000u) ? 0x8000u : 0xFFFFu))); }
DEVI void ce_desc(unsigned& a, unsigned& b) { const unsigned mx = umax_(a, b), mn = umin_(a, b); a = mx; b = mn; }
DEVI void sort16_desc(unsigned (&g)[16]) {
#pragma unroll
    for (int k = 2; k <= 16; k <<= 1)
#pragma unroll
        for (int j = k >> 1; j > 0; j >>= 1)
#pragma unroll
            for (int i = 0; i < 16; ++i) { const int l = i ^ j; if (l > i) { if ((i & k) == 0) ce_desc(g[i], g[l]); else ce_desc(g[l], g[i]); } }
}
DEVI void merge16_desc(unsigned (&L)[16], const unsigned (&g)[16]) {
#pragma unroll
    for (int i = 0; i < 16; ++i) L[i] = umax_(L[i], g[15 - i]);
#pragma unroll
    for (int j = 8; j > 0; j >>= 1)
#pragma unroll
        for (int i = 0; i < 16; ++i) { const int l = i ^ j; if (l > i) ce_desc(L[i], L[l]); }
}
DEVI void topk_block(const Args& a, LAS float* stg, int task, int lane) {
    const int tb = task >> 3, h = task & 7;
    const unsigned short* sc = (const unsigned short*)(a.ws + WS_SC) + (size_t)tb * 64 * 2048 + h * 256;
    unsigned L[2][16];
#pragma unroll
    for (int p = 0; p < 2; ++p) {
#pragma unroll
        for (int i = 0; i < 16; ++i) L[p][i] = 0u;
        for (int sub = 0; sub < 2; ++sub) {
            v4u ld[8];
#pragma unroll
            for (int q = 0; q < 8; ++q) ld[q] = *(const v4u*)(sc + (size_t)(q * 8 + (lane >> 3)) * 2048 + p * 128 + sub * 64 + (lane & 7) * 8);
            __builtin_amdgcn_wave_barrier();
#pragma unroll
            for (int q = 0; q < 8; ++q) *(LAS v4u*)(stg + (q * 8 + (lane >> 3)) * 36 + (lane & 7) * 4) = ld[q];
            LDS_WAIT(); __builtin_amdgcn_wave_barrier();
#pragma unroll
            for (int q2 = 0; q2 < 4; ++q2) {
                const v4u v0 = *(const LAS v4u*)(stg + lane * 36 + q2 * 8), v1 = *(const LAS v4u*)(stg + lane * 36 + q2 * 8 + 4);
                unsigned g[16];
#pragma unroll
                for (int e = 0; e < 8; ++e) {
                    const unsigned h0 = (e & 1) ? (v0[e >> 1] >> 16) : (v0[e >> 1] & 0xFFFFu), h1 = (e & 1) ? (v1[e >> 1] >> 16) : (v1[e >> 1] & 0xFFFFu);
                    g[e] = (hkey(h0) << 16) | (unsigned)(sub * 64 + q2 * 16 + e); g[8 + e] = (hkey(h1) << 16) | (unsigned)(sub * 64 + q2 * 16 + 8 + e);
                }
                sort16_desc(g);
                merge16_desc(L[p], g);
            }
            LDS_WAIT(); __builtin_amdgcn_wave_barrier();
        }
    }
    unsigned C[16];
#pragma unroll
    for (int i = 0; i < 16; ++i) C[i] = 0u;
#pragma unroll
    for (int ia = 0; ia < 16; ++ia) {
        const float va = hkey_dec(L[0][ia]); const unsigned ea = (L[0][ia] & 127u) << 7;
#pragma unroll
        for (int ib = 0; ib < 16; ++ib) {
            if ((ia + 1) * (ib + 1) <= 16) {
                unsigned x = (skey(va + hkey_dec(L[1][ib])) & 0xFFFFC000u) | ea | (L[1][ib] & 127u);
#pragma unroll
                for (int i = 0; i < 16; ++i) { const unsigned t = umax_(C[i], x); x = umin_(C[i], x); C[i] = t; }
            }
        }
    }
    const unsigned short* srow = sc + (size_t)lane * 2048;
    float cv[16]; float mx = -3.0e38f;
#pragma unroll
    for (int i = 0; i < 16; ++i) { const unsigned e = C[i] & 0x3FFFu; cv[i] = h2f(srow[e >> 7]) + h2f(srow[128 + (e & 127u)]); mx = fmaxf(mx, cv[i]); }
    float es = 0.f;
#pragma unroll
    for (int i = 0; i < 16; ++i) { cv[i] = __expf(cv[i] - mx); es += cv[i]; }
    const float inv = 1.0f / es;
    const size_t item = ((size_t)tb * 64 + lane) * 8 + h;
    int* ids = (int*)(a.ws + WS_IDS) + item * 16; float* gts = (float*)(a.ws + WS_GATES) + item * 16;
#pragma unroll
    for (int i = 0; i < 16; i += 4) { *(v4u*)(ids + i) = (v4u){C[i] & 0x3FFFu, C[i + 1] & 0x3FFFu, C[i + 2] & 0x3FFFu, C[i + 3] & 0x3FFFu};
        *(f32x4*)(gts + i) = (f32x4){cv[i] * inv, cv[i + 1] * inv, cv[i + 2] * inv, cv[i + 3] * inv}; }
}

DEVI void cvt16_fp8(const v4u& r, float (&f)[16]) {
#pragma unroll
    for (int w = 0; w < 4; ++w) { const f32x2 lo = __builtin_amdgcn_cvt_pk_f32_fp8((int)r[w], false), hi = __builtin_amdgcn_cvt_pk_f32_fp8((int)r[w], true);
        f[4 * w] = lo[0]; f[4 * w + 1] = lo[1]; f[4 * w + 2] = hi[0]; f[4 * w + 3] = hi[1]; }
}
#ifndef GCH
#define GCH 128
#endif
#ifndef GATHER_NT
#define GATHER_NT 0
#endif
#if GATHER_NT
#define NTLD(p) (*(p))
#define NTST(v, p) __builtin_nontemporal_store((v), (p))
#else
#define NTLD(p) (*(p))
#define NTST(v, p) (*(p) = (v))
#endif
DEVI int bperm_i(int srclane, int v) { return __builtin_amdgcn_ds_bpermute(srclane << 2, v); }
DEVI void gx_issue(v4u (&row)[16], const unsigned char* tab, int id0, int id1, int g) {
#pragma unroll
    for (int it = 0; it < 16; ++it) { const int e = bperm_i((it * 8 + g) & 63, it < 8 ? id0 : id1); row[it] = *(const v4u*)(tab + (size_t)e * 128); }
}
#if PEER_U_INT8
DEVI void gu_math(const v4u (&row)[16], const v4u& xq, const v4u&, float* pd, int g, int i) {
    int d[16];
#pragma unroll
    for (int it = 0; it < 16; ++it) { int s = 0;
#pragma unroll
        for (int w = 0; w < 4; ++w) s = __builtin_amdgcn_sdot4((int)row[it][w], (int)xq[w], s, false);
        d[it] = s; }
    const bool b2 = i & 4, b1 = i & 2, b0 = i & 1;
    int y[2];
#pragma unroll
    for (int hh = 0; hh < 2; ++hh) {
        int w4[4], w2[2];
#pragma unroll
        for (int q = 0; q < 4; ++q) { const int send = b2 ? d[8 * hh + q] : d[8 * hh + q + 4], keep = b2 ? d[8 * hh + q + 4] : d[8 * hh + q]; w4[q] = keep + __shfl_xor(send, 4); }
#pragma unroll
        for (int q = 0; q < 2; ++q) { const int send = b1 ? w4[q] : w4[q + 2], keep = b1 ? w4[q + 2] : w4[q]; w2[q] = keep + __shfl_xor(send, 2); }
        { const int send = b0 ? w2[0] : w2[1], keep = b0 ? w2[1] : w2[0]; y[hh] = keep + __shfl_xor(send, 1); }
    }
    NTST((float)y[0], pd + i * 8 + g); NTST((float)y[1], pd + (8 + i) * 8 + g);
}
#else
DEVI void gu_math(const v4u (&row)[16], const v4u& x0, const v4u& x1, float* pd, int g, int i) {
    float xs[16]; { float u0[8], u1[8]; unpack8(x0, u0); unpack8(x1, u1);
#pragma unroll
        for (int q = 0; q < 8; ++q) { xs[q] = u0[q]; xs[8 + q] = u1[q]; } }
    f32x2 xp2[8];
#pragma unroll
    for (int q = 0; q < 8; ++q) xp2[q] = (f32x2){xs[2 * q], xs[2 * q + 1]};
    float d[16];
#pragma unroll
    for (int it = 0; it < 16; ++it) { f32x2 sm = {0.f, 0.f};
#pragma unroll
        for (int w = 0; w < 4; ++w) { sm = __builtin_elementwise_fma(__builtin_amdgcn_cvt_pk_f32_fp8((int)row[it][w], false), xp2[2 * w], sm);
                                      sm = __builtin_elementwise_fma(__builtin_amdgcn_cvt_pk_f32_fp8((int)row[it][w], true), xp2[2 * w + 1], sm); }
        d[it] = sm[0] + sm[1];
        if ((it & 3) == 3) __builtin_amdgcn_sched_barrier(0); }
    const bool b2 = i & 4, b1 = i & 2, b0 = i & 1;
    float y[2];
#pragma unroll
    for (int hh = 0; hh < 2; ++hh) {
        float w4[4], w2[2];
#pragma unroll
        for (int q = 0; q < 4; ++q) { const float send = b2 ? d[8 * hh + q] : d[8 * hh + q + 4], keep = b2 ? d[8 * hh + q + 4] : d[8 * hh + q]; w4[q] = keep + __shfl_xor(send, 4); }
#pragma unroll
        for (int q = 0; q < 2; ++q) { const float send = b1 ? w4[q] : w4[q + 2], keep = b1 ? w4[q + 2] : w4[q]; w2[q] = keep + __shfl_xor(send, 2); }
        { const float send = b0 ? w2[0] : w2[1], keep = b0 ? w2[1] : w2[0]; y[hh] = keep + __shfl_xor(send, 1); }
    }
    pd[i * 8 + g] = y[0]; pd[(8 + i) * 8 + g] = y[1];
}
#endif
DEVI void gu_chunk(const Args& a, int j, int chunk, int wave, int lane) {
    unsigned char* ws = a.ws;
    const int g = lane >> 3, i = lane & 7;
    const unsigned char* tab = ws + WS_PU + (size_t)j * PNE * 128 + i * 16;
    float* PD = (float*)(ws + WS_PD) + (size_t)j * T * 128;
    const int* idbase = (const int*)(ws + WS_IDS);
#if PEER_U_INT8
    const unsigned char* xbase = ws + WS_X1Q + j * 128 + i * 16;
#define GU_X1(p) (*(const v4u*)(p))
#else
    const bf16* xbase = (const bf16*)(ws + WS_X1B) + j * 128 + i * 16;
#define GU_X1(p) (*(const v4u*)((p) + 8))
#endif
    const int t0 = chunk * GCH + wave * (GCH / 8);
    v4u rowA[16], rowB[16];
    int ia0 = NTLD(idbase + (size_t)t0 * 128 + lane), ia1 = NTLD(idbase + (size_t)t0 * 128 + 64 + lane);
    int ib0 = NTLD(idbase + (size_t)(t0 + 1) * 128 + lane), ib1 = NTLD(idbase + (size_t)(t0 + 1) * 128 + 64 + lane);
    v4u xa0 = *(const v4u*)(xbase + (size_t)t0 * 1024), xa1 = GU_X1(xbase + (size_t)t0 * 1024), xb0, xb1;
    gx_issue(rowA, tab, ia0, ia1, g);
    for (int tt = 0; tt < GCH / 8; tt += 2) {
        const int t = t0 + tt; const bool more = tt + 2 < GCH / 8;
        if (more) { ia0 = NTLD(idbase + (size_t)(t + 2) * 128 + lane); ia1 = NTLD(idbase + (size_t)(t + 2) * 128 + 64 + lane); }
        xb0 = *(const v4u*)(xbase + (size_t)(t + 1) * 1024); xb1 = GU_X1(xbase + (size_t)(t + 1) * 1024);
        __builtin_amdgcn_sched_barrier(0);
        gx_issue(rowB, tab, ib0, ib1, g);
        __builtin_amdgcn_sched_barrier(0);
        gu_math(rowA, xa0, xa1, PD + (size_t)t * 128, g, i);
        __builtin_amdgcn_sched_barrier(0);
        if (more) { ib0 = NTLD(idbase + (size_t)(t + 3) * 128 + lane); ib1 = NTLD(idbase + (size_t)(t + 3) * 128 + 64 + lane);
            xa0 = *(const v4u*)(xbase + (size_t)(t + 2) * 1024); xa1 = GU_X1(xbase + (size_t)(t + 2) * 1024); }
        __builtin_amdgcn_sched_barrier(0);
        if (more) gx_issue(rowA, tab, ia0, ia1, g);
        __builtin_amdgcn_sched_barrier(0);
        gu_math(rowB, xb0, xb1, PD + (size_t)(t + 1) * 128, g, i);
        __builtin_amdgcn_sched_barrier(0);
    }
}
DEVI void gv_math(const v4u (&row)[16], float c0, float c1, bf16* op, int g, int i, int lane) {
    const bool b5 = lane & 32, b4 = lane & 16, b3 = lane & 8;
    const int p = (b5 ? 4 : 0) + (b4 ? 2 : 0) + (b3 ? 1 : 0), colA = (p >> 1) * 4 + (p & 1);
    float cf[16];
#pragma unroll
    for (int it = 0; it < 16; ++it) cf[it] = __uint_as_float((unsigned)bperm_i((it * 8 + g) & 63, (int)__float_as_uint(it < 8 ? c0 : c1)));
#pragma unroll
    for (int pass = 0; pass < 2; ++pass) {
        f32x2 acc2[4];
#pragma unroll
        for (int c = 0; c < 4; ++c) acc2[c] = (f32x2){0.f, 0.f};
#pragma unroll
        for (int it = 0; it < 16; ++it) { const f32x2 c2 = {cf[it], cf[it]};
#pragma unroll
            for (int w = 0; w < 4; ++w) { const f32x2 v = pass ? __builtin_amdgcn_cvt_pk_f32_fp8((int)row[it][w], true) : __builtin_amdgcn_cvt_pk_f32_fp8((int)row[it][w], false); acc2[w] = __builtin_elementwise_fma(c2, v, acc2[w]); }
            if ((it & 3) == 3) __builtin_amdgcn_sched_barrier(0);
        }
        float acc[8];
#pragma unroll
        for (int c = 0; c < 4; ++c) { acc[2 * c] = acc2[c][0]; acc[2 * c + 1] = acc2[c][1]; }
        float w4[4], w2[2], y;
#pragma unroll
        for (int q = 0; q < 4; ++q) { const float send = b5 ? acc[q] : acc[q + 4], keep = b5 ? acc[q + 4] : acc[q]; w4[q] = keep + __shfl_xor(send, 32); }
#pragma unroll
        for (int q = 0; q < 2; ++q) { const float send = b4 ? w4[q] : w4[q + 2], keep = b4 ? w4[q + 2] : w4[q]; w2[q] = keep + __shfl_xor(send, 16); }
        { const float send = b3 ? w2[0] : w2[1], keep = b3 ? w2[1] : w2[0]; y = keep + __shfl_xor(send, 8); }
        NTST((bf16)f2bf(y), op + i * 16 + colA + 2 * pass);
    }
}
#ifndef PROBE_GVMATH
#define PROBE_GVMATH 0
#endif
__device__ unsigned long long gvm_dummy;
DEVI void gv_chunk(const Args& a, int j, int chunk, int wave, int lane, unsigned long long& gvm_acc) {
    unsigned char* ws = a.ws;
    const int g = lane >> 3, i = lane & 7;
    const unsigned char* tab = ws + WS_PV + (size_t)j * PNE * 128 + i * 16;
    const int* idbase = (const int*)(ws + WS_IDS); const float* cfbase = (const float*)(ws + WS_CF);
    bf16* obase = (bf16*)(ws + WS_OP) + j * 128;
    const int t0 = chunk * GCH + wave * (GCH / 8);
    v4u rowA[16], rowB[16];
    int ia0 = NTLD(idbase + (size_t)t0 * 128 + lane), ia1 = NTLD(idbase + (size_t)t0 * 128 + 64 + lane);
    int ib0 = NTLD(idbase + (size_t)(t0 + 1) * 128 + lane), ib1 = NTLD(idbase + (size_t)(t0 + 1) * 128 + 64 + lane);
    float ca0 = NTLD(cfbase + (size_t)t0 * 128 + lane), ca1 = NTLD(cfbase + (size_t)t0 * 128 + 64 + lane), cb0, cb1;
    gx_issue(rowA, tab, ia0, ia1, g);
    for (int tt = 0; tt < GCH / 8; tt += 2) {
        const int t = t0 + tt; const bool more = tt + 2 < GCH / 8;
        if (more) { ia0 = NTLD(idbase + (size_t)(t + 2) * 128 + lane); ia1 = NTLD(idbase + (size_t)(t + 2) * 128 + 64 + lane); }
        cb0 = NTLD(cfbase + (size_t)(t + 1) * 128 + lane); cb1 = NTLD(cfbase + (size_t)(t + 1) * 128 + 64 + lane);
        __builtin_amdgcn_sched_barrier(0);
        gx_issue(rowB, tab, ib0, ib1, g);
        __builtin_amdgcn_sched_barrier(0);
        { const unsigned long long m0_ = PROBE_GVMATH ? __builtin_amdgcn_s_memrealtime() : 0ull;
        gv_math(rowA, ca0, ca1, obase + (size_t)t * 1024, g, i, lane);
        if (PROBE_GVMATH) gvm_acc += __builtin_amdgcn_s_memrealtime() - m0_; }
        __builtin_amdgcn_sched_barrier(0);
        if (more) { ib0 = NTLD(idbase + (size_t)(t + 3) * 128 + lane); ib1 = NTLD(idbase + (size_t)(t + 3) * 128 + 64 + lane);
            ca0 = NTLD(cfbase + (size_t)(t + 2) * 128 + lane); ca1 = NTLD(cfbase + (size_t)(t + 2) * 128 + 64 + lane); }
        __builtin_amdgcn_sched_barrier(0);
        if (more) gx_issue(rowA, tab, ia0, ia1, g);
        __builtin_amdgcn_sched_barrier(0);
        { const unsigned long long m0_ = PROBE_GVMATH ? __builtin_amdgcn_s_memrealtime() : 0ull;
        gv_math(rowB, cb0, cb1, obase + (size_t)(t + 1) * 1024, g, i, lane);
        if (PROBE_GVMATH) gvm_acc += __builtin_amdgcn_s_memrealtime() - m0_; }
        __builtin_amdgcn_sched_barrier(0);
    }
}
DEVI void gvg_issue(v4u (&row)[8], const unsigned char* tab, const v4u (&ev)[2]) {
#pragma unroll
    for (int q = 0; q < 8; ++q) row[q] = *(const v4u*)(tab + (size_t)ev[q >> 2][q & 3] * 128);
}
DEVI void gvg_math(const v4u (&row)[8], const f32x4 (&cv)[2], f32x2 (&acc2)[8]) {
#pragma unroll
    for (int q = 0; q < 8; ++q) { const float c = cv[q >> 2][q & 3]; const f32x2 c2 = {c, c};
#pragma unroll
        for (int w = 0; w < 4; ++w) { acc2[2 * w] = __builtin_elementwise_fma(c2, __builtin_amdgcn_cvt_pk_f32_fp8((int)row[q][w], false), acc2[2 * w]);
                                      acc2[2 * w + 1] = __builtin_elementwise_fma(c2, __builtin_amdgcn_cvt_pk_f32_fp8((int)row[q][w], true), acc2[2 * w + 1]); }
        if ((q & 3) == 3) __builtin_amdgcn_sched_barrier(0); }
}
DEVI void gv_chunk_grp(const Args& a, int j, int chunk, int wave, int lane) {
    unsigned char* ws = a.ws;
    const int g = lane >> 3, i = lane & 7;
    const unsigned char* tab = ws + WS_PV + (size_t)j * PNE * 128 + i * 16;
    for (int r = 0; r < GCH / 64; ++r) {
        const int t = chunk * GCH + r * 64 + wave * 8 + g;
        const int* idp = (const int*)(ws + WS_IDS) + (size_t)t * 128; const float* cfp = (const float*)(ws + WS_CF) + (size_t)t * 128;
        f32x2 acc2[8];
#pragma unroll
        for (int c = 0; c < 8; ++c) acc2[c] = (f32x2){0.f, 0.f};
        v4u rowA[8], rowB[8], evA[2], evB[2]; f32x4 cvA[2], cvB[2];
#pragma unroll
        for (int q = 0; q < 2; ++q) { evA[q] = *(const v4u*)(idp + 4 * q); cvA[q] = *(const f32x4*)(cfp + 4 * q); }
        gvg_issue(rowA, tab, evA);
#pragma unroll
        for (int q = 0; q < 2; ++q) evB[q] = *(const v4u*)(idp + 8 + 4 * q);
        for (int s = 0; s < 16; s += 2) {
            if (s + 2 < 16) {
#pragma unroll
                for (int q = 0; q < 2; ++q) evA[q] = *(const v4u*)(idp + (s + 2) * 8 + 4 * q);
            }
#pragma unroll
            for (int q = 0; q < 2; ++q) cvB[q] = *(const f32x4*)(cfp + (s + 1) * 8 + 4 * q);
            __builtin_amdgcn_sched_barrier(0);
            gvg_issue(rowB, tab, evB);
            __builtin_amdgcn_sched_barrier(0);
            gvg_math(rowA, cvA, acc2);
            __builtin_amdgcn_sched_barrier(0);
            if (s + 3 < 16) {
#pragma unroll
                for (int q = 0; q < 2; ++q) evB[q] = *(const v4u*)(idp + (s + 3) * 8 + 4 * q);
            }
            if (s + 2 < 16) {
#pragma unroll
                for (int q = 0; q < 2; ++q) cvA[q] = *(const f32x4*)(cfp + (s + 2) * 8 + 4 * q);
            }
            __builtin_amdgcn_sched_barrier(0);
            if (s + 2 < 16) gvg_issue(rowA, tab, evA);
            __builtin_amdgcn_sched_barrier(0);
            gvg_math(rowB, cvB, acc2);
            __builtin_amdgcn_sched_barrier(0);
        }
        bf16* op = (bf16*)(ws + WS_OP) + (size_t)t * 1024 + j * 128 + i * 16;
        v4u w0, w1; w0.x = pk2(acc2[0][0], acc2[0][1]); w0.y = pk2(acc2[1][0], acc2[1][1]); w0.z = pk2(acc2[2][0], acc2[2][1]); w0.w = pk2(acc2[3][0], acc2[3][1]);
        w1.x = pk2(acc2[4][0], acc2[4][1]); w1.y = pk2(acc2[5][0], acc2[5][1]); w1.z = pk2(acc2[6][0], acc2[6][1]); w1.w = pk2(acc2[7][0], acc2[7][1]);
        *(v4u*)op = w0; *(v4u*)(op + 8) = w1;
    }
}
#if PEER_U_INT8
DEVI void gug_math(const v4u (&row)[8], const v4u& xq, float* pd, int i) {
    int d[8];
#pragma unroll
    for (int q = 0; q < 8; ++q) { int s = 0;
#pragma unroll
        for (int w = 0; w < 4; ++w) s = __builtin_amdgcn_sdot4((int)row[q][w], (int)xq[w], s, false);
        d[q] = s; }
    const bool b2 = i & 4, b1 = i & 2, b0 = i & 1;
    int w4[4], w2[2], y;
#pragma unroll
    for (int q = 0; q < 4; ++q) { const int send = b2 ? d[q] : d[q + 4], keep = b2 ? d[q + 4] : d[q]; w4[q] = keep + __shfl_xor(send, 4); }
#pragma unroll
    for (int q = 0; q < 2; ++q) { const int send = b1 ? w4[q] : w4[q + 2], keep = b1 ? w4[q + 2] : w4[q]; w2[q] = keep + __shfl_xor(send, 2); }
    { const int send = b0 ? w2[0] : w2[1], keep = b0 ? w2[1] : w2[0]; y = keep + __shfl_xor(send, 1); }
    pd[i] = (float)y;
}
DEVI void gug_issue16(v4u (&row)[16], const unsigned char* tab, const v4u (&ev)[4]) {
#pragma unroll
    for (int q = 0; q < 16; ++q) row[q] = *(const v4u*)(tab + (size_t)ev[q >> 2][q & 3] * 128);
}
DEVI void gug_math16(const v4u (&row)[16], const v4u& xq, float* pd, int i) {
    int d[16];
#pragma unroll
    for (int q = 0; q < 16; ++q) { int s = 0;
#pragma unroll
        for (int w = 0; w < 4; ++w) s = __builtin_amdgcn_sdot4((int)row[q][w], (int)xq[w], s, false);
        d[q] = s; }
    const bool b2 = i & 4, b1 = i & 2, b0 = i & 1;
#pragma unroll
    for (int hh = 0; hh < 2; ++hh) {
        int w4[4], w2[2], y;
#pragma unroll
        for (int q = 0; q < 4; ++q) { const int send = b2 ? d[8 * hh + q] : d[8 * hh + q + 4], keep = b2 ? d[8 * hh + q + 4] : d[8 * hh + q]; w4[q] = keep + __shfl_xor(send, 4); }
#pragma unroll
        for (int q = 0; q < 2; ++q) { const int send = b1 ? w4[q] : w4[q + 2], keep = b1 ? w4[q + 2] : w4[q]; w2[q] = keep + __shfl_xor(send, 2); }
        { const int send = b0 ? w2[0] : w2[1], keep = b0 ? w2[1] : w2[0]; y = keep + __shfl_xor(send, 1); }
        pd[8 * hh + i] = (float)y;
    }
}
DEVI void gu_chunk_grp(const Args& a, int j, int chunk, int wave, int lane) {
    unsigned char* ws = a.ws;
    const int g = lane >> 3, i = lane & 7;
    const unsigned char* tab = ws + WS_PU + (size_t)j * PNE * 128 + i * 16;
    for (int r = 0; r < GCH / 64; ++r) {
        const int t = chunk * GCH + r * 64 + wave * 8 + g;
        const int* idp = (const int*)(ws + WS_IDS) + (size_t)t * 128;
        float* pd = (float*)(ws + WS_PD) + (size_t)j * T * 128 + (size_t)t * 128;
        const v4u xq = *(const v4u*)(ws + WS_X1Q + (size_t)t * 1024 + j * 128 + i * 16);
        v4u rowA[16], rowB[16], evA[4], evB[4];
#pragma unroll
        for (int q = 0; q < 4; ++q) evA[q] = *(const v4u*)(idp + 4 * q);
        gug_issue16(rowA, tab, evA);
#pragma unroll
        for (int q = 0; q < 4; ++q) evB[q] = *(const v4u*)(idp + 16 + 4 * q);
        for (int s = 0; s < 8; s += 2) {
            if (s + 2 < 8) {
#pragma unroll
                for (int q = 0; q < 4; ++q) evA[q] = *(const v4u*)(idp + (s + 2) * 16 + 4 * q);
            }
            __builtin_amdgcn_sched_barrier(0);
            gug_issue16(rowB, tab, evB);
            __builtin_amdgcn_sched_barrier(0);
            gug_math16(rowA, xq, pd + s * 16, i);
            __builtin_amdgcn_sched_barrier(0);
            if (s + 3 < 8) {
#pragma unroll
                for (int q = 0; q < 4; ++q) evB[q] = *(const v4u*)(idp + (s + 3) * 16 + 4 * q);
            }
            __builtin_amdgcn_sched_barrier(0);
            if (s + 2 < 8) gug_issue16(rowA, tab, evA);
            __builtin_amdgcn_sched_barrier(0);
            gug_math16(rowB, xq, pd + (s + 1) * 16, i);
            __builtin_amdgcn_sched_barrier(0);
        }
    }
}
#endif
#ifndef GV_GROUPED
#define GV_GROUPED 1
#endif
#ifndef GU_GROUPED
#define GU_GROUPED 1
#endif
template <int WHICH> DEVI void sliced_phase(const Args& a, LAS unsigned char* lds, int wave, int lane, int ctr_off = 0) {
    unsigned* ctr = (unsigned*)(a.ws + WS_CTL) + (WHICH ? CW_GV : CW_GU) + ctr_off;
    volatile LAS unsigned* slot = (volatile LAS unsigned*)(lds + LDS_BYTES - 32);
#ifdef SLICE_BY_BLOCK
    const int xcc = (int)(blockIdx.x & 7u);
#else
    const int xcc = (int)(xb_xcc_id() & 7u);
#endif
    unsigned long long gvm_acc = 0;
    for (int pass = 0; pass < 8; ++pass) {
        const int j = (xcc + pass) & 7;
        for (;;) {
            __syncthreads();
            if (threadIdx.x == 0) *slot = __hip_atomic_fetch_add(ctr + 64 * j, 1u, __ATOMIC_RELAXED, __HIP_MEMORY_SCOPE_AGENT);
            __syncthreads();
            const unsigned c = *slot;
            if (c >= (unsigned)(T / GCH)) break;
            if (WHICH) { if (GV_GROUPED) gv_chunk_grp(a, j, (int)c, wave, lane); else gv_chunk(a, j, (int)c, wave, lane, gvm_acc); } else { if (GU_GROUPED && PEER_U_INT8) gu_chunk_grp(a, j, (int)c, wave, lane); else gu_chunk(a, j, (int)c, wave, lane); }
        }
    }
    if (PROBE_GVMATH && WHICH) { const unsigned long long s_ = __builtin_amdgcn_s_memrealtime(); while (__builtin_amdgcn_s_memrealtime() - s_ < PROBE_GVMATH * gvm_acc) __builtin_amdgcn_s_sleep(8); }
}
DEVI void coef_phase(const Args& a) {
    unsigned char* ws = a.ws;
    const float* PD = (const float*)(ws + WS_PD); const float* gts = (const float*)(ws + WS_GATES); float* CF = (float*)(ws + WS_CF);
    for (size_t i = (size_t)blockIdx.x * 512 + threadIdx.x; i < (size_t)T * 128 / 4; i += (size_t)gridDim.x * 512) {
        f32x4 s = *(const f32x4*)(PD + i * 4);
#pragma unroll
        for (int j = 1; j < 8; ++j) s += *(const f32x4*)(PD + (size_t)j * T * 128 + i * 4);
        const f32x4 gt = *(const f32x4*)(gts + i * 4);
        f32x4 o;
#if PEER_U_INT8
        const v4u ev = *(const v4u*)((const int*)(ws + WS_IDS) + i * 4);
        const float xsc = ((const float*)(ws + WS_XS))[i >> 5];
        const float* us = (const float*)(ws + WS_US);
#pragma unroll
        for (int q = 0; q < 4; ++q) o[q] = gt[q] * gelu_t(s[q] * xsc * us[ev[q]]) * (1.0f / PV_SCALE);
#else
#pragma unroll
        for (int q = 0; q < 4; ++q) o[q] = gt[q] * gelu_t(s[q] * (1.0f / PU_SCALE)) * (1.0f / PV_SCALE);
#endif
        *(f32x4*)(CF + i * 4) = o;
    }
}
template <int NT> DEVI void ln2_tokens(const Args& a, int t0, int tstride, int lane) {
    unsigned char* ws = a.ws;
    v4u xr[NT][2], orr[NT][2];
#pragma unroll
    for (int q = 0; q < NT; ++q) { const int tq = (t0 + q * tstride < T) ? t0 + q * tstride : t0; const size_t o = (size_t)tq * 1024 + lane * 16;
        const bf16* xp = (const bf16*)(ws + WS_X1B) + o; const bf16* ip = (const bf16*)(ws + WS_OP) + o;
        xr[q][0] = *(const v4u*)xp; xr[q][1] = *(const v4u*)(xp + 8); orr[q][0] = *(const v4u*)ip; orr[q][1] = *(const v4u*)(ip + 8); }
    const float* g2 = a.in[23] + lane * 16; const float* b2 = a.in[24] + lane * 16;
    f32x4 gg[4], bb[4];
#pragma unroll
    for (int i = 0; i < 4; ++i) { gg[i] = *(const f32x4*)(g2 + 4 * i); bb[i] = *(const f32x4*)(b2 + 4 * i); }
#pragma unroll
    for (int q = 0; q < NT; ++q) {
        float xf[16], acc[16];
        { float t0a[8], t1a[8]; unpack8(xr[q][0], t0a); unpack8(xr[q][1], t1a);
#pragma unroll
          for (int i = 0; i < 8; ++i) { xf[i] = t0a[i]; xf[8 + i] = t1a[i]; } }
        { float t0a[8], t1a[8]; unpack8(orr[q][0], t0a); unpack8(orr[q][1], t1a);
#pragma unroll
          for (int i = 0; i < 8; ++i) { acc[i] = t0a[i]; acc[8 + i] = t1a[i]; } }
        float s = 0.f;
#pragma unroll
        for (int i = 0; i < 16; ++i) { acc[i] += ALPHA * xf[i]; s += acc[i]; }
        const float mean = wave_sum(s) * (1.0f / 1024.0f); float qq = 0.f;
#pragma unroll
        for (int i = 0; i < 16; ++i) { acc[i] -= mean; qq += acc[i] * acc[i]; }
        const float rstd = rsqrtf(wave_sum(qq) * (1.0f / 1024.0f) + LN_EPS);
        if (t0 + q * tstride >= T) continue;
        float* op = a.out + (size_t)(t0 + q * tstride) * 1024 + lane * 16;
#pragma unroll
        for (int i = 0; i < 4; ++i) {
            f32x4 y; y[0] = acc[4 * i] * rstd * gg[i][0] + bb[i][0]; y[1] = acc[4 * i + 1] * rstd * gg[i][1] + bb[i][1]; y[2] = acc[4 * i + 2] * rstd * gg[i][2] + bb[i][2]; y[3] = acc[4 * i + 3] * rstd * gg[i][3] + bb[i][3];
            *(f32x4*)(op + 4 * i) = y;
        }
    }
}

enum Phase { PH_PREP = 0, PH_PROJ, PH_S5Z, PH_S5SCAN, PH_S5Y, PH_HGRN, PH_GLU, PH_MERGE, PH_OUT, PH_LN1, PH_SCORES, PH_TOPK, PH_GU, PH_COEF, PH_GV, PH_LN2, PH_COUNT };

#ifndef STAGGER_SLEEPS
#define STAGGER_SLEEPS 2
#endif
DEVI void stagger() { if (blockIdx.x & 1) { for (int i = 0; i < STAGGER_SLEEPS; ++i) __builtin_amdgcn_s_sleep(127); } }
#ifndef PG8_ALIGN
#define PG8_ALIGN true
#endif
#ifndef PG8_SP2
#define PG8_SP2 true
#endif
template <class Epi> DEVI void run_gemm(LAS unsigned char* lds, const bf16* A, const bf16* Bt, int M, int N, int K, int lda, int ldb, const Epi& E) {
    pg8::Gemm g; g.A = A; g.Bt = Bt; g.M = M; g.N = N; g.K = K; g.lda = lda; g.ldb = ldb; g.sA = 0; g.sB = 0; g.nz = 1;
    pg8::StaticOrder S; S.init(M, N, gridDim.x, blockIdx.x, 1);
    pg8::gemm_phase<Epi, pg8::StaticOrder, PG8_ALIGN, PG8_SP2>(lds, g, S, E);
}
template <class Epi> DEVI void run_gemm_batched(LAS unsigned char* lds, const bf16* A, const bf16* Bt, int M, int N, int K, int lda, int ldb, size_t sA, size_t sB, int nz, const Epi& E, int cidx = -1) {
    pg8::Gemm g; g.A = A; g.Bt = Bt; g.M = M; g.N = N; g.K = K; g.lda = lda; g.ldb = ldb; g.sA = sA; g.sB = sB; g.nz = nz;
    pg8::StaticOrder S; S.init(M, N, gridDim.x, cidx < 0 ? (int)blockIdx.x : cidx, nz);
    pg8::gemm_phase<Epi, pg8::StaticOrder, PG8_ALIGN, PG8_SP2>(lds, g, S, E);
}

#ifndef MK_COOP
#define MK_COOP 1
#endif
__global__ void __launch_bounds__(512, 2) mk_fwd(Args a) {
    extern __shared__ __attribute__((aligned(16))) unsigned char smem[];
    LAS unsigned char* lds = (LAS unsigned char*)smem;
    cg::grid_group grid = cg::this_grid();
    const int tid = threadIdx.x, lane = tid & 63, wave = __builtin_amdgcn_readfirstlane(tid >> 6), G = gridDim.x;
    unsigned char* ws = a.ws;
    volatile LAS unsigned* bst = (volatile LAS unsigned*)(lds + LDS_BYTES - 16);
    if (tid < 2) bst[tid] = 0u;
    __syncthreads();
    const XcdBarrier xb = xcd_barrier_post((unsigned*)(ws + WS_CTL), bst);
#ifndef REP_PH
#define REP_PH -1
#endif
#ifndef REP_N
#define REP_N 1
#endif
#ifndef PROBE_PH
#define PROBE_PH -1
#endif
#ifndef PROBE_BAR
#define PROBE_BAR 0
#endif
    unsigned long long bar_acc_ = 0;
#define PH_BEGIN(P) if (a.ph_lo <= (P) && (P) < a.ph_hi) { if (a.ph_lo < (P)) { const unsigned long long bt0_ = PROBE_BAR ? __builtin_amdgcn_s_memrealtime() : 0ull; if (MK_COOP && (P) == PH_PROJ) grid.sync(); else xcd_barrier(xb); if (PROBE_BAR) bar_acc_ += __builtin_amdgcn_s_memrealtime() - bt0_; } \
    const int ph_cur_ = (P); const unsigned long long ph_t0_ = (PROBE_PH >= 0) ? __builtin_amdgcn_s_memrealtime() : 0ull; for (int rep_ = 0; rep_ < ((P) == REP_PH ? REP_N : 1); ++rep_) {
#define PH_END } if (PROBE_PH >= 0 && ph_cur_ == PROBE_PH) { const unsigned long long d_ = __builtin_amdgcn_s_memrealtime() - ph_t0_, s_ = __builtin_amdgcn_s_memrealtime(); while (__builtin_amdgcn_s_memrealtime() - s_ < 2 * d_) __builtin_amdgcn_s_sleep(8); } }
    PH_BEGIN(PH_PREP) phase_prep(a, lds); for (int it = blockIdx.x; it < S5G * 8; it += G) s5_tables_item(a, lds, it); PH_END
    PH_BEGIN(PH_PROJ) EpiProj E; E.ws = ws; E.lb_logits = a.in[12];
#ifdef PROBE_PHASE_BLOCK
        const unsigned long long pp0_ = __builtin_amdgcn_s_memrealtime();
#endif
#if PROJ_INT8
        run_gemm(lds, (const bf16*)(ws + WS_XB), (const bf16*)(ws + WS_WINT), T, INC, 512, 512, 512, E);
#else
        run_gemm(lds, (const bf16*)(ws + WS_XB), (const bf16*)(ws + WS_WINT), T, INC, 1024, 1024, 1024, E);
#endif
#ifdef PROBE_PHASE_BLOCK
        if (PROBE_PHASE_COND) { const unsigned long long d_ = __builtin_amdgcn_s_memrealtime() - pp0_, t0_ = __builtin_amdgcn_s_memrealtime(); while (__builtin_amdgcn_s_memrealtime() - t0_ < 2 * d_) __builtin_amdgcn_s_sleep(8); }
#endif
    PH_END
    PH_BEGIN(PH_S5Z)
        for (int it = blockIdx.x; it < 256; it += G) if ((it & 3) != 3) hgrn_segment<false>(a, lds, it);
        __syncthreads();
        EpiS5Z E; E.ws = ws;
        run_gemm_batched(lds, (const bf16*)(ws + WS_U5), (const bf16*)(ws + WS_WZ), 1024, 256, 1024, UK, 1024, (size_t)1024 * UK, (size_t)256 * 1024, S5G, E, G - 1 - (int)blockIdx.x); PH_END
    PH_BEGIN(PH_S5SCAN) s5_scan(a); PH_END
    PH_BEGIN(PH_S5Y) EpiS5Y E; E.ws = ws;
        run_gemm_batched(lds, (const bf16*)(ws + WS_U5), (const bf16*)(ws + WS_TY), 1024, 1024, UK, UK, UK, (size_t)1024 * UK, (size_t)1024 * UK, S5G, E); PH_END
    PH_BEGIN(PH_HGRN) for (int it = blockIdx.x; it < 256; it += G) hgrn_segment<true>(a, lds, it); PH_END
    PH_BEGIN(PH_GLU) EpiGlu E; E.ws = ws; E.bias = a.in[11];
        run_gemm(lds, (const bf16*)(ws + WS_Y2), (const bf16*)(ws + WS_WGLUT), T, 512, 512, 512, 512, E); PH_END
    PH_BEGIN(PH_MERGE) EpiMerge E; E.ws = ws;
        pg8::Gemm g; g.A = (const bf16*)(ws + WS_YAB); g.Bt = (const bf16*)(ws + WS_WPAT); g.M = T; g.N = 1024; g.K = 512; g.lda = 1024; g.ldb = 1024; g.sA = 512; g.sB = 512; g.nz = 2;
        pg8::ChainOrder S; S.init(T, 1024, G, blockIdx.x, 1);
        pg8::gemm_phase<EpiMerge, pg8::ChainOrder, PG8_ALIGN, PG8_SP2>(lds, g, S, E); PH_END
    PH_BEGIN(PH_OUT) EpiOut E; E.ws = ws; E.x = a.in[0];
        run_gemm(lds, (const bf16*)(ws + WS_MG), (const bf16*)(ws + WS_WOT), T, 1024, 1024, 1024, 1024, E); PH_END
    PH_BEGIN(PH_LN1) for (int r = blockIdx.x * 8 + wave; r < T; r += 8 * G * 4) ln1_rows<4>(a, r, 8 * G, lane); PH_END
    PH_BEGIN(PH_SCORES) EpiScores E; E.ws = ws;
#if SCORES_INT8
        run_gemm(lds, (const bf16*)(ws + WS_X1Q), (const bf16*)(ws + WS_WFT), T, 2048, 512, 512, 512, E);
#else
        run_gemm(lds, (const bf16*)(ws + WS_X1B), (const bf16*)(ws + WS_WFT), T, 2048, 1024, 1024, 1024, E);
#endif
    PH_END
    PH_BEGIN(PH_TOPK) LAS float* stg = (LAS float*)(lds + wave * 9216);
        for (int it = blockIdx.x * 8 + wave; it < (T / 64) * PH; it += 8 * G) topk_block(a, stg, it, lane); PH_END
    PH_BEGIN(PH_GU) sliced_phase<0>(a, lds, wave, lane);
#ifdef PROBE_GU2
        sliced_phase<0>(a, lds, wave, lane, 64 * 16);
#endif
    PH_END
    PH_BEGIN(PH_COEF) coef_phase(a); PH_END
    PH_BEGIN(PH_GV) sliced_phase<1>(a, lds, wave, lane);
#ifdef PROBE_GV2
        sliced_phase<1>(a, lds, wave, lane, 64 * 16);
#endif
    PH_END
    PH_BEGIN(PH_LN2) for (int t = blockIdx.x * 8 + wave; t < T; t += 8 * G * 4) ln2_tokens<4>(a, t, 8 * G, lane); PH_END
    if (PROBE_BAR) {
        unsigned* mx = (unsigned*)(ws + WS_CTL) + 7000;
        if (tid == 0) __hip_atomic_fetch_max(mx, 0x7fffffffu - (unsigned)bar_acc_, __ATOMIC_RELAXED, __HIP_MEMORY_SCOPE_AGENT);
        xcd_barrier(xb);
        const unsigned long long mn = 0x7fffffffu - __hip_atomic_load(mx, __ATOMIC_RELAXED, __HIP_MEMORY_SCOPE_AGENT);
        const unsigned long long s_ = __builtin_amdgcn_s_memrealtime(); while (__builtin_amdgcn_s_memrealtime() - s_ < PROBE_BAR * mn) __builtin_amdgcn_s_sleep(8); }
}

#ifndef MK_ONE_LAUNCH
#define MK_ONE_LAUNCH 1
#endif

extern "C" void kernel_launch(void* const* d_in, const int* in_sizes, int n_in, void* d_out, int out_size, void* d_ws, size_t ws_size, hipStream_t stream) {
    static int grid = 0;
    if (grid == 0) {
        if (n_in != 25 || out_size != T * D || ws_size < WS_END) { fprintf(stderr, "kernel_launch: unexpected problem (n_in %d, out %d, ws %zu)\n", n_in, out_size, ws_size); grid = -1; return; }
        int dev = 0, cus = 0, per_cu = 0;
        if (hipGetDevice(&dev) != hipSuccess || hipDeviceGetAttribute(&cus, hipDeviceAttributeMultiprocessorCount, dev) != hipSuccess) { grid = -1; return; }
        if (hipFuncSetAttribute((const void*)mk_fwd, hipFuncAttributeMaxDynamicSharedMemorySize, LDS_BYTES) != hipSuccess) { fprintf(stderr, "kernel_launch: hipFuncSetAttribute failed\n"); grid = -1; return; }
        if (hipOccupancyMaxActiveBlocksPerMultiprocessor(&per_cu, (const void*)mk_fwd, 512, LDS_BYTES) != hipSuccess || per_cu < 1) { fprintf(stderr, "kernel_launch: occupancy query says %d\n", per_cu); per_cu = 1; }
        (void)hipGetLastError();
        grid = cus;
    }
    if (grid < 0) return;
    Args a{};
    for (int i = 0; i < 25; ++i) a.in[i] = (const float*)d_in[i];
    a.out = (float*)d_out; a.ws = (unsigned char*)d_ws;
#if MK_ONE_LAUNCH
    if (hipMemsetAsync((char*)d_ws + WS_CTL, 0, CTL_WORDS * 4, stream) != hipSuccess) { fprintf(stderr, "kernel_launch: memset of the barrier words failed\n"); return; }
    a.ph_lo = 0; a.ph_hi = PH_COUNT;
#if MK_COOP
    void* kargs[] = {&a};
    hipError_t e = hipLaunchCooperativeKernel((const void*)mk_fwd, dim3(grid), dim3(512), kargs, LDS_BYTES, stream);
    if (e != hipSuccess) fprintf(stderr, "kernel_launch: cooperative launch failed: %s (grid %d)\n", hipGetErrorString(e), grid);
#else
    hipLaunchKernelGGL(mk_fwd, dim3(grid), dim3(512), LDS_BYTES, stream, a);
#endif
#else
    for (int ph = 0; ph < PH_COUNT; ++ph) {
        a.ph_lo = ph; a.ph_hi = ph + 1;
        hipLaunchKernelGGL(mk_fwd, dim3(grid), dim3(512), LDS_BYTES, stream, a);
    }
#endif
}
```
